# Optimizing an MI355X kernel written in HIP

```python
import jax, jax.numpy as jnp
from jax import lax
import numpy as np

D_MODEL = 1024
BATCH = 4
SEQ = 4096
DEPTH = 4

CHUNK = 64
N_EVEN = (DEPTH + 1) // 2
N_ODD = DEPTH // 2
ALPHA = (2 * DEPTH) ** 0.25
BETA = (8 * DEPTH) ** -0.25
LN_EPS = 1e-5
NEG = -1e30

POOL_WIDTH = D_MODEL // 2
POOL_WINDOWS = (2, 4, 8, 16)
POOL_GROUP = POOL_WIDTH // len(POOL_WINDOWS)
ML_HEADS = 4
ML_DK = (D_MODEL // 2) // ML_HEADS
ML_DV = (D_MODEL // 2) // ML_HEADS
ML_QK = ML_HEADS * ML_DK
ML_WIDTH = ML_HEADS * ML_DV
CONV_K = 4
EVEN_IN = POOL_WIDTH + 2 * ML_QK + 2 * ML_WIDTH + 2 * ML_HEADS
EVEN_MIX = POOL_WIDTH + ML_WIDTH
GLA_HEADS = 4
GLA_DK = (D_MODEL // 2) // GLA_HEADS
GLA_DV = D_MODEL // GLA_HEADS
GLA_QK = GLA_HEADS * GLA_DK
GLA_V = GLA_HEADS * GLA_DV
GLA_RANK = 16
GLA_TAU = 16.0
GLA_CHUNK = 16
ODD_IN = 2 * GLA_QK + 2 * GLA_V + GLA_RANK
N_EXPERTS = 32
TOP_K = 4
D_EXPERT = D_MODEL
SWIGLU_LIMIT = 7.0
SWIGLU_ALPHA = 1.702

kernel_name = "hybrid_pool_mlstm_gla_moe_deepnorm"


def layer_norm(x, g, b):
    xf = x.astype(jnp.float32)
    mu = xf.mean(-1, keepdims=True)
    var = jnp.square(xf - mu).mean(-1, keepdims=True)
    return ((xf - mu) * lax.rsqrt(var + LN_EPS) * g + b).astype(x.dtype)


def head_norm(h, g):
    mu = h.mean(-1, keepdims=True)
    var = jnp.square(h - mu).mean(-1, keepdims=True)
    hn = (h - mu) * lax.rsqrt(var + LN_EPS)
    return hn.reshape(h.shape[:2] + (-1,)) * g


def to_chunks(t, L):
    B_, S_ = t.shape[:2]
    t = t.astype(jnp.float32).reshape((B_, S_ // L, L) + t.shape[2:])
    return jnp.swapaxes(jnp.moveaxis(t, 1, 0), 2, 3)


def from_chunks(t):
    t = jnp.moveaxis(jnp.swapaxes(t, 2, 3), 0, 1)
    return t.reshape((t.shape[0], t.shape[1] * t.shape[2]) + t.shape[3:])


def pool_mixer(u, w_pool, pool_scale):
    B_, S_, _ = u.shape
    uf = u.astype(jnp.float32).reshape(B_, S_, len(POOL_WINDOWS), POOL_GROUP)
    cs = jnp.cumsum(uf, axis=1)
    pos = jnp.arange(1, S_ + 1, dtype=jnp.float32)
    means = []
    for gi, w in enumerate(POOL_WINDOWS):
        c = cs[:, :, gi]
        lag = jnp.pad(c, ((0, 0), (w, 0), (0, 0)))[:, :S_]
        cnt = jnp.minimum(pos, float(w))[:, None]
        means.append((c - lag) / cnt)
    d = (jnp.stack(means, axis=2) - uf).astype(u.dtype)
    y = jnp.einsum('bsgc,gcd->bsgd', d, w_pool).reshape(B_, S_, POOL_WIDTH)
    return y * pool_scale


def causal_dwconv(x, w, b):
    C = x.shape[-1]
    y = lax.conv_general_dilated(x, w[:, None, :], window_strides=(1,),
                                 padding=((CONV_K - 1, 0),),
                                 dimension_numbers=('NWC', 'WIO', 'NWC'),
                                 feature_group_count=C)
    return y + b


def mlstm(q, k, v, ig, fg):
    B_ = q.shape[0]
    k = k * (ML_DK ** -0.5)
    lf = jax.nn.log_sigmoid(fg.astype(jnp.float32))
    xs = (to_chunks(q, CHUNK), to_chunks(k, CHUNK), to_chunks(v, CHUNK),
          to_chunks(ig, CHUNK), to_chunks(lf, CHUNK))
    mask = jnp.tril(jnp.ones((CHUNK, CHUNK), dtype=bool))

    def step(carry, inp):
        C, n, m = carry
        qc, kc, vc, ic, lfc = inp
        b = jnp.cumsum(lfc, axis=-1)
        g = b[..., -1]
        D = jnp.where(mask, b[..., :, None] - b[..., None, :] + ic[..., None, :], NEG)
        m_inter = b + m[..., None]
        m_t = jnp.maximum(m_inter, D.max(-1))
        Wts = jnp.exp(D - m_t[..., None])
        Sts = jnp.einsum('bhtd,bhsd->bhts', qc, kc) * Wts
        sc = jnp.exp(m_inter - m_t)
        num = jnp.einsum('bhts,bhsv->bhtv', Sts, vc) + sc[..., None] * jnp.einsum('bhtd,bhdv->bhtv', qc, C)
        den = Sts.sum(-1) + sc * jnp.einsum('bhtd,bhd->bht', qc, n)
        h = num / jnp.maximum(jnp.abs(den), jnp.exp(-m_t))[..., None]
        a = g[..., None] - b + ic
        m_new = jnp.maximum(g + m, a.max(-1))
        decay = jnp.exp(g + m - m_new)
        wk = jnp.exp(a - m_new[..., None])[..., None] * kc
        C_new = decay[..., None, None] * C + jnp.einsum('bhsd,bhsv->bhdv', wk, vc)
        n_new = decay[..., None] * n + wk.sum(-2)
        return (C_new, n_new, m_new), h

    init = (jnp.zeros((B_, ML_HEADS, ML_DK, ML_DV), jnp.float32),
            jnp.zeros((B_, ML_HEADS, ML_DK), jnp.float32),
            jnp.zeros((B_, ML_HEADS), jnp.float32))
    _, hs = lax.scan(step, init, xs)
    return from_chunks(hs)


def gla(q, k, v, lg):
    B_ = q.shape[0]
    q = q * (GLA_DK ** -0.5)
    xs = (to_chunks(q, GLA_CHUNK), to_chunks(k, GLA_CHUNK),
          to_chunks(v, GLA_CHUNK), to_chunks(lg, GLA_CHUNK))
    mask = jnp.tril(jnp.ones((GLA_CHUNK, GLA_CHUNK), dtype=bool))[..., None]

    def step(S, inp):
        qc, kc, vc, gc = inp
        Bc = jnp.cumsum(gc, axis=-2)
        E = jnp.where(mask, Bc[..., :, None, :] - Bc[..., None, :, :], NEG)
        A = jnp.einsum('bhtd,bhsd,bhtsd->bhts', qc, kc, jnp.exp(E))
        o = jnp.einsum('bhts,bhsv->bhtv', A, vc) + jnp.einsum('bhtd,bhdv->bhtv', qc * jnp.exp(Bc), S)
        Bl = Bc[..., -1:, :]
        S_new = jnp.exp(Bl[..., 0, :])[..., None] * S + jnp.einsum('bhsd,bhsv->bhdv', kc * jnp.exp(Bl - Bc), vc)
        return S_new, o

    _, os_ = lax.scan(step, jnp.zeros((B_, GLA_HEADS, GLA_DK, GLA_DV), jnp.float32), xs)
    return from_chunks(os_)


def even_mixer(x, w_in, w_pool, pool_scale, conv_w, conv_b, i_bias, f_bias, ml_norm, w_out):
    B_, S_, _ = x.shape
    p = x @ w_in
    o1 = POOL_WIDTH
    o2 = o1 + 2 * ML_QK
    o3 = o2 + ML_WIDTH
    o4 = o3 + ML_WIDTH
    u, qk, vv, og, gates = jnp.split(p, [o1, o2, o3, o4], axis=-1)
    y_pool = pool_mixer(u, w_pool, pool_scale)
    qk = jax.nn.silu(causal_dwconv(qk, conv_w, conv_b))
    q, k = jnp.split(qk, 2, axis=-1)
    q = q.reshape(B_, S_, ML_HEADS, ML_DK)
    k = k.reshape(B_, S_, ML_HEADS, ML_DK)
    vv = vv.reshape(B_, S_, ML_HEADS, ML_DV)
    ig = gates[..., :ML_HEADS] + i_bias
    fg = gates[..., ML_HEADS:] + f_bias
    h = mlstm(q, k, vv, ig, fg)
    y_ml = (head_norm(h, ml_norm) * jax.nn.sigmoid(og.astype(jnp.float32))).astype(x.dtype)
    return jnp.concatenate([y_pool, y_ml], axis=-1) @ w_out


def odd_mixer(x, w_in, gla_w2, gla_b, gla_norm, w_out):
    B_, S_, _ = x.shape
    p = x @ w_in
    q, k, v, r, glr = jnp.split(p, [GLA_QK, 2 * GLA_QK, 2 * GLA_QK + GLA_V, 2 * GLA_QK + 2 * GLA_V], axis=-1)
    lg = jax.nn.log_sigmoid((glr @ gla_w2 + gla_b).astype(jnp.float32)) / GLA_TAU
    o = gla(q.reshape(B_, S_, GLA_HEADS, GLA_DK), k.reshape(B_, S_, GLA_HEADS, GLA_DK),
            v.reshape(B_, S_, GLA_HEADS, GLA_DV), lg.reshape(B_, S_, GLA_HEADS, GLA_DK))
    o = head_norm(o, gla_norm) * jax.nn.silu(r.astype(jnp.float32))
    return o.astype(x.dtype) @ w_out


def moe(x, router_w, router_b, w_gu, b_gu, w_down, b_down):
    B_, S_, D_ = x.shape
    xt = x.reshape(-1, D_)
    T = xt.shape[0]
    logits = (xt @ router_w + router_b).astype(jnp.float32)
    top_v, top_e = lax.top_k(logits, TOP_K)
    gate = jax.nn.softmax(top_v, axis=-1)
    flat_e = top_e.reshape(-1)
    order = jnp.argsort(flat_e)
    e_sorted = flat_e[order]
    tok = order // TOP_K
    sizes = jnp.bincount(flat_e, length=N_EXPERTS).astype(jnp.int32)
    xs = xt[tok]
    h = lax.ragged_dot(xs, w_gu, sizes) + b_gu[e_sorted]
    glu = jnp.minimum(h[:, 0::2], SWIGLU_LIMIT)
    lin = jnp.clip(h[:, 1::2], -SWIGLU_LIMIT, SWIGLU_LIMIT)
    act = glu * jax.nn.sigmoid(SWIGLU_ALPHA * glu) * (lin + 1.0)
    y = lax.ragged_dot(act, w_down, sizes) + b_down[e_sorted]
    y = y * gate.reshape(-1)[order][:, None].astype(y.dtype)
    out = jax.ops.segment_sum(y, tok, num_segments=T)
    return out.reshape(B_, S_, D_)


def setup_inputs(seed: int = 0) -> dict:
    key = jax.random.key(seed)
    ks = jax.random.split(key, 26)
    f32 = jnp.float32
    nrm = lambda k, shape, s: jax.random.normal(k, shape, f32) * s
    return {
        "x": nrm(ks[0], (BATCH, SEQ, D_MODEL), 1.0),
        "even_w_in": nrm(ks[1], (N_EVEN, D_MODEL, EVEN_IN), D_MODEL ** -0.5),
        "pool_w": nrm(ks[2], (N_EVEN, len(POOL_WINDOWS), POOL_GROUP, POOL_GROUP), POOL_GROUP ** -0.5),
        "pool_scale": 1.0 + nrm(ks[3], (N_EVEN, POOL_WIDTH), 0.1),
        "conv_w": nrm(ks[4], (N_EVEN, CONV_K, 2 * ML_QK), CONV_K ** -0.5),
        "conv_b": nrm(ks[5], (N_EVEN, 2 * ML_QK), 0.02),
        "i_bias": nrm(ks[6], (N_EVEN, ML_HEADS), 0.1),
        "f_bias": jnp.linspace(3.0, 6.0, ML_HEADS, dtype=f32)[None, :] + nrm(ks[7], (N_EVEN, ML_HEADS), 0.1),
        "ml_norm": 1.0 + nrm(ks[8], (N_EVEN, ML_WIDTH), 0.02),
        "even_w_out": nrm(ks[9], (N_EVEN, EVEN_MIX, D_MODEL), BETA * EVEN_MIX ** -0.5),
        "odd_w_in": nrm(ks[10], (N_ODD, D_MODEL, ODD_IN), D_MODEL ** -0.5),
        "gla_w2": nrm(ks[11], (N_ODD, GLA_RANK, GLA_QK), GLA_RANK ** -0.5),
        "gla_b": nrm(ks[12], (N_ODD, GLA_QK), 0.1),
        "gla_norm": 1.0 + nrm(ks[13], (N_ODD, GLA_V), 0.02),
        "odd_w_out": nrm(ks[14], (N_ODD, GLA_V, D_MODEL), BETA * GLA_V ** -0.5),
        "ln1_g": 1.0 + nrm(ks[15], (DEPTH, D_MODEL), 0.02),
        "ln1_b": nrm(ks[16], (DEPTH, D_MODEL), 0.02),
        "ln2_g": 1.0 + nrm(ks[17], (DEPTH, D_MODEL), 0.02),
        "ln2_b": nrm(ks[18], (DEPTH, D_MODEL), 0.02),
        "router_w": nrm(ks[19], (DEPTH, D_MODEL, N_EXPERTS), D_MODEL ** -0.5),
        "router_b": nrm(ks[20], (DEPTH, N_EXPERTS), 0.01),
        "w_gate_up": nrm(ks[21], (DEPTH, N_EXPERTS, D_MODEL, 2 * D_EXPERT), D_MODEL ** -0.5),
        "b_gate_up": nrm(ks[22], (DEPTH, N_EXPERTS, 2 * D_EXPERT), 0.01),
        "w_down": nrm(ks[23], (DEPTH, N_EXPERTS, D_EXPERT, D_MODEL), BETA * D_EXPERT ** -0.5),
        "b_down": nrm(ks[24], (DEPTH, N_EXPERTS, D_MODEL), 0.01),
    }


def reference(x, even_w_in, pool_w, pool_scale, conv_w, conv_b, i_bias, f_bias, ml_norm,
              even_w_out, odd_w_in, gla_w2, gla_b, gla_norm, odd_w_out,
              ln1_g, ln1_b, ln2_g, ln2_b, router_w, router_b,
              w_gate_up, b_gate_up, w_down, b_down):
    for layer in range(DEPTH):
        i = layer // 2
        if layer % 2 == 0:
            mix = even_mixer(x, even_w_in[i], pool_w[i], pool_scale[i], conv_w[i], conv_b[i],
                             i_bias[i], f_bias[i], ml_norm[i], even_w_out[i])
        else:
            mix = odd_mixer(x, odd_w_in[i], gla_w2[i], gla_b[i], gla_norm[i], odd_w_out[i])
        x = layer_norm(ALPHA * x + mix, ln1_g[layer], ln1_b[layer])
        ffn = moe(x, router_w[layer], router_b[layer], w_gate_up[layer], b_gate_up[layer],
                  w_down[layer], b_down[layer])
        x = layer_norm(ALPHA * x + ffn, ln2_g[layer], ln2_b[layer])
    return x
```

```cpp
#include <hip/hip_runtime.h>
#include <cstdio>
#include <cstdint>
namespace pg8 {
#define PG8_LAS __attribute__((address_space(3)))
typedef unsigned short bf16_t;
typedef short bf16x8 __attribute__((ext_vector_type(8)));
typedef float f32x4 __attribute__((ext_vector_type(4)));
typedef unsigned u32x4 __attribute__((ext_vector_type(4)));
constexpr int BM = 256, BK = 64, HALF = 128, HTB = HALF * BK * 2  , STAGE_BYTES = 8 * HTB, NXCD = 8, WGM = 8;

__host__ __device__ __forceinline__ int lds_byte(int r, int c) { const int st = (r >> 4) * 2 + (c >> 5), rr = r & 15, cc = c & 31, ob = rr * 64 + cc * 2; return st * 1024 + (ob ^ (((ob >> 9) & 1) << 5)); }
__host__ __device__ __forceinline__ void stage_rc(int b, int& R, int& C) { const int st = b / 1024, sb = b % 1024, swz = sb ^ (((sb >> 9) & 1) << 5); R = (st >> 1) * 16 + swz / 64; C = (st & 1) * 32 + (swz % 64) / 2; }
__host__ __device__ __forceinline__ int perm32(int rho) { const int n = rho >> 4, i = rho & 15; return 8 * (i >> 2) + 4 * n + (i & 3); }

struct Unit { int pm, pn, aidx, nval, slot; };
struct Gemm { const bf16_t* A; const bf16_t* Bt; int M, N, K; };

struct StaticOrder {
    int nM, nN, nwg, G, c;
    __host__ __device__ void init(int M, int N, int G_, int c_) { nM = M / BM; nN = N / BM; nwg = nM * nN; G = G_; c = c_; }
    __host__ __device__ bool next(int i, Unit& u) const {
        const long L = (long)i * G + c; if (L >= nwg) return false;
        int wgid = (int)L; { const int q = nwg / NXCD, r = nwg % NXCD, xcd = wgid % NXCD, off = wgid / NXCD; wgid = (xcd < r ? xcd * (q + 1) : r * (q + 1) + (xcd - r) * q) + off; }
        const int nig = WGM * nN, gid = wgid / nig, fm = gid * WGM, gsz = (nM - fm) < WGM ? (nM - fm) : WGM;
        u.pm = fm + ((wgid % nig) % gsz); u.pn = (wgid % nig) / gsz; return true;
    }
    __device__ __forceinline__ void a_ready(const Unit&) const {}
    __device__ __forceinline__ void done(const Unit&) const {}
};

typedef float f32x2c_t __attribute__((ext_vector_type(2))); typedef __bf16 bf16x2c_t __attribute__((ext_vector_type(2)));
__device__ __forceinline__ unsigned cvt_pk_bf16(float lo, float hi) { f32x2c_t v = {lo, hi}; bf16x2c_t b = __builtin_convertvector(v, bf16x2c_t); return __builtin_bit_cast(unsigned, b); }
typedef float f32x2 __attribute__((ext_vector_type(2)));

struct EpiStoreBf16 {
    static constexpr bool PERM = true, AFTER_DRAIN = false;
    bf16_t* O; int ldc; const float* scale; int col_off;
    __device__ __forceinline__ void operator()(const f32x4 (&acc)[2][2][4][2], const Unit& u, int wr, int wc, int fr, int fq) const {
        const int row0 = u.pm * BM + wr * 64 + fr, col0 = u.pn * BM + wc * 32 + 8 * fq;
        f32x4 sv[2][2];
#pragma unroll
        for (int bj = 0; bj < 2; ++bj)
#pragma unroll
            for (int n = 0; n < 2; ++n) sv[bj][n] = scale ? *(const f32x4*)(scale + col0 + bj * HALF + 4 * n) : (f32x4){1.f, 1.f, 1.f, 1.f};
#pragma unroll
        for (int ai = 0; ai < 2; ++ai)
#pragma unroll
            for (int m = 0; m < 4; ++m) { bf16_t* rowp = O + (size_t)(row0 + ai * HALF + m * 16) * ldc + col_off + col0;
#pragma unroll
                for (int bj = 0; bj < 2; ++bj) { const f32x4 v0 = acc[ai][bj][m][0] * sv[bj][0], v1 = acc[ai][bj][m][1] * sv[bj][1];
                    u32x4 w; w.x = cvt_pk_bf16(v0[0], v0[1]); w.y = cvt_pk_bf16(v0[2], v0[3]); w.z = cvt_pk_bf16(v1[0], v1[1]); w.w = cvt_pk_bf16(v1[2], v1[3]);
                    *(u32x4*)(rowp + bj * HALF) = w; } }
    }
};
struct EpiResBf16 {
    static constexpr bool PERM = true, AFTER_DRAIN = false;
    const bf16_t* X; bf16_t* O; int ldc; float alpha;
    __device__ __forceinline__ void operator()(const f32x4 (&acc)[2][2][4][2], const Unit& u, int wr, int wc, int fr, int fq) const {
        const int row0 = u.pm * BM + wr * 64 + fr, col0 = u.pn * BM + wc * 32 + 8 * fq;
        u32x4 xr[2][4][2];
#pragma unroll
        for (int ai = 0; ai < 2; ++ai)
#pragma unroll
            for (int m = 0; m < 4; ++m)
#pragma unroll
                for (int bj = 0; bj < 2; ++bj) xr[ai][m][bj] = *(const u32x4*)(X + (size_t)(row0 + ai * HALF + m * 16) * ldc + col0 + bj * HALF);
#pragma unroll
        for (int ai = 0; ai < 2; ++ai)
#pragma unroll
            for (int m = 0; m < 4; ++m) { const size_t off = (size_t)(row0 + ai * HALF + m * 16) * ldc + col0;
#pragma unroll
                for (int bj = 0; bj < 2; ++bj) { const u32x4 xx = xr[ai][m][bj];
                    const f32x4 x0 = {__builtin_bit_cast(float, xx.x << 16), __builtin_bit_cast(float, xx.x & 0xffff0000u), __builtin_bit_cast(float, xx.y << 16), __builtin_bit_cast(float, xx.y & 0xffff0000u)};
                    const f32x4 x1 = {__builtin_bit_cast(float, xx.z << 16), __builtin_bit_cast(float, xx.z & 0xffff0000u), __builtin_bit_cast(float, xx.w << 16), __builtin_bit_cast(float, xx.w & 0xffff0000u)};
                    const f32x4 v0 = x0 * alpha + acc[ai][bj][m][0], v1 = x1 * alpha + acc[ai][bj][m][1];
                    u32x4 w; w.x = cvt_pk_bf16(v0[0], v0[1]); w.y = cvt_pk_bf16(v0[2], v0[3]); w.z = cvt_pk_bf16(v1[0], v1[1]); w.w = cvt_pk_bf16(v1[2], v1[3]);
                    *(u32x4*)(O + off + bj * HALF) = w; } }
    }
};
__device__ __forceinline__ f32x2 swiglu2(f32x4 h) {
    f32x2 g = {fminf(h[0], 7.0f), fminf(h[2], 7.0f)}, l = {fminf(fmaxf(h[1], -7.0f), 7.0f), fminf(fmaxf(h[3], -7.0f), 7.0f)};
    const f32x2 t = g * (-2.4554669595930156f);
    f32x2 e2; e2.x = __builtin_amdgcn_exp2f(t.x); e2.y = __builtin_amdgcn_exp2f(t.y);
    const f32x2 d = e2 + 1.0f;
    f32x2 r; r.x = __builtin_amdgcn_rcpf(d.x); r.y = __builtin_amdgcn_rcpf(d.y);
    return (g * r) * (l + 1.0f);
}
__device__ __forceinline__ unsigned pk4_fp8(float a, float b, float c, float d) { int v = __builtin_amdgcn_cvt_pk_fp8_f32(a, b, 0, false); v = __builtin_amdgcn_cvt_pk_fp8_f32(c, d, v, true); return (unsigned)v; }
struct EpiSwiglu {
    static constexpr bool PERM = true, AFTER_DRAIN = false;
    bf16_t* ACT; const float* bgu; int skip; unsigned char* ACT8; float ascale;
    __device__ __forceinline__ void operator()(const f32x4 (&acc)[2][2][4][2], const Unit& u, int wr, int wc, int fr, int fq) const {
        if (skip && u.pm >= 0) return;
        const int e = u.pn >> 3, pnl = u.pn & 7;
        const int row0 = u.pm * BM + wr * 64 + fr, hcol0 = pnl * BM + wc * 32 + 8 * fq;
        f32x4 bv[2][2];
#pragma unroll
        for (int bj = 0; bj < 2; ++bj)
#pragma unroll
            for (int n = 0; n < 2; ++n) bv[bj][n] = *(const f32x4*)(bgu + (size_t)e * 2048 + hcol0 + bj * HALF + 4 * n);
#pragma unroll
        for (int ai = 0; ai < 2; ++ai)
#pragma unroll
            for (int m = 0; m < 4; ++m) { bf16_t* rowp = ACT + (size_t)(row0 + ai * HALF + m * 16) * 1024 + (hcol0 >> 1);
#pragma unroll
                for (int bj = 0; bj < 2; ++bj) { const f32x4 v0 = acc[ai][bj][m][0] * ascale + bv[bj][0], v1 = acc[ai][bj][m][1] * ascale + bv[bj][1];
                    typedef unsigned u32x2v __attribute__((ext_vector_type(2)));
                    const f32x2 a0 = swiglu2(v0), a1 = swiglu2(v1);
                    if (ACT8) *(unsigned*)(ACT8 + (size_t)(row0 + ai * HALF + m * 16) * 1024 + (hcol0 >> 1) + bj * (HALF / 2)) = pk4_fp8(a0.x, a0.y, a1.x, a1.y);
                    else { u32x2v w; w.x = cvt_pk_bf16(a0.x, a0.y); w.y = cvt_pk_bf16(a1.x, a1.y); *(u32x2v*)(rowp + bj * (HALF / 2)) = w; } } }
    }
};
struct EpiDown {
    static constexpr bool PERM = true, AFTER_DRAIN = false;
    bf16_t* Y; const float* bdn; int skip; float ascale;
    __device__ __forceinline__ void operator()(const f32x4 (&acc)[2][2][4][2], const Unit& u, int wr, int wc, int fr, int fq) const {
        if (skip && u.pm >= 0) return;
        const int e = u.pn >> 2, pnl = u.pn & 3;
        const int row0 = u.pm * BM + wr * 64 + fr, col0 = pnl * BM + wc * 32 + 8 * fq;
        f32x4 bv[2][2];
#pragma unroll
        for (int bj = 0; bj < 2; ++bj)
#pragma unroll
            for (int n = 0; n < 2; ++n) bv[bj][n] = *(const f32x4*)(bdn + (size_t)e * 1024 + col0 + bj * HALF + 4 * n);
#pragma unroll
        for (int ai = 0; ai < 2; ++ai)
#pragma unroll
            for (int m = 0; m < 4; ++m) { bf16_t* rowp = Y + (size_t)(row0 + ai * HALF + m * 16) * 1024 + col0;
#pragma unroll
                for (int bj = 0; bj < 2; ++bj) { const f32x4 v0 = acc[ai][bj][m][0] * ascale + bv[bj][0], v1 = acc[ai][bj][m][1] * ascale + bv[bj][1];
                    u32x4 w; w.x = cvt_pk_bf16(v0[0], v0[1]); w.y = cvt_pk_bf16(v0[2], v0[3]); w.z = cvt_pk_bf16(v1[0], v1[1]); w.w = cvt_pk_bf16(v1[2], v1[3]);
                    *(u32x4*)(rowp + bj * HALF) = w; } }
    }
};
struct MoeOrder {
    int NT, G, c, total; const PG8_LAS int* tile_e; const PG8_LAS int* tbase; const PG8_LAS int* cnt; int force0, rev;
    __device__ __forceinline__ bool next(int i, Unit& u) const {
        const int L = i * G + c; if (L >= total) return false;
        const int pm0 = L / NT, pnl = L - pm0 * NT, pm = rev ? (total / NT - 1 - pm0) : pm0; const int e = __builtin_amdgcn_readfirstlane(tile_e[pm]);
        const int pml = pm - __builtin_amdgcn_readfirstlane(tbase[e]);
        u.pm = pm; u.pn = (force0 ? 0 : e) * NT + pnl; u.aidx = e * 16384 + pml * 256; u.nval = __builtin_amdgcn_readfirstlane(cnt[e]) - pml * 256; u.slot = i; return true;
    }
    __device__ __forceinline__ void a_ready(const Unit&) const {}
    __device__ __forceinline__ void done(const Unit&) const {}
};
template <class Epi, class Sched, bool ALIGN_EPI = false, bool SP2 = false, bool GATHER = false, bool FP8 = false>
__device__ __forceinline__ void gemm_phase(PG8_LAS unsigned char* lds, const Gemm g, const Sched& S, const Epi& E, const PG8_LAS int* gcache = nullptr) {
    int tid_ = threadIdx.x; asm volatile("" : "+v"(tid_));
    const int tid = tid_, wid = __builtin_amdgcn_readfirstlane(tid >> 6), lane = tid & 63, wr = wid >> 2, wc = wid & 3, fr = lane & 15, fq = lane >> 4;
    const int K = g.K, nt = K / BK;
    unsigned voffA[2], voffB[2]; int rA[2]; unsigned cA2[2];
#pragma unroll
    for (int i = 0; i < 2; ++i) { int R, C; stage_rc(tid * 16 + i * 8192, R, C); const int Rb = Epi::PERM ? ((R & ~31) + perm32(R & 31)) : R;
        voffA[i] = (unsigned)(R * K + C) * 2u; voffB[i] = (unsigned)(Rb * K + C) * 2u; rA[i] = R; cA2[i] = (unsigned)C * 2u; }
    const size_t kstep = (size_t)(BK * 2);
    const size_t hstep = (size_t)HALF * K * 2;
    const size_t tstep = 2 * hstep;
    const unsigned ldsw = (unsigned)wid * 1024u;
    const int aoff = lds_byte(wr * 64 + fr, fq * 8), boff = lds_byte(wc * 32 + fr, fq * 8);
#define PG8_SA(b, h) (((b) * 2 + (h)) * HTB)
#define PG8_SB(b, h) ((4 + (b) * 2 + (h)) * HTB)
#define PG8_STAGE(bufoff, gbase, voff) do { _Pragma("unroll") for (int _i = 0; _i < 2; ++_i) \
        __builtin_amdgcn_global_load_lds((const unsigned*)((const char*)(gbase) + (voff)[_i]), (PG8_LAS unsigned*)(lds + (bufoff) + ldsw + _i * 8192), 16, 0, 0); } while (0)
#define PG8_STAGE_A(bufoff, ubase, half, gsel_) do { if constexpr (GATHER) { PG8_STAGE(bufoff, ubase, (gsel_)[half]); } else { PG8_STAGE(bufoff, (ubase) + (half) * hstep, voffA); } } while (0)
#define PG8_GOFF(u_, dst_) do { _Pragma("unroll") for (int _h = 0; _h < 2; ++_h) _Pragma("unroll") for (int _i = 0; _i < 2; ++_i) { const int _r = 128 * _h + rA[_i]; \
        const int _tok = gcache[(u_).slot * 256 + _r]; (dst_)[_h][_i] = (unsigned)_tok * (unsigned)(K * 2) + cA2[_i]; } } while (0)
#define PG8_LDA(dst, b, h) do { _Pragma("unroll") for (int m = 0; m < 4; ++m) { const i32x4_ lo_ = *(const PG8_LAS i32x4_*)(lds + PG8_SA(b, h) + aoff + m * 2048), hi_ = *(const PG8_LAS i32x4_*)(lds + PG8_SA(b, h) + aoff + m * 2048 + 1024); \
        dst[m] = __builtin_shufflevector(lo_, hi_, 0, 1, 2, 3, 4, 5, 6, 7); } } while (0)
#define PG8_LDB(dst, b, h) do { _Pragma("unroll") for (int n = 0; n < 2; ++n) { const i32x4_ lo_ = *(const PG8_LAS i32x4_*)(lds + PG8_SB(b, h) + boff + n * 2048), hi_ = *(const PG8_LAS i32x4_*)(lds + PG8_SB(b, h) + boff + n * 2048 + 1024); \
        dst[n] = __builtin_shufflevector(lo_, hi_, 0, 1, 2, 3, 4, 5, 6, 7); } } while (0)
#define PG8_MMA(ai, bj, At, Bt) do { __builtin_amdgcn_s_setprio(1); \
        if constexpr (FP8) { _Pragma("unroll") for (int m = 0; m < 4; ++m) _Pragma("unroll") for (int n = 0; n < 2; ++n) \
                asm volatile("v_mfma_scale_f32_16x16x128_f8f6f4 %0, %1, %2, %0, %3, %3 op_sel_hi:[0,0,0]" : "+v"(acc[ai][bj][m][n]) : "v"(Bt[n]), "v"(At[m]), "v"(mxscale)); } \
        else { _Pragma("unroll") for (int m = 0; m < 4; ++m) _Pragma("unroll") for (int n = 0; n < 2; ++n) { \
                acc[ai][bj][m][n] = __builtin_amdgcn_mfma_f32_16x16x32_bf16(__builtin_bit_cast(bf16x8, __builtin_shufflevector(Bt[n], Bt[n], 0, 1, 2, 3)), __builtin_bit_cast(bf16x8, __builtin_shufflevector(At[m], At[m], 0, 1, 2, 3)), acc[ai][bj][m][n], 0, 0, 0); \
                acc[ai][bj][m][n] = __builtin_amdgcn_mfma_f32_16x16x32_bf16(__builtin_bit_cast(bf16x8, __builtin_shufflevector(Bt[n], Bt[n], 4, 5, 6, 7)), __builtin_bit_cast(bf16x8, __builtin_shufflevector(At[m], At[m], 4, 5, 6, 7)), acc[ai][bj][m][n], 0, 0, 0); } } \
        __builtin_amdgcn_s_setprio(0); } while (0)
#define PG8_WAIT_V(n) asm volatile("s_waitcnt vmcnt(" #n ")" ::: "memory")
#define PG8_WAIT_L(n) asm volatile("s_waitcnt lgkmcnt(" #n ")" ::: "memory")
#define PG8_BAR __builtin_amdgcn_s_barrier()
#define PG8_SCHED __builtin_amdgcn_sched_barrier(0)
    Unit cur, nxt; int ui = 0; int mxscale = 0x7F7F7F7F; asm volatile("" : "+v"(mxscale));
    if (!S.next(0, cur)) return;
    f32x4 acc[2][2][4][2];
#pragma unroll
    for (int a = 0; a < 2; ++a)
#pragma unroll
        for (int b = 0; b < 2; ++b)
#pragma unroll
            for (int m = 0; m < 4; ++m)
#pragma unroll
                for (int n = 0; n < 2; ++n) acc[a][b][m][n] = (f32x4){0.f, 0.f, 0.f, 0.f};
    typedef int i32x4_ __attribute__((ext_vector_type(4))); typedef int i32x8_ __attribute__((ext_vector_type(8)));
    i32x8_ At[4], B0[2], B1[2];
    const char* cA = (const char*)g.A + (GATHER ? (size_t)0 : (size_t)cur.pm * tstep); const char* cB = (const char*)g.Bt + (size_t)cur.pn * tstep;
    unsigned gofc[2][2] = {{0u, 0u}, {0u, 0u}}, gofn[2][2] = {{0u, 0u}, {0u, 0u}};
    if constexpr (GATHER) PG8_GOFF(cur, gofc);
    S.a_ready(cur);
    if constexpr (SP2) {
        PG8_STAGE(PG8_SB(0, 0), cB, voffB); PG8_STAGE(PG8_SB(0, 1), cB + hstep, voffB); PG8_STAGE_A(PG8_SA(0, 0), cA, 0, gofc); PG8_STAGE_A(PG8_SA(0, 1), cA, 1, gofc);
        if (wr == 1) PG8_BAR;
        PG8_WAIT_V(2); PG8_BAR;
        PG8_STAGE(PG8_SB(1, 0), cB + kstep, voffB); PG8_STAGE_A(PG8_SA(1, 0), cA + kstep, 0, gofc); PG8_STAGE(PG8_SB(1, 1), cB + hstep + kstep, voffB);
        PG8_WAIT_V(6); PG8_BAR;
    } else {
        PG8_STAGE(PG8_SB(0, 0), cB, voffB); PG8_STAGE_A(PG8_SA(0, 0), cA, 0, gofc); PG8_STAGE(PG8_SB(0, 1), cB + hstep, voffB); PG8_STAGE_A(PG8_SA(0, 1), cA, 1, gofc);
        if (wr == 1) PG8_BAR;
        PG8_WAIT_V(4); PG8_BAR;
        PG8_STAGE(PG8_SB(1, 0), cB + kstep, voffB); PG8_STAGE_A(PG8_SA(1, 0), cA + kstep, 0, gofc); PG8_STAGE(PG8_SB(1, 1), cB + hstep + kstep, voffB);
        PG8_WAIT_V(6); PG8_BAR;
    }
    for (;;) {
        const bool has_next = S.next(ui + 1, nxt);
        const char* nA = (has_next && !GATHER) ? (const char*)g.A + (size_t)nxt.pm * tstep : cA; const char* nB = has_next ? (const char*)g.Bt + (size_t)nxt.pn * tstep : cB;
        if constexpr (GATHER) { if (has_next) PG8_GOFF(nxt, gofn); else {
#pragma unroll
                for (int _h = 0; _h < 2; ++_h) { gofn[_h][0] = gofc[_h][0]; gofn[_h][1] = gofc[_h][1]; } } }
#pragma unroll 1
        for (int t = 0; t < nt; t += 2) {
            const bool last = (t == nt - 2);
            const char* a1 = cA + (size_t)(t + 1) * kstep;
            const char* a2 = last ? nA : cA + (size_t)(t + 2) * kstep; const char* b2 = last ? nB : cB + (size_t)(t + 2) * kstep;
            const char* a3 = a2 + kstep; const char* b3 = b2 + kstep;
            unsigned gsel[2][2];
#pragma unroll
            for (int _h = 0; _h < 2; ++_h) { gsel[_h][0] = last ? gofn[_h][0] : gofc[_h][0]; gsel[_h][1] = last ? gofn[_h][1] : gofc[_h][1]; }
            if (last && has_next) S.a_ready(nxt);
            if constexpr (SP2) {
            PG8_LDB(B0, 0, 0); PG8_LDB(B1, 0, 1); PG8_SCHED; PG8_LDA(At, 0, 0); PG8_STAGE_A(PG8_SA(1, 1), a1, 1, gofc);
            PG8_WAIT_V(8); PG8_WAIT_L(0); PG8_BAR; PG8_MMA(0, 0, At, B0); PG8_MMA(0, 1, At, B1); PG8_BAR; PG8_SCHED;
            PG8_LDA(At, 0, 1); PG8_STAGE(PG8_SB(0, 0), b2, voffB); PG8_STAGE(PG8_SB(0, 1), b2 + hstep, voffB); PG8_STAGE_A(PG8_SA(0, 0), a2, 0, gsel);
            PG8_WAIT_V(8); PG8_WAIT_L(0); PG8_BAR; PG8_MMA(1, 0, At, B0); PG8_MMA(1, 1, At, B1); PG8_BAR; PG8_SCHED;
            PG8_LDB(B0, 1, 0); PG8_LDB(B1, 1, 1); PG8_SCHED; PG8_LDA(At, 1, 0); PG8_STAGE_A(PG8_SA(0, 1), a2, 1, gsel);
            PG8_WAIT_V(8); PG8_WAIT_L(0); PG8_BAR; PG8_MMA(0, 0, At, B0); PG8_MMA(0, 1, At, B1); PG8_BAR; PG8_SCHED;
            PG8_LDA(At, 1, 1); PG8_STAGE(PG8_SB(1, 0), b3, voffB); PG8_STAGE(PG8_SB(1, 1), b3 + hstep, voffB); PG8_STAGE_A(PG8_SA(1, 0), a3, 0, gsel);
            PG8_WAIT_V(8); PG8_WAIT_L(0); PG8_BAR; PG8_MMA(1, 0, At, B0); PG8_MMA(1, 1, At, B1); PG8_BAR; PG8_SCHED;
            } else {
            PG8_LDB(B0, 0, 0); PG8_SCHED; PG8_LDA(At, 0, 0); PG8_STAGE_A(PG8_SA(1, 1), a1, 1, gofc);
            PG8_WAIT_L(8); PG8_BAR; PG8_WAIT_L(0); PG8_MMA(0, 0, At, B0); PG8_BAR; PG8_SCHED;
            PG8_LDB(B1, 0, 1); PG8_STAGE(PG8_SB(0, 0), b2, voffB);
            PG8_BAR; PG8_WAIT_L(0); PG8_MMA(0, 1, At, B1); PG8_BAR;
            PG8_LDA(At, 0, 1); PG8_STAGE_A(PG8_SA(0, 0), a2, 0, gsel);
            PG8_BAR; PG8_WAIT_L(0); PG8_MMA(1, 0, At, B0); PG8_BAR; PG8_SCHED;
            PG8_STAGE(PG8_SB(0, 1), b2 + hstep, voffB);
            PG8_WAIT_V(6); PG8_BAR; PG8_MMA(1, 1, At, B1); PG8_BAR;
            PG8_LDB(B0, 1, 0); PG8_SCHED; PG8_LDA(At, 1, 0); PG8_STAGE_A(PG8_SA(0, 1), a2, 1, gsel);
            PG8_WAIT_L(8); PG8_BAR; PG8_WAIT_L(0); PG8_MMA(0, 0, At, B0); PG8_BAR; PG8_SCHED;
            PG8_LDB(B1, 1, 1); PG8_STAGE(PG8_SB(1, 0), b3, voffB);
            PG8_BAR; PG8_WAIT_L(0); PG8_MMA(0, 1, At, B1); PG8_BAR;
            PG8_LDA(At, 1, 1); PG8_STAGE_A(PG8_SA(1, 0), a3, 0, gsel);
            PG8_BAR; PG8_WAIT_L(0); PG8_MMA(1, 0, At, B0); PG8_BAR; PG8_SCHED;
            PG8_STAGE(PG8_SB(1, 1), b3 + hstep, voffB);
            PG8_WAIT_V(6); PG8_BAR; PG8_MMA(1, 1, At, B1); PG8_BAR;
            }
        }
        if constexpr (FP8) asm volatile("s_nop 15\n\ts_nop 15" ::: "memory");
        if constexpr (ALIGN_EPI) { if (wr == 0) PG8_BAR; }
        if constexpr (!Epi::AFTER_DRAIN) { E(acc, cur, wr, wc, fr, fq); S.done(cur); }
        if (!has_next) break;
#pragma unroll
        for (int a = 0; a < 2; ++a)
#pragma unroll
            for (int b = 0; b < 2; ++b)
#pragma unroll
                for (int m = 0; m < 4; ++m)
#pragma unroll
                    for (int n = 0; n < 2; ++n) acc[a][b][m][n] = (f32x4){0.f, 0.f, 0.f, 0.f};
        cur = nxt; cA = nA; cB = nB; ++ui;
        if constexpr (GATHER) {
#pragma unroll
            for (int _h = 0; _h < 2; ++_h) { gofc[_h][0] = gofn[_h][0]; gofc[_h][1] = gofn[_h][1]; } }
        if constexpr (ALIGN_EPI) { if (wr == 1) PG8_BAR; }
    }
    PG8_WAIT_V(0);
    if constexpr (!ALIGN_EPI) { if (wr == 0) PG8_BAR; }
    PG8_BAR;
    if constexpr (Epi::AFTER_DRAIN) { E.fused(acc, cur, wr, wc, fr, fq, lds, wid, lane); S.done(cur); }
#undef PG8_SA
#undef PG8_SB
#undef PG8_STAGE
#undef PG8_STAGE_A
#undef PG8_GOFF
#undef PG8_LDA
#undef PG8_LDB
#undef PG8_MMA
#undef PG8_WAIT_V
#undef PG8_WAIT_L
#undef PG8_BAR
#undef PG8_SCHED
}
}

constexpr int NWAVES = 8, NTHR = 512;
constexpr int SEQ = 4096, D = 1024, M = 16384, DEPTH = 4;
constexpr int EVEN_IN = 2568, ODD_IN = 3088, NE_P = 2560, NO_P = 3072, LDP = 3072;
constexpr int NEXP = 32, MAXROWS = 65536 + 32 * 256;
constexpr float ALPHA = 1.6817928305074290f, LN_EPS = 1e-5f;
constexpr int NPH = 12, NPHASES = 1 + DEPTH * NPH;
#ifndef PROBE_DUP
#define PROBE_DUP 0
#endif
#ifndef MOE_FP8_DOWN
#define MOE_FP8_DOWN 1
#endif
#ifndef MOE_FP8_GU
#define MOE_FP8_GU 1
#endif
constexpr float WDN_SCALE = 128.0f, WGU_SCALE = 64.0f;
#ifndef IDLE_Q
#define IDLE_Q 0
#endif
#ifndef MK_SPLIT
#define MK_SPLIT 0
#endif

constexpr size_t MiB = 1u << 20;
constexpr size_t WS_CTL = 0, CTL_ZERO_BYTES = 1 * MiB;
constexpr size_t WS_WINE = 1 * MiB, WS_WINO = 11 * MiB, WS_WOUT = 23 * MiB, WS_WP = 31 * MiB, WS_WGU = 32 * MiB, WS_WDN = 544 * MiB;
constexpr size_t WS_X = 800 * MiB, WS_XB = 864 * MiB, WS_X1 = 896 * MiB, WS_X1B = 960 * MiB, WS_PRE = 992 * MiB, WS_P = 1056 * MiB, WS_MIX = 1152 * MiB;
constexpr size_t WS_QK = 1184 * MiB, WS_DD = 1216 * MiB, WS_GATES = 1232 * MiB, WS_H = 1234 * MiB, WS_TOKE = 1298 * MiB, WS_TOKPOS = WS_TOKE + 256 * 1024, WS_GATE = WS_TOKE + 512 * 1024, WS_SLOT = WS_TOKE + 768 * 1024;
constexpr size_t WS_XS = 1300 * MiB, WS_ACT = 1444 * MiB, WS_Y = 1588 * MiB, WS_END = 1876 * MiB;
constexpr size_t WS_X1F8 = WS_XS;
constexpr size_t WS_ACT8 = WS_ACT;
constexpr int CW_TMO = 0, CW_BAR = 4096, CW_CNT = 16384;

constexpr int RING_OFF = 0, RING_BYTES = 131072;
constexpr int MISC_OFF = RING_BYTES;
constexpr int GCACHE_OFF = RING_BYTES + 8192, GCACHE_SLOTS = 16;
constexpr int LDS_BYTES = GCACHE_OFF + GCACHE_SLOTS * 1024;
constexpr int MW_CNT = 16, MW_ROWBASE = 48, MW_TILEE = 96, MW_NTILES = 400, MW_LCNT = 416, MW_WBASE = 448, MW_PICK = 512, MW_TBASE = 1600;
constexpr size_t WS_LIST = WS_H + 2 * MiB;

#define GAS __attribute__((address_space(1)))
#define LAS __attribute__((address_space(3)))
typedef unsigned short bf16;
typedef unsigned v4u __attribute__((ext_vector_type(4)));
typedef unsigned v2u __attribute__((ext_vector_type(2)));
typedef float f32x4 __attribute__((ext_vector_type(4)));
typedef GAS unsigned gu32;
#define RLX_AGENT __ATOMIC_RELAXED, __HIP_MEMORY_SCOPE_AGENT
#define LDS_WAIT() asm volatile("s_waitcnt lgkmcnt(0)" ::: "memory")
#define VM_WAIT() asm volatile("s_waitcnt vmcnt(0)" ::: "memory")
typedef float f32x2_t __attribute__((ext_vector_type(2))); typedef __bf16 bf16x2_t __attribute__((ext_vector_type(2)));
__device__ __forceinline__ unsigned pk2(float lo, float hi) { f32x2_t v = {lo, hi}; bf16x2_t b = __builtin_convertvector(v, bf16x2_t); return __builtin_bit_cast(unsigned, b); }
__device__ __forceinline__ unsigned f2bf(float f) { return pk2(f, f) & 0xffffu; }
__device__ __forceinline__ float bf2f(unsigned short b) { return __builtin_bit_cast(float, (unsigned)b << 16); }
__device__ __forceinline__ float bflo(unsigned w) { return __builtin_bit_cast(float, w << 16); }
__device__ __forceinline__ float bfhi(unsigned w) { return __builtin_bit_cast(float, w & 0xffff0000u); }
__device__ __forceinline__ float sigmoidf_(float x) { return __builtin_amdgcn_rcpf(1.0f + __expf(-x)); }
__device__ __forceinline__ float logsigmoidf_(float x) { return fminf(x, 0.f) - __logf(1.0f + __expf(-fabsf(x))); }

#define XB_TMO      128
#define XB_XCNT(j)  (256  + 64 * (j))
#define XB_XSUB(j)  (1280 + 64 * (j))
#define XB_XGEN(j)  (2304 + 64 * (j))
#define XB_TOP      3328
#define XB_TOPGEN   3392
#define XCD_BAR_WORDS 3456
#define XB_SPIN_CAP (1u << 18)

__device__ __forceinline__ unsigned xb_ld(unsigned* p)              { return __hip_atomic_load(p, __ATOMIC_RELAXED, __HIP_MEMORY_SCOPE_AGENT); }
__device__ __forceinline__ unsigned xb_add(unsigned* p, unsigned v) { return __hip_atomic_fetch_add(p, v, __ATOMIC_RELAXED, __HIP_MEMORY_SCOPE_AGENT); }
__device__ __forceinline__ unsigned xb_xcc_id() { return (unsigned)__builtin_amdgcn_s_getreg((3 << 11) | 20) & 0xFu; }
#define XB_SPIN(cond, bar) do { unsigned _sp = 0; while (cond) { __builtin_amdgcn_s_sleep(1); \
    if ((++_sp & 255u) == 0u) { if (xb_ld(&(bar)[XB_TMO])) break; if (_sp > XB_SPIN_CAP) { atomicAdd(&(bar)[XB_TMO], 1u); break; } } } } while (0)

struct XcdBarrier {
    unsigned* bar; unsigned x;
    volatile LAS unsigned* st;
};

__device__ __forceinline__ XcdBarrier xcd_barrier_post(unsigned* bar, volatile LAS unsigned* st) {
    XcdBarrier b; b.bar = bar; b.x = xb_xcc_id(); b.st = st;
    if (threadIdx.x == 0) (void)xb_add(&bar[XB_XCNT(b.x)], 1u);
    return b;
}
__device__ __forceinline__ void xcd_barrier_complete(unsigned* bar, unsigned x, unsigned& nloc, unsigned& nx) {
    const unsigned G = gridDim.x * gridDim.y * gridDim.z;
    unsigned sum, cnt, mine, sp = 0u;
    for (;;) {
        sum = 0u; cnt = 0u; mine = 0u;
#pragma unroll
        for (unsigned j = 0; j < 16; ++j) { const unsigned c = xb_ld(&bar[XB_XCNT(j)]); sum += c; cnt += (c > 0u) ? 1u : 0u; mine = (j == x) ? c : mine; }
        if (sum == G) break;
        __builtin_amdgcn_s_sleep(1);
        if ((++sp & 255u) == 0u) { if (xb_ld(&bar[XB_TMO])) break; if (sp > XB_SPIN_CAP) { atomicAdd(&bar[XB_TMO], 1u); break; } }
    }
    nloc = mine > 0u ? mine : 1u; nx = cnt > 0u ? cnt : 1u;
}

__device__ __forceinline__ void xcd_barrier(const XcdBarrier& b) {
    asm volatile("s_waitcnt vmcnt(0)" ::: "memory");
    __syncthreads();
    if (threadIdx.x == 0) {
        unsigned* bar = b.bar;
        __builtin_amdgcn_s_waitcnt(0);
        unsigned nloc = b.st[0], nx = b.st[1];
        if (nloc == 0u) { xcd_barrier_complete(bar, b.x, nloc, nx); b.st[0] = nloc; b.st[1] = nx; }
        const unsigned old = xb_add(&bar[XB_XSUB(b.x)], 1u);
        const unsigned gen = old / nloc;
        if (old + 1u == (gen + 1u) * nloc) {
            __builtin_amdgcn_fence(__ATOMIC_RELEASE, "agent");
            asm volatile("s_waitcnt vmcnt(0)" ::: "memory");
            const unsigned og = xb_add(&bar[XB_TOP], 1u);
            const unsigned tg = og / nx;
            if (og + 1u == (tg + 1u) * nx) xb_add(&bar[XB_TOPGEN], 1u);
            else XB_SPIN(xb_ld(&bar[XB_TOPGEN]) == tg, bar);
            __builtin_amdgcn_fence(__ATOMIC_ACQUIRE, "agent");
            xb_add(&bar[XB_XGEN(b.x)], 1u);
            asm volatile("s_waitcnt vmcnt(0)" ::: "memory");
        } else {
            XB_SPIN(xb_ld(&bar[XB_XGEN(b.x)]) == gen, bar);
            __builtin_amdgcn_fence(__ATOMIC_ACQUIRE, "agent");
            asm volatile("s_waitcnt vmcnt(0)" ::: "memory");
        }
    }
    __syncthreads();
}


typedef short s16x4 __attribute__((ext_vector_type(4)));
__device__ __forceinline__ pg8::bf16x8 tr8(const LAS unsigned char* p, int pitchB) {
    const s16x4 lo = __builtin_amdgcn_ds_read_tr16_b64_v4i16((LAS s16x4*)p);
    const s16x4 hi = __builtin_amdgcn_ds_read_tr16_b64_v4i16((LAS s16x4*)(p + 4 * pitchB));
    return __builtin_shufflevector(lo, hi, 0, 1, 2, 3, 4, 5, 6, 7);
}
struct Args { const float* in[25]; float* out; unsigned char* ws; int ph_lo, ph_hi; };
struct Frame {
    LAS unsigned char* lds;
    volatile LAS unsigned* MISC;
    gu32* ctl;
    int tid, lane, wave, vcu, G;
    float* out; unsigned char* ws;
};
__device__ __forceinline__ float dpp_add(float v, const int ctrl_sel) {
    const int x = __builtin_bit_cast(int, v); int y;
    if (ctrl_sel == 0) y = __builtin_amdgcn_update_dpp(x, x, 0xB1, 0xF, 0xF, false);
    else if (ctrl_sel == 1) y = __builtin_amdgcn_update_dpp(x, x, 0x4E, 0xF, 0xF, false);
    else if (ctrl_sel == 2) y = __builtin_amdgcn_update_dpp(x, x, 0x124, 0xF, 0xF, false);
    else y = __builtin_amdgcn_update_dpp(x, x, 0x128, 0xF, 0xF, false);
    return v + __builtin_bit_cast(float, y);
}
__device__ __forceinline__ float wave_sum(float v) {
    v = dpp_add(v, 0); v = dpp_add(v, 1); v = dpp_add(v, 2); v = dpp_add(v, 3);
    v += __shfl_xor(v, 16); v += __shfl_xor(v, 32);
    return v;
}
struct P0Tile { const float* src; size_t ldw; bf16* dst; size_t ldd; int fp8; };
constexpr int P0_PB = 528;
__device__ __forceinline__ P0Tile p0_tile(Frame& F, const Args& A, int t) {
    bf16* wine = (bf16*)(F.ws + WS_WINE); bf16* wino = (bf16*)(F.ws + WS_WINO); bf16* wout = (bf16*)(F.ws + WS_WOUT); bf16* wgu = (bf16*)(F.ws + WS_WGU); bf16* wdn = (bf16*)(F.ws + WS_WDN);
    constexpr int T_GU = 8 * 8, T_DN = 8 * 4, T_WE = 8 * 10, T_WO = 8 * 12, T_OUT = 8 * 4;
    constexpr int N_GU = 128 * T_GU, N_DN = 128 * T_DN, N_WE = 2 * T_WE, N_WO = 2 * T_WO;
    P0Tile o; int r = t, kt, nt; o.fp8 = 0;
    if (r < N_GU) { const int mtx = r / T_GU, q = r % T_GU; kt = q / 8; nt = q % 8; o.src = A.in[21] + (size_t)mtx * 1024 * 2048; o.ldw = 2048; o.dst = MOE_FP8_GU ? (bf16*)((unsigned char*)wgu + (size_t)mtx * 2048 * 1024) : wgu + (size_t)mtx * 2048 * 1024; o.fp8 = MOE_FP8_GU ? 2 : 0; }
    else if ((r -= N_GU) < N_DN) { const int mtx = r / T_DN, q = r % T_DN; kt = q / 4; nt = q % 4; o.src = A.in[23] + (size_t)mtx * 1024 * 1024; o.ldw = 1024; o.dst = MOE_FP8_DOWN ? (bf16*)((unsigned char*)wdn + (size_t)mtx * 1024 * 1024) : wdn + (size_t)mtx * 1024 * 1024; o.fp8 = MOE_FP8_DOWN; }
    else if ((r -= N_DN) < N_WE) { const int mtx = r / T_WE, q = r % T_WE; kt = q / 10; nt = q % 10; o.src = A.in[1] + (size_t)mtx * 1024 * EVEN_IN; o.ldw = EVEN_IN; o.dst = wine + (size_t)mtx * NE_P * 1024; }
    else if ((r -= N_WE) < N_WO) { const int mtx = r / T_WO, q = r % T_WO; kt = q / 12; nt = q % 12; o.src = A.in[10] + (size_t)mtx * 1024 * ODD_IN; o.ldw = ODD_IN; o.dst = wino + (size_t)mtx * NO_P * 1024; }
    else { r -= N_WO; const int l = r / T_OUT, q = r % T_OUT; kt = q / 4; nt = q % 4; o.src = ((l & 1) ? A.in[14] : A.in[9]) + (size_t)(l >> 1) * 1024 * 1024; o.ldw = 1024; o.dst = wout + (size_t)l * 1024 * 1024; }
    o.ldd = 1024; o.src += (size_t)(128 * kt) * o.ldw + 256 * nt;
    if (o.fp8) o.dst = (bf16*)((unsigned char*)o.dst + (size_t)(256 * nt) * 1024 + 128 * kt); else o.dst += (size_t)(256 * nt) * o.ldd + 128 * kt;
    return o;
}
__device__ __forceinline__ void p0_tile_load(const P0Tile& t, int wave, int lane, f32x4 (&v)[16]) {
#pragma unroll
    for (int i = 0; i < 16; ++i) v[i] = __builtin_nontemporal_load((const GAS f32x4*)(t.src + (size_t)(16 * wave + i) * t.ldw + 4 * lane));
}
__device__ __forceinline__ int p0_map(int layer, int j) { return layer < 0 ? j : (j < 1024 ? 8192 + layer * 1024 + j : layer * 2048 + (j - 1024)); }
__device__ __forceinline__ void p0_convert(Frame& F, const Args& A, int layer, int j0, int jstep, int jend) {
    LAS unsigned char* img = F.lds + RING_OFF;
    const int lane = F.lane, w = F.wave, g = lane >> 4, q = (lane & 15) >> 2, p = lane & 3, l15 = lane & 15;
    f32x4 v[16];
    int j = j0;
    if (j < jend) { const P0Tile cur = p0_tile(F, A, p0_map(layer, j)); p0_tile_load(cur, w, lane, v); }
    for (; j < jend; j += jstep) {
        const P0Tile cur = p0_tile(F, A, p0_map(layer, j));
#pragma unroll
        for (int i = 0; i < 16; ++i) { v2u o; o.x = pk2(v[i].x, v[i].y); o.y = pk2(v[i].z, v[i].w); *(LAS v2u*)(img + (16 * w + i) * P0_PB + lane * 8) = o; }
        __syncthreads();
        if (j + jstep < jend) { const P0Tile nx = p0_tile(F, A, p0_map(layer, j + jstep)); p0_tile_load(nx, w, lane, v); }
        if (cur.fp8) {
            const float sc_ = (cur.fp8 == 2) ? WGU_SCALE : WDN_SCALE;
#pragma unroll
            for (int kh = 0; kh < 2; ++kh)
#pragma unroll
                for (int c = 0; c < 2; ++c) {
                    const v4u f0 = __builtin_bit_cast(v4u, tr8(img + (64 * kh + 16 * g + q) * P0_PB + (32 * w + 16 * c + 4 * p) * 2, P0_PB));
                    const v4u f1 = __builtin_bit_cast(v4u, tr8(img + (64 * kh + 16 * g + 8 + q) * P0_PB + (32 * w + 16 * c + 4 * p) * 2, P0_PB));
                    v4u o8;
                    o8.x = pg8::pk4_fp8(bflo(f0.x) * sc_, bfhi(f0.x) * sc_, bflo(f0.y) * sc_, bfhi(f0.y) * sc_); o8.y = pg8::pk4_fp8(bflo(f0.z) * sc_, bfhi(f0.z) * sc_, bflo(f0.w) * sc_, bfhi(f0.w) * sc_);
                    o8.z = pg8::pk4_fp8(bflo(f1.x) * sc_, bfhi(f1.x) * sc_, bflo(f1.y) * sc_, bfhi(f1.y) * sc_); o8.w = pg8::pk4_fp8(bflo(f1.z) * sc_, bfhi(f1.z) * sc_, bflo(f1.w) * sc_, bfhi(f1.w) * sc_);
                    *(GAS v4u*)((unsigned char*)cur.dst + (size_t)(32 * w + 16 * c + l15) * 1024 + 64 * kh + 16 * g) = o8;
                }
        } else {
#pragma unroll
            for (int kb = 0; kb < 4; ++kb)
#pragma unroll
                for (int c = 0; c < 2; ++c) {
                    const pg8::bf16x8 fr = tr8(img + (32 * kb + 8 * g + q) * P0_PB + (32 * w + 16 * c + 4 * p) * 2, P0_PB);
                    *(GAS pg8::bf16x8*)(cur.dst + (size_t)(32 * w + 16 * c + l15) * cur.ldd + 32 * kb + 8 * g) = fr;
                }
        }
        __syncthreads();
    }
}
__device__ __forceinline__ void p0_weights(Frame& F, const Args& A) {
    bf16* wp = (bf16*)(F.ws + WS_WP);
    p0_convert(F, A, -1, 12288 + F.vcu, F.G, 12768);
    for (int i = F.vcu * NTHR + F.tid; i < 2 * 4 * 128 * 128; i += F.G * NTHR) { const int mtx = i >> 14, d = (i >> 7) & 127, c = i & 127, li = mtx >> 2, gg = mtx & 3;
        wp[(size_t)li * 512 * 512 + (size_t)(gg * 128 + d) * 512 + gg * 128 + c] = (bf16)f2bf(A.in[2][(size_t)mtx * 16384 + c * 128 + d]); }
    for (int i = (F.vcu * NTHR + F.tid); i < 2 * 512 * 64; i += F.G * NTHR) {
        const int li = i / (512 * 64), rem = i % (512 * 64), row = rem / 64, ch = rem % 64;
        if ((row >> 7) != (ch >> 4)) *(GAS v4u*)(wp + (size_t)li * 512 * 512 + (size_t)row * 512 + ch * 8) = (v4u){0u, 0u, 0u, 0u};
    }
}

__device__ __forceinline__ void moe_tables(Frame& F, int layer) {
    if (F.tid < 64) {
        const int e = F.tid & 31;
        const unsigned n = __hip_atomic_load((unsigned*)(F.ctl + CW_CNT + (layer * 32 + e) * 64), RLX_AGENT), t = (n + 255u) >> 8;
        unsigned incl = t;
#pragma unroll
        for (int o = 1; o < 32; o <<= 1) { const unsigned up = __shfl_up(incl, o, 32); if (e >= o) incl += up; }
        const unsigned tb = incl - t;
        if (F.tid < 32) {
            F.MISC[MW_CNT + e] = n; F.MISC[MW_ROWBASE + e] = tb * 256u; F.MISC[MW_TBASE + e] = tb;
            for (unsigned k = 0; k < t; ++k) F.MISC[MW_TILEE + tb + k] = (unsigned)e;
            if (e == 31) { F.MISC[MW_ROWBASE + 32] = incl * 256u; F.MISC[MW_NTILES] = incl; }
        }
    }
    __syncthreads();
}
constexpr int XS_LD = 1028;
template <int MODE>
__device__ __forceinline__ void rw_phase(Frame& F, const Args& A, int layer) {
    LAS float* xs = (LAS float*)(F.lds + RING_OFF);
    LAS float* part = (LAS float*)(F.lds + RING_OFF + 16 * XS_LD * 4);
    const int lane = F.lane, w = F.wave, tid = F.tid;
    const float* pw = nullptr; size_t ldw = 0; int ncols = 0; const float* pbias = nullptr;
    if (MODE == 1) { pw = A.in[19] + (size_t)layer * 1024 * 32; ldw = 32; ncols = 32; pbias = A.in[20] + layer * 32; }
    else { const int nl = (MODE == 0) ? 0 : layer + 1;
        if (nl < DEPTH) { if (nl & 1) { pw = A.in[10] + (size_t)(nl >> 1) * 1024 * ODD_IN + NO_P; ldw = ODD_IN; ncols = 16; } else { pw = A.in[1] + (size_t)(nl >> 1) * 1024 * EVEN_IN + NE_P; ldw = EVEN_IN; ncols = 8; } } }
    const float* lg = nullptr; const float* lb = nullptr;
    if (MODE == 1) { lg = A.in[15] + layer * D; lb = A.in[16] + layer * D; }
    if (MODE == 2) { lg = A.in[17] + layer * D; lb = A.in[18] + layer * D; }
    bf16* XB = (bf16*)(F.ws + WS_XB); bf16* X1B = (bf16*)(F.ws + WS_X1B);
    const bf16* PRE = (const bf16*)(F.ws + WS_PRE); const bf16* Y = (const bf16*)(F.ws + WS_Y); float* GATES = (float*)(F.ws + WS_GATES);
    float* GATE = (float*)(F.ws + WS_GATE); int* SLOT = (int*)(F.ws + WS_SLOT); int* LIST = (int*)(F.ws + WS_LIST);
    if (MODE == 1) { if (tid < 32) F.MISC[MW_LCNT + tid] = 0u; __syncthreads(); }
    if (MODE == 2 && MK_SPLIT) moe_tables(F, layer);
    int srow = 0, gbits = 0;
    if (MODE == 2) { const int tl = F.vcu + (lane >> 3) * F.G;
        if (tl < M / 16) { const int tk = (tl * 16 + 2 * w + ((lane >> 2) & 1)) * 4 + (lane & 3); const int idx = SLOT[tk]; srow = (int)F.MISC[MW_TBASE + (idx >> 14)] * 256 + (idx & 16383); gbits = __builtin_bit_cast(int, GATE[tk]); } }
    f32x4 rx[2][4]; v2u xx[2][4], yy[2][4][4]; float gk[2][4];
#define RW_ISSUE(tile_, tc_) do { const int tok0_ = (tile_) * 16 + 2 * w; \
        if (MODE == 0) { _Pragma("unroll") for (int rr = 0; rr < 2; ++rr) { const GAS f32x4* xr = (const GAS f32x4*)(A.in[0] + (size_t)(tok0_ + rr) * D) + lane; _Pragma("unroll") for (int j = 0; j < 4; ++j) rx[rr][j] = xr[64 * j]; } } \
        else if (MODE == 1) { _Pragma("unroll") for (int rr = 0; rr < 2; ++rr) { const GAS v2u* xr = (const GAS v2u*)(PRE + (size_t)(tok0_ + rr) * D) + lane; _Pragma("unroll") for (int j = 0; j < 4; ++j) xx[rr][j] = xr[64 * j]; } } \
        else { _Pragma("unroll") for (int rr = 0; rr < 2; ++rr) _Pragma("unroll") for (int k = 0; k < 4; ++k) { const int li = (tc_) * 8 + rr * 4 + k; const int s = __builtin_amdgcn_readlane(srow, li); gk[rr][k] = __builtin_bit_cast(float, __builtin_amdgcn_readlane(gbits, li)); \
                    const GAS v2u* yr = (const GAS v2u*)(Y + (size_t)s * D) + lane; _Pragma("unroll") for (int j = 0; j < 4; ++j) yy[rr][k][j] = yr[64 * j]; } \
            _Pragma("unroll") for (int rr = 0; rr < 2; ++rr) { const GAS v2u* xr = (const GAS v2u*)(X1B + (size_t)(tok0_ + rr) * D) + lane; _Pragma("unroll") for (int j = 0; j < 4; ++j) xx[rr][j] = xr[64 * j]; } } } while (0)
    int tcount = 0;
    if (F.vcu < M / 16) RW_ISSUE(F.vcu, 0);
    float bw0[8][4], bw1[8][4];
    { const int kq = lane >> 4, c0 = lane & 15, c1 = 16 + (lane & 15);
#pragma unroll
        for (int st = 0; st < 8; ++st)
#pragma unroll
            for (int j = 0; j < 4; ++j) { const int k = 128 * w + 16 * st + 4 * kq + j;
                bw0[st][j] = (ncols > 0 && c0 < ncols) ? pw[(size_t)k * ldw + c0] : 0.f; bw1[st][j] = (MODE == 1 && ncols > 0 && c1 < ncols) ? pw[(size_t)k * ldw + c1] : 0.f; } }
    f32x4 lgv[4], lbv[4];
#pragma unroll
    for (int j = 0; j < 4; ++j) { lgv[j] = (MODE != 0) ? *((const GAS f32x4*)lg + lane + 64 * j) : (f32x4){1.f, 1.f, 1.f, 1.f}; lbv[j] = (MODE != 0) ? *((const GAS f32x4*)lb + lane + 64 * j) : (f32x4){0.f, 0.f, 0.f, 0.f}; }
    for (int tile = F.vcu; tile < M / 16; tile += F.G, ++tcount) {
        f32x4 vv[2][4];
#pragma unroll
        for (int rr = 0; rr < 2; ++rr)
#pragma unroll
            for (int j = 0; j < 4; ++j) {
                if (MODE == 0) vv[rr][j] = rx[rr][j];
                else { f32x4 a = (f32x4){bflo(xx[rr][j].x), bfhi(xx[rr][j].x), bflo(xx[rr][j].y), bfhi(xx[rr][j].y)};
                    if (MODE == 2) { a = a * ALPHA;
#pragma unroll
                        for (int k = 0; k < 4; ++k) { const v2u y2 = yy[rr][k][j]; const float g = gk[rr][k]; a.x += bflo(y2.x) * g; a.y += bfhi(y2.x) * g; a.z += bflo(y2.y) * g; a.w += bfhi(y2.y) * g; } }
                    vv[rr][j] = a; } }
        if (tile + F.G < M / 16) RW_ISSUE(tile + F.G, tcount + 1);
#pragma unroll
        for (int rr = 0; rr < 2; ++rr) {
            const int r = 2 * w + rr, tok = tile * 16 + r;
            f32x4 v[4];
#pragma unroll
            for (int j = 0; j < 4; ++j) v[j] = vv[rr][j];
            if (MODE != 0) {
                float s = 0.f;
#pragma unroll
                for (int j = 0; j < 4; ++j) s += (v[j].x + v[j].y) + (v[j].z + v[j].w);
                const float mean = wave_sum(s) * (1.f / D); float s2 = 0.f;
#pragma unroll
                for (int j = 0; j < 4; ++j) { v[j] = v[j] - mean; s2 += (v[j].x * v[j].x + v[j].y * v[j].y) + (v[j].z * v[j].z + v[j].w * v[j].w); }
                const float rstd = __builtin_amdgcn_rsqf(wave_sum(s2) * (1.f / D) + LN_EPS);
#pragma unroll
                for (int j = 0; j < 4; ++j) v[j] = v[j] * rstd * lgv[j] + lbv[j];
                if (MODE == 2 && layer == DEPTH - 1) { GAS f32x4* o4 = (GAS f32x4*)(F.out + (size_t)tok * D) + lane;
#pragma unroll
                    for (int j = 0; j < 4; ++j) o4[64 * j] = v[j]; }
            }
            bf16* bo = (MODE == 1) ? X1B : XB;
            GAS v2u* o8 = (GAS v2u*)(bo + (size_t)tok * D) + lane;
            if (!(MODE == 2 && layer == DEPTH - 1)) {
#pragma unroll
                for (int j = 0; j < 4; ++j) { v2u p; p.x = pk2(v[j].x, v[j].y); p.y = pk2(v[j].z, v[j].w); o8[64 * j] = p; } }
            if (MODE == 1 && MOE_FP8_GU) { GAS unsigned* o4 = (GAS unsigned*)(F.ws + WS_X1F8 + (size_t)tok * D) + lane;
#pragma unroll
                for (int j = 0; j < 4; ++j) o4[64 * j] = pg8::pk4_fp8(v[j].x, v[j].y, v[j].z, v[j].w); }
            if (ncols > 0) {
#pragma unroll
                for (int j = 0; j < 4; ++j) *(LAS f32x4*)(xs + r * XS_LD + 4 * lane + 256 * j) = v[j]; }
        }
        if (ncols > 0) __syncthreads();
        if (ncols > 0) {
            f32x4 acc0 = {0.f, 0.f, 0.f, 0.f}, acc1 = {0.f, 0.f, 0.f, 0.f};
            const int prow = lane & 15, kq = lane >> 4, c0 = lane & 15, c1 = 16 + (lane & 15);
#pragma unroll
            for (int st = 0; st < 8; ++st) {
                const int k0 = 128 * w + 16 * st + 4 * kq;
                const f32x4 a = *(const LAS f32x4*)(xs + prow * XS_LD + k0);
#pragma unroll
                for (int j = 0; j < 4; ++j) {
                    acc0 = __builtin_amdgcn_mfma_f32_16x16x4f32(a[j], bw0[st][j], acc0, 0, 0, 0);
                    if (MODE == 1) acc1 = __builtin_amdgcn_mfma_f32_16x16x4f32(a[j], bw1[st][j], acc1, 0, 0, 0);
                }
            }
#pragma unroll
            for (int g = 0; g < 4; ++g) { part[(w * 16 + kq * 4 + g) * 32 + c0] = acc0[g]; part[(w * 16 + kq * 4 + g) * 32 + c1] = acc1[g]; }
        }
        __syncthreads();
        if (ncols > 0) {
            const int r = tid >> 5, c = tid & 31, tok = tile * 16 + r;
            float val = 0.f;
#pragma unroll
            for (int ww = 0; ww < 8; ++ww) val += part[(ww * 16 + r) * 32 + c];
            if (MODE != 1) { if (c < ncols) GATES[tok * 16 + c] = val; }
            else {
                val += pbias[c];
                float cur = val; float selv[4]; int seli[4];
#pragma unroll
                for (int k = 0; k < 4; ++k) {
                    float bv = cur; int bi = c;
#pragma unroll
                    for (int off = 16; off >= 1; off >>= 1) { const float ov = __shfl_xor(bv, off); const int oi = __shfl_xor(bi, off); if (ov > bv || (ov == bv && oi < bi)) { bv = ov; bi = oi; } }
                    selv[k] = bv; seli[k] = bi; if (c == bi) cur = -3.0e38f;
                }
                if (c < 4) {
                    const float e0 = 1.f, e1 = __expf(selv[1] - selv[0]), e2 = __expf(selv[2] - selv[0]), e3 = __expf(selv[3] - selv[0]);
                    const float inv = __builtin_amdgcn_rcpf(e0 + e1 + e2 + e3);
                    const float ge = (c == 0) ? e0 : (c == 1) ? e1 : (c == 2) ? e2 : e3;
                    const int ee = (c == 0) ? seli[0] : (c == 1) ? seli[1] : (c == 2) ? seli[2] : seli[3];
                    GATE[tok * 4 + c] = ge * inv;
                    const unsigned rank = __hip_atomic_fetch_add((LAS unsigned*)(F.lds + MISC_OFF) + MW_LCNT + ee, 1u, __ATOMIC_RELAXED, __HIP_MEMORY_SCOPE_WORKGROUP);
                    F.MISC[MW_PICK + tcount * 64 + r * 4 + c] = (unsigned)ee | (rank << 8);
                }
            }
        }
        __syncthreads();
    }
    if (MODE == 1) {
        if (tid < 32) { const unsigned n = F.MISC[MW_LCNT + tid]; unsigned base = 0u; if (n) base = __hip_atomic_fetch_add((unsigned*)(F.ctl + CW_CNT + (layer * 32 + tid) * 64), n, RLX_AGENT); F.MISC[MW_WBASE + tid] = base; }
        __syncthreads();
        for (int i = tid; i < tcount * 64; i += NTHR) { const int tc = i >> 6, r = (i >> 2) & 15, k = i & 3; const int tok = (F.vcu + tc * F.G) * 16 + r;
            const unsigned pk = F.MISC[MW_PICK + i]; const int idx = (int)((pk & 0xffu) * 16384u + F.MISC[MW_WBASE + (pk & 0xffu)] + (pk >> 8)); SLOT[tok * 4 + k] = idx; LIST[idx] = tok; }
        __syncthreads();
    }
}

constexpr size_t WS_QW = WS_QK, WS_KW = WS_QK + 16 * MiB, WS_ST = WS_XS;
constexpr size_t WS_BT = WS_H, WS_CM = WS_H + 256 * 1024, WS_RMAX = WS_H + 512 * 1024, WS_GC = WS_H + 516 * 1024, WS_MPREV = WS_H + 520 * 1024, WS_EBL = WS_H + 1 * MiB;
constexpr int KP = 136;

__device__ __forceinline__ pg8::f32x4 mma16(pg8::bf16x8 a, pg8::bf16x8 b, pg8::f32x4 c) { return __builtin_amdgcn_mfma_f32_16x16x32_bf16(a, b, c, 0, 0, 0); }

__device__ __forceinline__ void even_prep2(Frame& F, const Args& A, int li) {
    const bf16* P = (const bf16*)(F.ws + WS_P); bf16* QW = (bf16*)(F.ws + WS_QW); bf16* KW = (bf16*)(F.ws + WS_KW); bf16* DD = (bf16*)(F.ws + WS_DD);
    const float* GATES = (const float*)(F.ws + WS_GATES);
    float* BT = (float*)(F.ws + WS_BT); float* CM = (float*)(F.ws + WS_CM); float* RMAX = (float*)(F.ws + WS_RMAX); float* GC = (float*)(F.ws + WS_GC);
    const float* cw = A.in[4] + (size_t)li * 4 * 1024; const float* cb = A.in[5] + (size_t)li * 1024;
    LAS float* gs = (LAS float*)(F.lds + RING_OFF); LAS float* ls = gs + 256; LAS float* rs = ls + 256; LAS float* fac = rs + 256;
    const int tid = F.tid;
    for (int unit = F.vcu; unit < 256; unit += F.G) {
        const int tok0 = (unit >> 6) * SEQ + (unit & 63) * 64;
        v4u rows[19];
        { const int ch = (tid & 127) * 8, tb = tok0 + 16 * (tid >> 7), s0 = tb & (SEQ - 1);
#pragma unroll
            for (int r = 0; r < 19; ++r) { rows[r] = (v4u){0u, 0u, 0u, 0u}; if (s0 - 3 + r >= 0) rows[r] = *(const GAS v4u*)(P + (size_t)(tb - 3 + r) * LDP + 512 + ch); } }
        if (tid < 256) { const int t = tid >> 2, h = tid & 3; gs[tid] = GATES[(size_t)(tok0 + t) * 16 + h] + A.in[6][li * 4 + h]; ls[tid] = logsigmoidf_(GATES[(size_t)(tok0 + t) * 16 + 4 + h] + A.in[7][li * 4 + h]); }
        __syncthreads();
        if (tid < 256) {
            const int h = tid >> 6, t = tid & 63;
            float bs = ls[t * 4 + h];
#pragma unroll
            for (int o = 1; o < 64; o <<= 1) { const float up = __shfl_up(bs, o); if (t >= o) bs += up; }
            const float r = gs[t * 4 + h] - bs; float cm = r;
#pragma unroll
            for (int o = 1; o < 64; o <<= 1) { const float up = __shfl_up(cm, o); if (t >= o) cm = fmaxf(cm, up); }
            const float rmax = __shfl(cm, 63), gsum = __shfl(bs, 63);
            BT[(size_t)(tok0 + t) * 4 + h] = bs; CM[(size_t)(tok0 + t) * 4 + h] = cm;
            if (t == 0) { RMAX[unit * 4 + h] = rmax; GC[unit * 4 + h] = gsum; }
            fac[t * 4 + h] = __expf(r - rmax) * 0.08838834764831845f;
        }
        __syncthreads();
        {
            const int ch = (tid & 127) * 8, tb = tok0 + 16 * (tid >> 7);
            float wv[4][8], bv[8];
#pragma unroll
            for (int i = 0; i < 8; ++i) { bv[i] = cb[ch + i];
#pragma unroll
                for (int jj = 0; jj < 4; ++jj) wv[jj][i] = cw[jj * 1024 + ch + i]; }
#pragma unroll
            for (int t = 0; t < 16; ++t) {
                float acc[8];
#pragma unroll
                for (int i = 0; i < 8; ++i) acc[i] = bv[i];
#pragma unroll
                for (int jj = 0; jj < 4; ++jj) { const v4u pv = rows[t + jj];
                    acc[0] += wv[jj][0] * bflo(pv.x); acc[1] += wv[jj][1] * bfhi(pv.x); acc[2] += wv[jj][2] * bflo(pv.y); acc[3] += wv[jj][3] * bfhi(pv.y);
                    acc[4] += wv[jj][4] * bflo(pv.z); acc[5] += wv[jj][5] * bfhi(pv.z); acc[6] += wv[jj][6] * bflo(pv.w); acc[7] += wv[jj][7] * bfhi(pv.w); }
                const int tl = 16 * (tid >> 7) + t;
                const float sc = (ch >= 512) ? fac[tl * 4 + ((ch - 512) >> 7)] : 1.0f;
#pragma unroll
                for (int i = 0; i < 8; ++i) acc[i] = acc[i] * sigmoidf_(acc[i]) * sc;
                v4u o; o.x = pk2(acc[0], acc[1]); o.y = pk2(acc[2], acc[3]); o.z = pk2(acc[4], acc[5]); o.w = pk2(acc[6], acc[7]);
                if (ch < 512) *(GAS v4u*)(QW + (size_t)(tb + t) * 512 + ch) = o; else *(GAS v4u*)(KW + (size_t)(tb + t) * 512 + ch - 512) = o;
            }
        }
        {
            const int ch = (tid & 63) * 8, tb = tok0 + 8 * (tid >> 6), s0 = tb & (SEQ - 1), win = 2 << (ch >> 7);
            v4u rows[23];
#pragma unroll
            for (int r = 0; r < 23; ++r) { rows[r] = (v4u){0u, 0u, 0u, 0u}; if (r >= 16 - win && s0 - 15 + r >= 0) rows[r] = *(const GAS v4u*)(P + (size_t)(tb - 15 + r) * LDP + ch); }
#pragma unroll
            for (int t = 0; t < 8; ++t) {
                const int s = s0 + t, n = (s + 1 < win) ? (s + 1) : win;
                float acc[8] = {0.f, 0.f, 0.f, 0.f, 0.f, 0.f, 0.f, 0.f};
#pragma unroll
                for (int jj = 0; jj < 16; ++jj) { if (jj < win) { const v4u pv = rows[15 + t - jj];
                        acc[0] += bflo(pv.x); acc[1] += bfhi(pv.x); acc[2] += bflo(pv.y); acc[3] += bfhi(pv.y); acc[4] += bflo(pv.z); acc[5] += bfhi(pv.z); acc[6] += bflo(pv.w); acc[7] += bfhi(pv.w); } }
                const v4u u = rows[15 + t]; const float inv = __builtin_amdgcn_rcpf((float)n);
                const float u0[8] = {bflo(u.x), bfhi(u.x), bflo(u.y), bfhi(u.y), bflo(u.z), bfhi(u.z), bflo(u.w), bfhi(u.w)};
#pragma unroll
                for (int i = 0; i < 8; ++i) acc[i] = acc[i] * inv - u0[i];
                v4u o; o.x = pk2(acc[0], acc[1]); o.y = pk2(acc[2], acc[3]); o.z = pk2(acc[4], acc[5]); o.w = pk2(acc[6], acc[7]);
                *(GAS v4u*)(DD + (size_t)(tb + t) * 512 + ch) = o;
            }
        }
        __syncthreads();
    }
}
__device__ __forceinline__ void odd_prep(Frame& F, const Args& A, int li) {
    const bf16* P = (const bf16*)(F.ws + WS_P); bf16* QW = (bf16*)(F.ws + WS_QW); bf16* KW = (bf16*)(F.ws + WS_KW); float* EBL = (float*)(F.ws + WS_EBL);
    const float* GATES = (const float*)(F.ws + WS_GATES);
    const float* w2 = A.in[11] + (size_t)li * 16 * 512; const float* gb = A.in[12] + (size_t)li * 512;
    LAS float* gl = (LAS float*)(F.lds + RING_OFF);
    const int tid = F.tid, d = tid;
    float wc[16];
#pragma unroll
    for (int r = 0; r < 16; ++r) wc[r] = w2[r * 512 + d];
    const float gbv = gb[d];
    for (int unit = F.vcu; unit < 256; unit += F.G) {
        const int tok0 = (unit >> 6) * SEQ + (unit & 63) * 64;
        for (int i = tid; i < 1024; i += NTHR) gl[i] = GATES[(size_t)(tok0 + (i >> 4)) * 16 + (i & 15)];
        __syncthreads();
        float Bc = 0.f;
        unsigned short qn[8], kn[8];
#pragma unroll
        for (int j = 0; j < 8; ++j) { qn[j] = P[(size_t)(tok0 + j) * LDP + d]; kn[j] = P[(size_t)(tok0 + j) * LDP + 512 + d]; }
        for (int t0 = 0; t0 < 64; t0 += 8) {
            unsigned short qv[8], kv[8];
#pragma unroll
            for (int j = 0; j < 8; ++j) { qv[j] = qn[j]; kv[j] = kn[j]; }
            { const int tn = (t0 + 8 < 64) ? t0 + 8 : t0;
#pragma unroll
                for (int j = 0; j < 8; ++j) { qn[j] = P[(size_t)(tok0 + tn + j) * LDP + d]; kn[j] = P[(size_t)(tok0 + tn + j) * LDP + 512 + d]; } }
#pragma unroll
            for (int j = 0; j < 8; ++j) {
                const int t = t0 + j;
                float z = gbv;
#pragma unroll
                for (int r = 0; r < 16; ++r) z += gl[t * 16 + r] * wc[r];
                Bc += logsigmoidf_(z) * 0.0625f;
                QW[(size_t)(tok0 + t) * 512 + d] = (bf16)f2bf(bf2f(qv[j]) * 0.08838834764831845f * __expf(Bc));
                KW[(size_t)(tok0 + t) * 512 + d] = (bf16)f2bf(bf2f(kv[j]) * __expf(-Bc));
            }
        }
        EBL[unit * 512 + d] = __expf(Bc);
        __syncthreads();
    }
}
template <bool EVEN>
__device__ __forceinline__ void stage_rows128(Frame& F, const bf16* src, int tok0, int h, LAS unsigned char* dst) {
    for (int i = F.tid; i < 1024; i += NTHR) { const int t = i >> 4, ch = i & 15; const v4u x = *(const GAS v4u*)(src + (size_t)(tok0 + t) * 512 + h * 128 + ch * 8); *(LAS v4u*)(dst + t * (KP * 2) + ch * 16) = x; }
}
template <bool EVEN>
__device__ __forceinline__ void stage_v(Frame& F, int tok0, int h, LAS unsigned char* Vs) {
    constexpr int DV = EVEN ? 128 : 256, DVP = EVEN ? 144 : 256, VPB = (DVP + 8) * 2, CH = DV / 8;
    const bf16* P = (const bf16*)(F.ws + WS_P) + (EVEN ? 1536 : 1024) + h * DV;
    for (int i = F.tid; i < 64 * CH; i += NTHR) { const int t = i / CH, ch = i % CH; const v4u x = *(const GAS v4u*)(P + (size_t)(tok0 + t) * LDP + ch * 8); *(LAS v4u*)(Vs + t * VPB + ch * 16) = x; }
    if (EVEN) { if (F.tid < 128) { const int t = F.tid >> 1, ch = F.tid & 1; v4u x = {0u, 0u, 0u, 0u}; if (ch == 0) x.x = 0x00003F80u; *(LAS v4u*)(Vs + t * VPB + (128 + ch * 8) * 2) = x; } }
}
__device__ __forceinline__ void ld_rows128(Frame& F, const bf16* src, int tok0, int h, v4u (&r)[2]) {
#pragma unroll
    for (int k = 0; k < 2; ++k) { const int i = F.tid + NTHR * k, t = i >> 4, ch = i & 15; r[k] = *(const GAS v4u*)(src + (size_t)(tok0 + t) * 512 + h * 128 + ch * 8); }
}
__device__ __forceinline__ void st_rows128(Frame& F, LAS unsigned char* dst, const v4u (&r)[2]) {
#pragma unroll
    for (int k = 0; k < 2; ++k) { const int i = F.tid + NTHR * k, t = i >> 4, ch = i & 15; *(LAS v4u*)(dst + t * (KP * 2) + ch * 16) = r[k]; }
}
template <bool EVEN>
__device__ __forceinline__ void ld_v(Frame& F, int tok0, int h, v4u (&r)[EVEN ? 2 : 4]) {
    constexpr int DV = EVEN ? 128 : 256, CH = DV / 8, NK = EVEN ? 2 : 4;
    const bf16* P = (const bf16*)(F.ws + WS_P) + (EVEN ? 1536 : 1024) + h * DV;
#pragma unroll
    for (int k = 0; k < NK; ++k) { const int i = F.tid + NTHR * k, t = i / CH, ch = i % CH; r[k] = *(const GAS v4u*)(P + (size_t)(tok0 + t) * LDP + ch * 8); }
}
template <bool EVEN>
__device__ __forceinline__ void st_v(Frame& F, LAS unsigned char* Vs, const v4u (&r)[EVEN ? 2 : 4]) {
    constexpr int DV = EVEN ? 128 : 256, DVP = EVEN ? 144 : 256, VPB = (DVP + 8) * 2, CH = DV / 8, NK = EVEN ? 2 : 4;
#pragma unroll
    for (int k = 0; k < NK; ++k) { const int i = F.tid + NTHR * k, t = i / CH, ch = i % CH; *(LAS v4u*)(Vs + t * VPB + ch * 16) = r[k]; }
    if (EVEN) { if (F.tid < 128) { const int t = F.tid >> 1, ch = F.tid & 1; v4u x = {0u, 0u, 0u, 0u}; if (ch == 0) x.x = 0x00003F80u; *(LAS v4u*)(Vs + t * VPB + (128 + ch * 8) * 2) = x; } }
}
template <bool EVEN>
__device__ __forceinline__ void mix_phaseA(Frame& F) {
    constexpr int DVP = EVEN ? 144 : 256, NTW = EVEN ? 1 : 2, VPB = (DVP + 8) * 2, KPB = KP * 2;
    LAS unsigned char* KWs = F.lds + RING_OFF; LAS unsigned char* Vs = KWs + 64 * KPB;
    const bf16* KW = (const bf16*)(F.ws + WS_KW); bf16* ST = (bf16*)(F.ws + WS_ST);
    const int lane = F.lane, w = F.wave, g = lane >> 4, q = (lane & 15) >> 2, p = lane & 3;
    v4u rk[2], rv[EVEN ? 2 : 4];
    if (F.vcu * 4 < 1024) { const int unit = F.vcu, b = unit >> 6, c = unit & 63; ld_rows128(F, KW, b * SEQ + c * 64, 0, rk); ld_v<EVEN>(F, b * SEQ + c * 64, 0, rv); }
    for (int uu = F.vcu * 4; uu < 1024; uu += F.G * 4)
    for (int h = 0; h < 4; ++h) {
        const int unit = uu >> 2, b = unit >> 6, c = unit & 63, bh = b * 4 + h, u = bh * 64 + c, tok0 = b * SEQ + c * 64;
        st_rows128(F, KWs, rk); st_v<EVEN>(F, Vs, rv);
        __syncthreads();
        { const int nh = (h + 1) & 3, nuu = (h == 3) ? uu + F.G * 4 : uu;
            if (nuu < 1024) { const int nunit = nuu >> 2, nb = nunit >> 6, nc = nunit & 63; ld_rows128(F, KW, nb * SEQ + nc * 64, nh, rk); ld_v<EVEN>(F, nb * SEQ + nc * 64, nh, rv); } }
        pg8::f32x4 acc[NTW][8]; pg8::f32x4 accx = {0.f, 0.f, 0.f, 0.f};
#pragma unroll
        for (int j = 0; j < NTW; ++j)
#pragma unroll
            for (int mt = 0; mt < 8; ++mt) acc[j][mt] = (pg8::f32x4){0.f, 0.f, 0.f, 0.f};
#pragma unroll
        for (int ks = 0; ks < 2; ++ks) {
            pg8::bf16x8 bv[NTW], bx;
#pragma unroll
            for (int j = 0; j < NTW; ++j) bv[j] = tr8(Vs + (32 * ks + 8 * g + q) * VPB + (16 * (w * NTW + j) + 4 * p) * 2, VPB);
            if (EVEN) bx = tr8(Vs + (32 * ks + 8 * g + q) * VPB + (128 + 4 * p) * 2, VPB);
#pragma unroll
            for (int mt = 0; mt < 8; ++mt) {
                const pg8::bf16x8 a = tr8(KWs + (32 * ks + 8 * g + q) * KPB + (16 * mt + 4 * p) * 2, KPB);
#pragma unroll
                for (int j = 0; j < NTW; ++j) acc[j][mt] = mma16(a, bv[j], acc[j][mt]);
                if (EVEN) { if (mt == w) accx = mma16(a, bx, accx); }
            }
        }
#pragma unroll
        for (int j = 0; j < NTW; ++j)
#pragma unroll
            for (int mt = 0; mt < 8; ++mt) { v2u o; o.x = pk2(acc[j][mt][0], acc[j][mt][1]); o.y = pk2(acc[j][mt][2], acc[j][mt][3]);
                *(GAS v2u*)(ST + ((size_t)u * DVP + 16 * (w * NTW + j) + (lane & 15)) * 128 + 16 * mt + 4 * g) = o; }
        if (EVEN) { v2u o; o.x = pk2(accx[0], accx[1]); o.y = pk2(accx[2], accx[3]); *(GAS v2u*)(ST + ((size_t)u * DVP + 128 + (lane & 15)) * 128 + 16 * w + 4 * g) = o; }
        __syncthreads();
    }
}
template <bool EVEN>
__device__ __forceinline__ void mix_scan(Frame& F, int nwg_s, int idx_s) {
    constexpr int DVP = EVEN ? 144 : 256, NTK = DVP * 16;
    bf16* ST = (bf16*)(F.ws + WS_ST);
    const float* RMAX = (const float*)(F.ws + WS_RMAX); const float* GC = (const float*)(F.ws + WS_GC); float* MPREV = (float*)(F.ws + WS_MPREV); const float* EBL = (const float*)(F.ws + WS_EBL);
    if (idx_s >= 0)
    for (int gi = (F.wave * nwg_s + idx_s) * 64 + F.lane; gi < 16 * NTK; gi += nwg_s * NTHR) {
        const int bh = gi / NTK, rem = gi % NTK, dv = rem >> 4, d8 = rem & 15, b = bh >> 2, h = bh & 3;
        bf16* base = ST + ((size_t)(bh * 64) * DVP + dv) * 128 + d8 * 8;
        float s[8];
#pragma unroll
        for (int i = 0; i < 8; ++i) s[i] = 0.f;
        float m = 0.f;
        for (int c0 = 0; c0 < 64; c0 += 8) {
            v4u uu[8];
#pragma unroll
            for (int k = 0; k < 8; ++k) uu[k] = *(const GAS v4u*)(base + (size_t)(c0 + k) * DVP * 128);
#pragma unroll
            for (int k = 0; k < 8; ++k) {
                const int c = c0 + k;
                const float u8[8] = {bflo(uu[k].x), bfhi(uu[k].x), bflo(uu[k].y), bfhi(uu[k].y), bflo(uu[k].z), bfhi(uu[k].z), bflo(uu[k].w), bfhi(uu[k].w)};
                v4u o;
                if (EVEN) {
                    const float rmax = RMAX[(b * 64 + c) * 4 + h], gc = GC[(b * 64 + c) * 4 + h];
                    const float Mc = fmaxf(m, rmax), al = __expf(m - Mc), be = __expf(rmax - Mc), kap = __expf(m - rmax);
                    o.x = pk2(kap * s[0], kap * s[1]); o.y = pk2(kap * s[2], kap * s[3]); o.z = pk2(kap * s[4], kap * s[5]); o.w = pk2(kap * s[6], kap * s[7]);
                    if (dv == 0 && d8 == 0) MPREV[bh * 64 + c] = m;
#pragma unroll
                    for (int i = 0; i < 8; ++i) s[i] = al * s[i] + be * u8[i];
                    m = gc + Mc;
                } else {
                    o.x = pk2(s[0], s[1]); o.y = pk2(s[2], s[3]); o.z = pk2(s[4], s[5]); o.w = pk2(s[6], s[7]);
                    const f32x4 a0 = *(const GAS f32x4*)(EBL + (size_t)(b * 64 + c) * 512 + h * 128 + d8 * 8), a1 = *(const GAS f32x4*)(EBL + (size_t)(b * 64 + c) * 512 + h * 128 + d8 * 8 + 4);
                    const float al[8] = {a0.x, a0.y, a0.z, a0.w, a1.x, a1.y, a1.z, a1.w};
#pragma unroll
                    for (int i = 0; i < 8; ++i) s[i] = al[i] * (s[i] + u8[i]);
                }
                *(GAS v4u*)(base + (size_t)c * DVP * 128) = o;
            }
        }
    }
}
template <bool EVEN>
__device__ __forceinline__ void mix_phaseC(Frame& F, const Args& A, int li) {
    constexpr int DV = EVEN ? 128 : 256, DVP = EVEN ? 144 : 256, NTW = EVEN ? 1 : 2, VPB = (DVP + 8) * 2, KPB = KP * 2, PPB = 72 * 2, OP = DVP + 4;
    LAS unsigned char* QWs = F.lds + RING_OFF; LAS unsigned char* KWs = QWs + 64 * KPB; LAS unsigned char* Vs = KWs + 64 * KPB; LAS unsigned char* PS = F.lds + RING_OFF + 68608;
    LAS float* rho = (LAS float*)(F.lds + RING_OFF + 77824); LAS float* thr = rho + 64; LAS float* OUT = (LAS float*)(F.lds + RING_OFF);
    static_assert(64 * KPB * 2 + 64 * VPB <= 68608 && 64 * OP * 4 <= 68608, "phase C LDS map");
    const bf16* QW = (const bf16*)(F.ws + WS_QW); const bf16* KW = (const bf16*)(F.ws + WS_KW); const bf16* ST = (const bf16*)(F.ws + WS_ST);
    const bf16* P = (const bf16*)(F.ws + WS_P); bf16* MIX = (bf16*)(F.ws + WS_MIX);
    const float* gn = EVEN ? A.in[8] + (size_t)li * 512 : A.in[13] + (size_t)li * 1024;
    const int lane = F.lane, w = F.wave, g = lane >> 4, q = (lane & 15) >> 2, p = lane & 3, l15 = lane & 15;
    v4u rq[2], rk[2], rv[EVEN ? 2 : 4];
    if (F.vcu < 1024) { const int u = F.vcu, bh = u >> 6, c = u & 63, tok0 = (bh >> 2) * SEQ + c * 64, h = bh & 3; ld_rows128(F, QW, tok0, h, rq); ld_rows128(F, KW, tok0, h, rk); ld_v<EVEN>(F, tok0, h, rv); }
    for (int u = F.vcu; u < 1024; u += F.G) {
        const int bh = u >> 6, c = u & 63, b = bh >> 2, h = bh & 3, tok0 = b * SEQ + c * 64;
        pg8::bf16x8 sb[4][NTW], sbx[4];
#pragma unroll
        for (int ks = 0; ks < 4; ++ks) {
#pragma unroll
            for (int j = 0; j < NTW; ++j) sb[ks][j] = *(const GAS pg8::bf16x8*)(ST + ((size_t)u * DVP + 16 * (w * NTW + j) + l15) * 128 + 32 * ks + 8 * g);
            if (EVEN) sbx[ks] = *(const GAS pg8::bf16x8*)(ST + ((size_t)u * DVP + 128 + l15) * 128 + 32 * ks + 8 * g);
        }
        st_rows128(F, QWs, rq); st_rows128(F, KWs, rk); st_v<EVEN>(F, Vs, rv);
        if (EVEN) { if (F.tid < 64) { const int t = F.tid;
                const float cm = ((const float*)(F.ws + WS_CM))[(size_t)(tok0 + t) * 4 + h], bt = ((const float*)(F.ws + WS_BT))[(size_t)(tok0 + t) * 4 + h];
                const float rmax = ((const float*)(F.ws + WS_RMAX))[(b * 64 + c) * 4 + h], mp = ((const float*)(F.ws + WS_MPREV))[u];
                const float Mt = fmaxf(mp, cm); rho[t] = __expf(rmax - Mt); thr[t] = __expf(-(bt + Mt)); } }
        __syncthreads();
        if (u + F.G < 1024) { const int nu = u + F.G, nbh = nu >> 6, nc = nu & 63, ntok0 = (nbh >> 2) * SEQ + nc * 64, nh = nbh & 3;
            ld_rows128(F, QW, ntok0, nh, rq); ld_rows128(F, KW, ntok0, nh, rk); ld_v<EVEN>(F, ntok0, nh, rv); }
        {
            const int mt = w >> 1;
            pg8::f32x4 pa[2] = {{0.f, 0.f, 0.f, 0.f}, {0.f, 0.f, 0.f, 0.f}};
#pragma unroll
            for (int ks = 0; ks < 4; ++ks) {
                const pg8::bf16x8 a = *(const LAS pg8::bf16x8*)(QWs + (16 * mt + l15) * KPB + (32 * ks + 8 * g) * 2);
#pragma unroll
                for (int jj = 0; jj < 2; ++jj) { const int nt = 2 * (w & 1) + jj; const pg8::bf16x8 bb = *(const LAS pg8::bf16x8*)(KWs + (16 * nt + l15) * KPB + (32 * ks + 8 * g) * 2); pa[jj] = mma16(a, bb, pa[jj]); }
            }
#pragma unroll
            for (int jj = 0; jj < 2; ++jj) { const int nt = 2 * (w & 1) + jj, s = 16 * nt + l15;
#pragma unroll
                for (int r = 0; r < 4; ++r) { const int t = 16 * mt + 4 * g + r; *(LAS bf16*)(PS + t * PPB + s * 2) = (bf16)((s <= t) ? f2bf(pa[jj][r]) : 0u); } }
        }
        __syncthreads();
        pg8::f32x4 acc[NTW][4]; pg8::f32x4 accx = {0.f, 0.f, 0.f, 0.f};
#pragma unroll
        for (int j = 0; j < NTW; ++j)
#pragma unroll
            for (int mt = 0; mt < 4; ++mt) acc[j][mt] = (pg8::f32x4){0.f, 0.f, 0.f, 0.f};
#pragma unroll
        for (int ks = 0; ks < 2; ++ks) {
            pg8::bf16x8 bv[NTW], bx;
#pragma unroll
            for (int j = 0; j < NTW; ++j) bv[j] = tr8(Vs + (32 * ks + 8 * g + q) * VPB + (16 * (w * NTW + j) + 4 * p) * 2, VPB);
            if (EVEN) bx = tr8(Vs + (32 * ks + 8 * g + q) * VPB + (128 + 4 * p) * 2, VPB);
#pragma unroll
            for (int mt = 0; mt < 4; ++mt) {
                const pg8::bf16x8 a = *(const LAS pg8::bf16x8*)(PS + (16 * mt + l15) * PPB + (32 * ks + 8 * g) * 2);
#pragma unroll
                for (int j = 0; j < NTW; ++j) acc[j][mt] = mma16(a, bv[j], acc[j][mt]);
                if (EVEN) { if (mt == w) accx = mma16(a, bx, accx); }
            }
        }
#pragma unroll
        for (int ks = 0; ks < 4; ++ks) {
#pragma unroll
            for (int mt = 0; mt < 4; ++mt) {
                const pg8::bf16x8 a = *(const LAS pg8::bf16x8*)(QWs + (16 * mt + l15) * KPB + (32 * ks + 8 * g) * 2);
#pragma unroll
                for (int j = 0; j < NTW; ++j) acc[j][mt] = mma16(a, sb[ks][j], acc[j][mt]);
                if (EVEN) { if (mt == w) accx = mma16(a, sbx[ks], accx); }
            }
        }
        __syncthreads();
#pragma unroll
        for (int j = 0; j < NTW; ++j)
#pragma unroll
            for (int mt = 0; mt < 4; ++mt)
#pragma unroll
                for (int r = 0; r < 4; ++r) OUT[(16 * mt + 4 * g + r) * OP + 16 * (w * NTW + j) + l15] = acc[j][mt][r];
        if (EVEN) { if (w < 4) {
#pragma unroll
                for (int r = 0; r < 4; ++r) OUT[(16 * w + 4 * g + r) * OP + 128 + l15] = accx[r]; } }
        __syncthreads();
        if (EVEN) {
            unsigned og[8];
#pragma unroll
            for (int rr = 0; rr < 8; ++rr) og[rr] = *(const GAS unsigned*)(P + (size_t)(tok0 + 8 * w + rr) * LDP + 2048 + h * 128 + 2 * lane);
            const float g0 = gn[h * 128 + 2 * lane], g1 = gn[h * 128 + 2 * lane + 1];
#pragma unroll
            for (int rr = 0; rr < 8; ++rr) {
                const int t = 8 * w + rr; const size_t tok = (size_t)(tok0 + t);
                const float v0 = OUT[t * OP + 2 * lane], v1 = OUT[t * OP + 2 * lane + 1], den = OUT[t * OP + 128], rh = rho[t];
                const float dd = __builtin_amdgcn_rcpf(fmaxf(fabsf(rh * den), thr[t]));
                float h0 = rh * v0 * dd, h1 = rh * v1 * dd;
                const float mu = wave_sum(h0 + h1) * (1.f / 128.f); h0 -= mu; h1 -= mu;
                const float rs = __builtin_amdgcn_rsqf(wave_sum(h0 * h0 + h1 * h1) * (1.f / 128.f) + LN_EPS);
                const float o0 = h0 * rs * g0 * sigmoidf_(bflo(og[rr])), o1 = h1 * rs * g1 * sigmoidf_(bfhi(og[rr]));
                *(GAS unsigned*)(MIX + tok * 1024 + 512 + h * 128 + 2 * lane) = pk2(o0, o1);
            }
        } else {
            v2u rg[8];
#pragma unroll
            for (int rr = 0; rr < 8; ++rr) rg[rr] = *(const GAS v2u*)(P + (size_t)(tok0 + 8 * w + rr) * LDP + 2048 + h * 256 + 4 * lane);
            const f32x4 gg = *(const GAS f32x4*)(gn + h * 256 + 4 * lane);
#pragma unroll
            for (int rr = 0; rr < 8; ++rr) {
                const int t = 8 * w + rr; const size_t tok = (size_t)(tok0 + t);
                f32x4 v = *(const LAS f32x4*)(OUT + t * OP + 4 * lane);
                const float mu = wave_sum((v.x + v.y) + (v.z + v.w)) * (1.f / 256.f); v = v - mu;
                const float rs = __builtin_amdgcn_rsqf(wave_sum((v.x * v.x + v.y * v.y) + (v.z * v.z + v.w * v.w)) * (1.f / 256.f) + LN_EPS);
                const float r0 = bflo(rg[rr].x), r1 = bfhi(rg[rr].x), r2 = bflo(rg[rr].y), r3 = bfhi(rg[rr].y);
                v2u o; o.x = pk2(v.x * rs * gg.x * (r0 * sigmoidf_(r0)), v.y * rs * gg.y * (r1 * sigmoidf_(r1))); o.y = pk2(v.z * rs * gg.z * (r2 * sigmoidf_(r2)), v.w * rs * gg.w * (r3 * sigmoidf_(r3)));
                *(GAS v2u*)(MIX + tok * 1024 + h * 256 + 4 * lane) = o;
            }
        }
        __syncthreads();
    }
}

#define IN(k) (lo <= (k) && (k) < hi)
#define SEAM(k) do { if (!MK_SPLIT && (k) + 1 < hi) xcd_barrier(bar); } while (0)
template <int layer>
__device__ __forceinline__ void layer_body(Frame& F, const Args& args, const XcdBarrier& bar, const int lo, const int hi) {
        { int t_ = threadIdx.x; asm volatile("" : "+v"(t_)); F.tid = t_; F.lane = t_ & 63; F.wave = __builtin_amdgcn_readfirstlane(t_ >> 6);
          int v_ = F.vcu, g_ = F.G; asm volatile("" : "+s"(v_), "+s"(g_)); F.vcu = v_; F.G = g_; F.ws = args.ws; F.ctl = (gu32*)(args.ws + WS_CTL); }
        const int pb = 1 + layer * NPH, li = layer >> 1; const bool odd = layer & 1;
        bf16* XB = (bf16*)(F.ws + WS_XB); bf16* P = (bf16*)(F.ws + WS_P); bf16* MIX = (bf16*)(F.ws + WS_MIX);
        if (IN(pb + 0)) {
            const bf16* wt = odd ? (const bf16*)(F.ws + WS_WINO) + (size_t)li * NO_P * 1024 : (const bf16*)(F.ws + WS_WINE) + (size_t)li * NE_P * 1024;
            const int N = odd ? NO_P : NE_P;
            pg8::Gemm g{XB, wt, M, N, D}; pg8::StaticOrder S; S.init(M, N, F.G, (int)blockIdx.x);
            pg8::EpiStoreBf16 E{P, LDP, nullptr, 0};
            for (int rep = 0; rep < (PROBE_DUP == 5 ? 2 : 1); ++rep) pg8::gemm_phase<pg8::EpiStoreBf16, pg8::StaticOrder, true, true>(F.lds + RING_OFF, g, S, E);
            SEAM(pb + 0);
        }
        if (IN(pb + 1)) {
            if (odd) odd_prep(F, args, li); else even_prep2(F, args, li);
            if (PROBE_DUP == 4) { if (odd) odd_prep(F, args, li); else even_prep2(F, args, li); }
            VM_WAIT(); __syncthreads();
            if (odd) mix_phaseA<false>(F); else mix_phaseA<true>(F);
            if (PROBE_DUP == 2) { if (odd) mix_phaseA<false>(F); else mix_phaseA<true>(F); }
            SEAM(pb + 1);
        }
        if (IN(pb + 4)) {
            const bool split = !odd && F.G == 256;
            if (odd) mix_scan<false>(F, F.G, F.vcu); else mix_scan<true>(F, split ? 128 : F.G, split ? (int)blockIdx.x - 128 : F.vcu);
            if (!odd) {
                pg8::Gemm g{(const bf16*)(F.ws + WS_DD), (const bf16*)(F.ws + WS_WP) + (size_t)li * 512 * 512, M, 512, 512}; pg8::StaticOrder S; S.init(M, 512, F.G, (int)blockIdx.x);
                pg8::EpiStoreBf16 E{MIX, 1024, args.in[3] + (size_t)li * 512, 0};
                for (int rep = 0; rep < (PROBE_DUP == 5 ? 2 : 1); ++rep) pg8::gemm_phase<pg8::EpiStoreBf16, pg8::StaticOrder, true, true>(F.lds + RING_OFF, g, S, E);
            }
            SEAM(pb + 4);
        }
        if (IN(pb + 5)) { if (odd) mix_phaseC<false>(F, args, li); else mix_phaseC<true>(F, args, li); if (PROBE_DUP == 2) { if (odd) mix_phaseC<false>(F, args, li); else mix_phaseC<true>(F, args, li); } SEAM(pb + 5); }
        if (IN(pb + 6)) {
            pg8::Gemm g{MIX, (const bf16*)(F.ws + WS_WOUT) + (size_t)layer * 1024 * 1024, M, D, D}; pg8::StaticOrder S; S.init(M, D, F.G, (int)blockIdx.x);
            pg8::EpiResBf16 E{(const bf16*)(F.ws + WS_XB), (bf16*)(F.ws + WS_PRE), D, ALPHA};
            for (int rep = 0; rep < (PROBE_DUP == 5 ? 2 : 1); ++rep) pg8::gemm_phase<pg8::EpiResBf16, pg8::StaticOrder, true, true>(F.lds + RING_OFF, g, S, E);
            SEAM(pb + 6);
        }
#ifndef X_NO_RW
        if (IN(pb + 7)) {
            p0_convert(F, args, layer, 1024 + F.vcu, F.G, 3072); __syncthreads();
            rw_phase<1>(F, args, layer); SEAM(pb + 7); }
#endif
        if (IN(pb + 9)) {
            moe_tables(F, layer);
            pg8::Gemm g{(const bf16*)(F.ws + (MOE_FP8_GU ? WS_X1F8 : WS_X1B)), (const bf16*)(F.ws + WS_WGU) + (size_t)layer * 32 * 2048 * 1024 / (MOE_FP8_GU ? 2 : 1), MAXROWS, 32 * 2048, MOE_FP8_GU ? D / 2 : D};
            pg8::MoeOrder S{8, F.G, F.vcu, (int)F.MISC[MW_NTILES] * 8, (const LAS int*)(F.lds + MISC_OFF) + MW_TILEE, (const LAS int*)(F.lds + MISC_OFF) + MW_TBASE, (const LAS int*)(F.lds + MISC_OFF) + MW_CNT, 0, 0};
            pg8::EpiSwiglu E{(bf16*)(F.ws + WS_ACT), args.in[22] + (size_t)layer * 32 * 2048, 0, MOE_FP8_DOWN ? (unsigned char*)(F.ws + WS_ACT8) : nullptr, MOE_FP8_GU ? 1.0f / WGU_SCALE : 1.0f};
            {
                LAS int* gc = (LAS int*)(F.lds + GCACHE_OFF); const int* LIST = (const int*)(F.ws + WS_LIST);
                const int r = F.tid & 255, s0 = F.tid >> 8; int tk[GCACHE_SLOTS / 2];
#pragma unroll
                for (int i = 0; i < GCACHE_SLOTS / 2; ++i) { pg8::Unit uu; const bool ok = S.next(2 * i + s0, uu); const bool valid = ok && (r < uu.nval); const int ai = valid ? (uu.aidx + r) : 0; const int t = LIST[ai]; tk[i] = valid ? t : 0; }
#pragma unroll
                for (int i = 0; i < GCACHE_SLOTS / 2; ++i) gc[(2 * i + s0) * 256 + r] = tk[i];
                __syncthreads();
            }
            for (int rep = 0; rep < (PROBE_DUP == 3 ? 2 : 1); ++rep) pg8::gemm_phase<pg8::EpiSwiglu, pg8::MoeOrder, true, true, true, MOE_FP8_GU != 0>(F.lds + RING_OFF, g, S, E, (const LAS int*)(F.lds + GCACHE_OFF));
            if (PROBE_DUP == 6 || PROBE_DUP == 7 || PROBE_DUP == 8) { pg8::MoeOrder S2 = S; S2.force0 = (PROBE_DUP == 6) ? 1 : 0; pg8::EpiSwiglu E2{(bf16*)(F.ws + WS_END), args.in[22] + (size_t)layer * 32 * 2048, (PROBE_DUP == 7) ? (args.ph_hi > 0) : 0, nullptr, MOE_FP8_GU ? 1.0f / WGU_SCALE : 1.0f}; pg8::gemm_phase<pg8::EpiSwiglu, pg8::MoeOrder, true, true, true, MOE_FP8_GU != 0>(F.lds + RING_OFF, g, S2, E2, (const LAS int*)(F.lds + GCACHE_OFF)); }
            {
                const int total = (int)F.MISC[MW_NTILES] * 8, rem = (F.G == 256) ? (total & 255) : 0, nidle = rem ? 256 - rem : 0, nbusy = F.G - nidle;
                int x = (F.G == 256) ? (1024 - 4 * nidle) / 256 : 1024 / F.G; if (x < 0) x = 0;
                const int left = 1024 - nbusy * x, q = nidle ? (left + nidle - 1) / nidle : 0;
                int j0, j1;
                if (nidle == 0 || F.vcu < rem) { j0 = F.vcu * x; j1 = j0 + x; if (nidle == 0 && F.vcu == F.G - 1) j1 = 1024; }
                else { j0 = nbusy * x + (F.vcu - rem) * q; j1 = j0 + q; }
                if (j1 > 1024) j1 = 1024;
                p0_convert(F, args, layer, j0, 1, j1);
            }
            SEAM(pb + 9);
        }
        if (IN(pb + 10)) {
            if (MK_SPLIT) moe_tables(F, layer);
            pg8::Gemm g{(const bf16*)(F.ws + (MOE_FP8_DOWN ? WS_ACT8 : WS_ACT)), (const bf16*)(F.ws + WS_WDN) + (size_t)layer * 32 * 1024 * 1024 / (MOE_FP8_DOWN ? 2 : 1), MAXROWS, 32 * 1024, MOE_FP8_DOWN ? D / 2 : D};
            pg8::MoeOrder S{4, F.G, F.vcu, (int)F.MISC[MW_NTILES] * 4, (const LAS int*)(F.lds + MISC_OFF) + MW_TILEE, (const LAS int*)(F.lds + MISC_OFF) + MW_TBASE, (const LAS int*)(F.lds + MISC_OFF) + MW_CNT, 0, 1};
            pg8::EpiDown E{(bf16*)(F.ws + WS_Y), args.in[24] + (size_t)layer * 32 * 1024, 0, MOE_FP8_DOWN ? 1.0f / WDN_SCALE : 1.0f};
            for (int rep = 0; rep < (PROBE_DUP == 3 ? 2 : 1); ++rep) pg8::gemm_phase<pg8::EpiDown, pg8::MoeOrder, true, true, false, MOE_FP8_DOWN != 0>(F.lds + RING_OFF, g, S, E);
            if (PROBE_DUP == 6 || PROBE_DUP == 7 || PROBE_DUP == 8) { pg8::MoeOrder S2 = S; S2.force0 = (PROBE_DUP == 6) ? 1 : 0; pg8::EpiDown E2{(bf16*)(F.ws + WS_END), args.in[24] + (size_t)layer * 32 * 1024, (PROBE_DUP == 7) ? (args.ph_hi > 0) : 0, MOE_FP8_DOWN ? 1.0f / WDN_SCALE : 1.0f}; pg8::gemm_phase<pg8::EpiDown, pg8::MoeOrder, true, true, false, MOE_FP8_DOWN != 0>(F.lds + RING_OFF, g, S2, E2); }
            SEAM(pb + 10);
        }
#ifndef X_NO_RW
        if (IN(pb + 11)) { rw_phase<2>(F, args, layer); if (PROBE_DUP == 4) rw_phase<2>(F, args, layer); SEAM(pb + 11); }
#endif
}
__global__ void __launch_bounds__(NTHR, 2) fwd_kernel(Args args) {
    extern __shared__ __attribute__((aligned(16))) unsigned char lds[];
    Frame F;
    F.lds = (LAS unsigned char*)lds; F.MISC = (volatile LAS unsigned*)(F.lds + MISC_OFF);
    F.tid = threadIdx.x; F.lane = F.tid & 63; F.wave = __builtin_amdgcn_readfirstlane(F.tid >> 6);
    F.G = gridDim.x; { const int bx = blockIdx.x; F.vcu = (F.G % 8 == 0) ? (bx % 8) * (F.G / 8) + bx / 8 : bx; }
    F.ws = args.ws; F.ctl = (gu32*)(args.ws + WS_CTL); F.out = args.out;
    for (int u = F.tid; u < 2048; u += NTHR) ((LAS unsigned*)(F.lds + MISC_OFF))[u] = 0u;
    __syncthreads();
    const int lo = args.ph_lo, hi = args.ph_hi;
    XcdBarrier bar; bar.bar = (unsigned*)(F.ctl + CW_BAR); bar.x = 0; bar.st = nullptr;
    if (!MK_SPLIT) bar = xcd_barrier_post((unsigned*)(F.ctl + CW_BAR), F.MISC + 8);

    #ifndef X_NO_P0
    if (IN(0)) { p0_weights(F, args); __syncthreads(); if (PROBE_DUP == 1) { p0_weights(F, args); __syncthreads(); }
        if (PROBE_DUP == 9) { const size_t n4 = ((size_t)4 * 32 * 1024 * 2048 + (size_t)4 * 32 * 1024 * 1024) / 4; const size_t n4a = (size_t)4 * 32 * 1024 * 2048 / 4;
            for (size_t i = (size_t)F.vcu * NTHR + F.tid; i < n4; i += (size_t)F.G * NTHR) { const f32x4 v = __builtin_nontemporal_load((const GAS f32x4*)(i < n4a ? args.in[21] : args.in[23] - n4a * 4) + i);
                v2u o; o.x = pk2(v.x, v.y); o.y = pk2(v.z, v.w); *((GAS v2u*)(F.ws + WS_END) + i) = o; } } rw_phase<0>(F, args, 0); SEAM(0); }
#endif

    layer_body<0>(F, args, bar, lo, hi);
    layer_body<1>(F, args, bar, lo, hi);
    layer_body<2>(F, args, bar, lo, hi);
    layer_body<3>(F, args, bar, lo, hi);
#undef IN
#undef SEAM
}

extern "C" void kernel_launch(void* const* d_in, const int* in_sizes, int n_in, void* d_out, int out_size, void* d_ws, size_t ws_size, hipStream_t stream) {
    static int grid = 0;
    if (grid == 0) {
        if (n_in != 25 || in_sizes[0] != M * D || out_size != M * D || ws_size < WS_END + 1024 * MiB) { fprintf(stderr, "kernel_launch: unexpected shapes (n_in %d, in0 %d, out %d, ws %zu)\n", n_in, n_in > 0 ? in_sizes[0] : -1, out_size, ws_size); grid = -1; return; }
        int dev = 0, cus = 0, per_cu = 0;
        if (hipGetDevice(&dev) != hipSuccess || hipDeviceGetAttribute(&cus, hipDeviceAttributeMultiprocessorCount, dev) != hipSuccess) { grid = -1; return; }
        if (hipFuncSetAttribute((const void*)fwd_kernel, hipFuncAttributeMaxDynamicSharedMemorySize, LDS_BYTES) != hipSuccess) { fprintf(stderr, "kernel_launch: hipFuncSetAttribute failed\n"); grid = -1; return; }
        if (hipOccupancyMaxActiveBlocksPerMultiprocessor(&per_cu, (const void*)fwd_kernel, NTHR, LDS_BYTES) != hipSuccess || per_cu < 1) { fprintf(stderr, "kernel_launch: occupancy query says %d\n", per_cu); }
        (void)hipGetLastError();
        grid = cus;
    }
    if (grid < 0) return;
    if (hipMemsetAsync((char*)d_ws + WS_CTL, 0, CTL_ZERO_BYTES, stream) != hipSuccess) return;
    Args a{};
    for (int i = 0; i < 25; ++i) a.in[i] = (const float*)d_in[i];
    a.out = (float*)d_out; a.ws = (unsigned char*)d_ws;
#if MK_SPLIT
    for (int k = 0; k < NPHASES; ++k) {
        if (k >= 1) { const int j = (k - 1) % NPH, layer = (k - 1) / NPH; if (j == 2 || j == 3 || j == 8) continue; }
        a.ph_lo = k; a.ph_hi = k + 1;
        hipLaunchKernelGGL(fwd_kernel, dim3(grid), dim3(NTHR), LDS_BYTES, stream, a);
    }
#else
    a.ph_lo = 0; a.ph_hi = NPHASES;
    hipLaunchKernelGGL(fwd_kernel, dim3(grid), dim3(NTHR), LDS_BYTES, stream, a);
#endif
}
```

```cpp
#include <hip/hip_runtime.h>
#include <cstdio>
#include <cstdint>
namespace pg8 {
#define PG8_LAS __attribute__((address_space(3)))
typedef unsigned short bf16_t;
typedef short bf16x8 __attribute__((ext_vector_type(8)));
typedef float f32x4 __attribute__((ext_vector_type(4)));
typedef unsigned u32x4 __attribute__((ext_vector_type(4)));
constexpr int BM = 256, BK = 64, HALF = 128, HTB = HALF * BK * 2  , STAGE_BYTES = 8 * HTB, NXCD = 8, WGM = 8;

__host__ __device__ __forceinline__ int lds_byte(int r, int c) { const int st = (r >> 4) * 2 + (c >> 5), rr = r & 15, cc = c & 31, ob = rr * 64 + cc * 2; return st * 1024 + (ob ^ (((ob >> 9) & 1) << 5)); }
__host__ __device__ __forceinline__ void stage_rc(int b, int& R, int& C) { const int st = b / 1024, sb = b % 1024, swz = sb ^ (((sb >> 9) & 1) << 5); R = (st >> 1) * 16 + swz / 64; C = (st & 1) * 32 + (swz % 64) / 2; }
__host__ __device__ __forceinline__ int perm32(int rho) { const int n = rho >> 4, i = rho & 15; return 8 * (i >> 2) + 4 * n + (i & 3); }

struct Unit { int pm, pn, aidx, nval, slot; };
struct Gemm { const bf16_t* A; const bf16_t* Bt; int M, N, K; };

struct StaticOrder {
    int nM, nN, nwg, G, c;
    __host__ __device__ void init(int M, int N, int G_, int c_) { nM = M / BM; nN = N / BM; nwg = nM * nN; G = G_; c = c_; }
    __host__ __device__ bool next(int i, Unit& u) const {
        const long L = (long)i * G + c; if (L >= nwg) return false;
        int wgid = (int)L; { const int q = nwg / NXCD, r = nwg % NXCD, xcd = wgid % NXCD, off = wgid / NXCD; wgid = (xcd < r ? xcd * (q + 1) : r * (q + 1) + (xcd - r) * q) + off; }
        const int nig = WGM * nN, gid = wgid / nig, fm = gid * WGM, gsz = (nM - fm) < WGM ? (nM - fm) : WGM;
        u.pm = fm + ((wgid % nig) % gsz); u.pn = (wgid % nig) / gsz; return true;
    }
    __device__ __forceinline__ void a_ready(const Unit&) const {}
    __device__ __forceinline__ void done(const Unit&) const {}
};

typedef float f32x2c_t __attribute__((ext_vector_type(2))); typedef __bf16 bf16x2c_t __attribute__((ext_vector_type(2)));
__device__ __forceinline__ unsigned cvt_pk_bf16(float lo, float hi) { f32x2c_t v = {lo, hi}; bf16x2c_t b = __builtin_convertvector(v, bf16x2c_t); return __builtin_bit_cast(unsigned, b); }
typedef float f32x2 __attribute__((ext_vector_type(2)));

struct EpiStoreBf16 {
    static constexpr bool PERM = true, AFTER_DRAIN = false;
    bf16_t* O; int ldc; const float* scale; int col_off;
    __device__ __forceinline__ void operator()(const f32x4 (&acc)[2][2][4][2], const Unit& u, int wr, int wc, int fr, int fq) const {
        const int row0 = u.pm * BM + wr * 64 + fr, col0 = u.pn * BM + wc * 32 + 8 * fq;
        f32x4 sv[2][2];
#pragma unroll
        for (int bj = 0; bj < 2; ++bj)
#pragma unroll
            for (int n = 0; n < 2; ++n) sv[bj][n] = scale ? *(const f32x4*)(scale + col0 + bj * HALF + 4 * n) : (f32x4){1.f, 1.f, 1.f, 1.f};
#pragma unroll
        for (int ai = 0; ai < 2; ++ai)
#pragma unroll
            for (int m = 0; m < 4; ++m) { bf16_t* rowp = O + (size_t)(row0 + ai * HALF + m * 16) * ldc + col_off + col0;
#pragma unroll
                for (int bj = 0; bj < 2; ++bj) { const f32x4 v0 = acc[ai][bj][m][0] * sv[bj][0], v1 = acc[ai][bj][m][1] * sv[bj][1];
                    u32x4 w; w.x = cvt_pk_bf16(v0[0], v0[1]); w.y = cvt_pk_bf16(v0[2], v0[3]); w.z = cvt_pk_bf16(v1[0], v1[1]); w.w = cvt_pk_bf16(v1[2], v1[3]);
                    *(u32x4*)(rowp + bj * HALF) = w; } }
    }
};
struct EpiResBf16 {
    static constexpr bool PERM = true, AFTER_DRAIN = false;
    const bf16_t* X; bf16_t* O; int ldc; float alpha;
    __device__ __forceinline__ void operator()(const f32x4 (&acc)[2][2][4][2], const Unit& u, int wr, int wc, int fr, int fq) const {
        const int row0 = u.pm * BM + wr * 64 + fr, col0 = u.pn * BM + wc * 32 + 8 * fq;
        u32x4 xr[2][4][2];
#pragma unroll
        for (int ai = 0; ai < 2; ++ai)
#pragma unroll
            for (int m = 0; m < 4; ++m)
#pragma unroll
                for (int bj = 0; bj < 2; ++bj) xr[ai][m][bj] = *(const u32x4*)(X + (size_t)(row0 + ai * HALF + m * 16) * ldc + col0 + bj * HALF);
#pragma unroll
        for (int ai = 0; ai < 2; ++ai)
#pragma unroll
            for (int m = 0; m < 4; ++m) { const size_t off = (size_t)(row0 + ai * HALF + m * 16) * ldc + col0;
#pragma unroll
                for (int bj = 0; bj < 2; ++bj) { const u32x4 xx = xr[ai][m][bj];
                    const f32x4 x0 = {__builtin_bit_cast(float, xx.x << 16), __builtin_bit_cast(float, xx.x & 0xffff0000u), __builtin_bit_cast(float, xx.y << 16), __builtin_bit_cast(float, xx.y & 0xffff0000u)};
                    const f32x4 x1 = {__builtin_bit_cast(float, xx.z << 16), __builtin_bit_cast(float, xx.z & 0xffff0000u), __builtin_bit_cast(float, xx.w << 16), __builtin_bit_cast(float, xx.w & 0xffff0000u)};
                    const f32x4 v0 = x0 * alpha + acc[ai][bj][m][0], v1 = x1 * alpha + acc[ai][bj][m][1];
                    u32x4 w; w.x = cvt_pk_bf16(v0[0], v0[1]); w.y = cvt_pk_bf16(v0[2], v0[3]); w.z = cvt_pk_bf16(v1[0], v1[1]); w.w = cvt_pk_bf16(v1[2], v1[3]);
                    *(u32x4*)(O + off + bj * HALF) = w; } }
    }
};
__device__ __forceinline__ f32x2 swiglu2(f32x4 h) {
    f32x2 g = {fminf(h[0], 7.0f), fminf(h[2], 7.0f)}, l = {fminf(fmaxf(h[1], -7.0f), 7.0f), fminf(fmaxf(h[3], -7.0f), 7.0f)};
    const f32x2 t = g * (-2.4554669595930156f);
    f32x2 e2; e2.x = __builtin_amdgcn_exp2f(t.x); e2.y = __builtin_amdgcn_exp2f(t.y);
    const f32x2 d = e2 + 1.0f;
    f32x2 r; r.x = __builtin_amdgcn_rcpf(d.x); r.y = __builtin_amdgcn_rcpf(d.y);
    return (g * r) * (l + 1.0f);
}
__device__ __forceinline__ unsigned pk4_fp8(float a, float b, float c, float d) { int v = __builtin_amdgcn_cvt_pk_fp8_f32(a, b, 0, false); v = __builtin_amdgcn_cvt_pk_fp8_f32(c, d, v, true); return (unsigned)v; }
struct EpiSwiglu {
    static constexpr bool PERM = true, AFTER_DRAIN = false;
    bf16_t* ACT; const float* bgu; int skip; unsigned char* ACT8; float ascale;
    __device__ __forceinline__ void operator()(const f32x4 (&acc)[2][2][4][2], const Unit& u, int wr, int wc, int fr, int fq) const {
        if (skip && u.pm >= 0) return;
        const int e = u.pn >> 3, pnl = u.pn & 7;
        const int row0 = u.pm * BM + wr * 64 + fr, hcol0 = pnl * BM + wc * 32 + 8 * fq;
        f32x4 bv[2][2];
#pragma unroll
        for (int bj = 0; bj < 2; ++bj)
#pragma unroll
            for (int n = 0; n < 2; ++n) bv[bj][n] = *(const f32x4*)(bgu + (size_t)e * 2048 + hcol0 + bj * HALF + 4 * n);
#pragma unroll
        for (int ai = 0; ai < 2; ++ai)
#pragma unroll
            for (int m = 0; m < 4; ++m) { bf16_t* rowp = ACT + (size_t)(row0 + ai * HALF + m * 16) * 1024 + (hcol0 >> 1);
#pragma unroll
                for (int bj = 0; bj < 2; ++bj) { const f32x4 v0 = acc[ai][bj][m][0] * ascale + bv[bj][0], v1 = acc[ai][bj][m][1] * ascale + bv[bj][1];
                    typedef unsigned u32x2v __attribute__((ext_vector_type(2)));
                    const f32x2 a0 = swiglu2(v0), a1 = swiglu2(v1);
                    if (ACT8) *(unsigned*)(ACT8 + (size_t)(row0 + ai * HALF + m * 16) * 1024 + (hcol0 >> 1) + bj * (HALF / 2)) = pk4_fp8(a0.x, a0.y, a1.x, a1.y);
                    else { u32x2v w; w.x = cvt_pk_bf16(a0.x, a0.y); w.y = cvt_pk_bf16(a1.x, a1.y); *(u32x2v*)(rowp + bj * (HALF / 2)) = w; } } }
    }
};
struct EpiDown {
    static constexpr bool PERM = true, AFTER_DRAIN = false;
    bf16_t* Y; const float* bdn; int skip; float ascale;
    __device__ __forceinline__ void operator()(const f32x4 (&acc)[2][2][4][2], const Unit& u, int wr, int wc, int fr, int fq) const {
        if (skip && u.pm >= 0) return;
        const int e = u.pn >> 2, pnl = u.pn & 3;
        const int row0 = u.pm * BM + wr * 64 + fr, col0 = pnl * BM + wc * 32 + 8 * fq;
        f32x4 bv[2][2];
#pragma unroll
        for (int bj = 0; bj < 2; ++bj)
#pragma unroll
            for (int n = 0; n < 2; ++n) bv[bj][n] = *(const f32x4*)(bdn + (size_t)e * 1024 + col0 + bj * HALF + 4 * n);
#pragma unroll
        for (int ai = 0; ai < 2; ++ai)
#pragma unroll
            for (int m = 0; m < 4; ++m) { bf16_t* rowp = Y + (size_t)(row0 + ai * HALF + m * 16) * 1024 + col0;
#pragma unroll
                for (int bj = 0; bj < 2; ++bj) { const f32x4 v0 = acc[ai][bj][m][0] * ascale + bv[bj][0], v1 = acc[ai][bj][m][1] * ascale + bv[bj][1];
                    u32x4 w; w.x = cvt_pk_bf16(v0[0], v0[1]); w.y = cvt_pk_bf16(v0[2], v0[3]); w.z = cvt_pk_bf16(v1[0], v1[1]); w.w = cvt_pk_bf16(v1[2], v1[3]);
                    *(u32x4*)(rowp + bj * HALF) = w; } }
    }
};
struct MoeOrder {
    int NT, G, c, total; const PG8_LAS int* tile_e; const PG8_LAS int* tbase; const PG8_LAS int* cnt; int force0, rev;
    __device__ __forceinline__ bool next(int i, Unit& u) const {
        const int L = i * G + c; if (L >= total) return false;
        const int pm0 = L / NT, pnl = L - pm0 * NT, pm = rev ? (total / NT - 1 - pm0) : pm0; const int e = __builtin_amdgcn_readfirstlane(tile_e[pm]);
        const int pml = pm - __builtin_amdgcn_readfirstlane(tbase[e]);
        u.pm = pm; u.pn = (force0 ? 0 : e) * NT + pnl; u.aidx = e * 16384 + pml * 256; u.nval = __builtin_amdgcn_readfirstlane(cnt[e]) - pml * 256; u.slot = i; return true;
    }
    __device__ __forceinline__ void a_ready(const Unit&) const {}
    __device__ __forceinline__ void done(const Unit&) const {}
};
template <class Epi, class Sched, bool ALIGN_EPI = false, bool SP2 = false, bool GATHER = false, bool FP8 = false>
__device__ __forceinline__ void gemm_phase(PG8_LAS unsigned char* lds, const Gemm g, const Sched& S, const Epi& E, const PG8_LAS int* gcache = nullptr) {
    int tid_ = threadIdx.x; asm volatile("" : "+v"(tid_));
    const int tid = tid_, wid = __builtin_amdgcn_readfirstlane(tid >> 6), lane = tid & 63, wr = wid >> 2, wc = wid & 3, fr = lane & 15, fq = lane >> 4;
    const int K = g.K, nt = K / BK;
    unsigned voffA[2], voffB[2]; int rA[2]; unsigned cA2[2];
#pragma unroll
    for (int i = 0; i < 2; ++i) { int R, C; stage_rc(tid * 16 + i * 8192, R, C); const int Rb = Epi::PERM ? ((R & ~31) + perm32(R & 31)) : R;
        voffA[i] = (unsigned)(R * K + C) * 2u; voffB[i] = (unsigned)(Rb * K + C) * 2u; rA[i] = R; cA2[i] = (unsigned)C * 2u; }
    const size_t kstep = (size_t)(BK * 2);
    const size_t hstep = (size_t)HALF * K * 2;
    const size_t tstep = 2 * hstep;
    const unsigned ldsw = (unsigned)wid * 1024u;
    const int aoff = lds_byte(wr * 64 + fr, fq * 8), boff = lds_byte(wc * 32 + fr, fq * 8);
#define PG8_SA(b, h) (((b) * 2 + (h)) * HTB)
#define PG8_SB(b, h) ((4 + (b) * 2 + (h)) * HTB)
#define PG8_STAGE(bufoff, gbase, voff) do { _Pragma("unroll") for (int _i = 0; _i < 2; ++_i) \
        __builtin_amdgcn_global_load_lds((const unsigned*)((const char*)(gbase) + (voff)[_i]), (PG8_LAS unsigned*)(lds + (bufoff) + ldsw + _i * 8192), 16, 0, 0); } while (0)
#define PG8_STAGE_A(bufoff, ubase, half, gsel_) do { if constexpr (GATHER) { PG8_STAGE(bufoff, ubase, (gsel_)[half]); } else { PG8_STAGE(bufoff, (ubase) + (half) * hstep, voffA); } } while (0)
#define PG8_GOFF(u_, dst_) do { _Pragma("unroll") for (int _h = 0; _h < 2; ++_h) _Pragma("unroll") for (int _i = 0; _i < 2; ++_i) { const int _r = 128 * _h + rA[_i]; \
        const int _tok = gcache[(u_).slot * 256 + _r]; (dst_)[_h][_i] = (unsigned)_tok * (unsigned)(K * 2) + cA2[_i]; } } while (0)
#define PG8_LDA(dst, b, h) do { _Pragma("unroll") for (int m = 0; m < 4; ++m) { const i32x4_ lo_ = *(const PG8_LAS i32x4_*)(lds + PG8_SA(b, h) + aoff + m * 2048), hi_ = *(const PG8_LAS i32x4_*)(lds + PG8_SA(b, h) + aoff + m * 2048 + 1024); \
        dst[m] = __builtin_shufflevector(lo_, hi_, 0, 1, 2, 3, 4, 5, 6, 7); } } while (0)
#define PG8_LDB(dst, b, h) do { _Pragma("unroll") for (int n = 0; n < 2; ++n) { const i32x4_ lo_ = *(const PG8_LAS i32x4_*)(lds + PG8_SB(b, h) + boff + n * 2048), hi_ = *(const PG8_LAS i32x4_*)(lds + PG8_SB(b, h) + boff + n * 2048 + 1024); \
        dst[n] = __builtin_shufflevector(lo_, hi_, 0, 1, 2, 3, 4, 5, 6, 7); } } while (0)
#define PG8_MMA(ai, bj, At, Bt) do { __builtin_amdgcn_s_setprio(1); \
        if constexpr (FP8) { _Pragma("unroll") for (int m = 0; m < 4; ++m) _Pragma("unroll") for (int n = 0; n < 2; ++n) \
                asm volatile("v_mfma_scale_f32_16x16x128_f8f6f4 %0, %1, %2, %0, %3, %3 op_sel_hi:[0,0,0]" : "+v"(acc[ai][bj][m][n]) : "v"(Bt[n]), "v"(At[m]), "v"(mxscale)); } \
        else { _Pragma("unroll") for (int m = 0; m < 4; ++m) _Pragma("unroll") for (int n = 0; n < 2; ++n) { \
                acc[ai][bj][m][n] = __builtin_amdgcn_mfma_f32_16x16x32_bf16(__builtin_bit_cast(bf16x8, __builtin_shufflevector(Bt[n], Bt[n], 0, 1, 2, 3)), __builtin_bit_cast(bf16x8, __builtin_shufflevector(At[m], At[m], 0, 1, 2, 3)), acc[ai][bj][m][n], 0, 0, 0); \
                acc[ai][bj][m][n] = __builtin_amdgcn_mfma_f32_16x16x32_bf16(__builtin_bit_cast(bf16x8, __builtin_shufflevector(Bt[n], Bt[n], 4, 5, 6, 7)), __builtin_bit_cast(bf16x8, __builtin_shufflevector(At[m], At[m], 4, 5, 6, 7)), acc[ai][bj][m][n], 0, 0, 0); } } \
        __builtin_amdgcn_s_setprio(0); } while (0)
#define PG8_WAIT_V(n) asm volatile("s_waitcnt vmcnt(" #n ")" ::: "memory")
#define PG8_WAIT_L(n) asm volatile("s_waitcnt lgkmcnt(" #n ")" ::: "memory")
#define PG8_BAR __builtin_amdgcn_s_barrier()
#define PG8_SCHED __builtin_amdgcn_sched_barrier(0)
    Unit cur, nxt; int ui = 0; int mxscale = 0x7F7F7F7F; asm volatile("" : "+v"(mxscale));
    if (!S.next(0, cur)) return;
    f32x4 acc[2][2][4][2];
#pragma unroll
    for (int a = 0; a < 2; ++a)
#pragma unroll
        for (int b = 0; b < 2; ++b)
#pragma unroll
            for (int m = 0; m < 4; ++m)
#pragma unroll
                for (int n = 0; n < 2; ++n) acc[a][b][m][n] = (f32x4){0.f, 0.f, 0.f, 0.f};
    typedef int i32x4_ __attribute__((ext_vector_type(4))); typedef int i32x8_ __attribute__((ext_vector_type(8)));
    i32x8_ At[4], B0[2], B1[2];
    const char* cA = (const char*)g.A + (GATHER ? (size_t)0 : (size_t)cur.pm * tstep); const char* cB = (const char*)g.Bt + (size_t)cur.pn * tstep;
    unsigned gofc[2][2] = {{0u, 0u}, {0u, 0u}}, gofn[2][2] = {{0u, 0u}, {0u, 0u}};
    if constexpr (GATHER) PG8_GOFF(cur, gofc);
    S.a_ready(cur);
    if constexpr (SP2) {
        PG8_STAGE(PG8_SB(0, 0), cB, voffB); PG8_STAGE(PG8_SB(0, 1), cB + hstep, voffB); PG8_STAGE_A(PG8_SA(0, 0), cA, 0, gofc); PG8_STAGE_A(PG8_SA(0, 1), cA, 1, gofc);
        if (wr == 1) PG8_BAR;
        PG8_WAIT_V(2); PG8_BAR;
        PG8_STAGE(PG8_SB(1, 0), cB + kstep, voffB); PG8_STAGE_A(PG8_SA(1, 0), cA + kstep, 0, gofc); PG8_STAGE(PG8_SB(1, 1), cB + hstep + kstep, voffB);
        PG8_WAIT_V(6); PG8_BAR;
    } else {
        PG8_STAGE(PG8_SB(0, 0), cB, voffB); PG8_STAGE_A(PG8_SA(0, 0), cA, 0, gofc); PG8_STAGE(PG8_SB(0, 1), cB + hstep, voffB); PG8_STAGE_A(PG8_SA(0, 1), cA, 1, gofc);
        if (wr == 1) PG8_BAR;
        PG8_WAIT_V(4); PG8_BAR;
        PG8_STAGE(PG8_SB(1, 0), cB + kstep, voffB); PG8_STAGE_A(PG8_SA(1, 0), cA + kstep, 0, gofc); PG8_STAGE(PG8_SB(1, 1), cB + hstep + kstep, voffB);
        PG8_WAIT_V(6); PG8_BAR;
    }
    for (;;) {
        const bool has_next = S.next(ui + 1, nxt);
        const char* nA = (has_next && !GATHER) ? (const char*)g.A + (size_t)nxt.pm * tstep : cA; const char* nB = has_next ? (const char*)g.Bt + (size_t)nxt.pn * tstep : cB;
        if constexpr (GATHER) { if (has_next) PG8_GOFF(nxt, gofn); else {
#pragma unroll
                for (int _h = 0; _h < 2; ++_h) { gofn[_h][0] = gofc[_h][0]; gofn[_h][1] = gofc[_h][1]; } } }
#pragma unroll 1
        for (int t = 0; t < nt; t += 2) {
            const bool last = (t == nt - 2);
            const char* a1 = cA + (size_t)(t + 1) * kstep;
            const char* a2 = last ? nA : cA + (size_t)(t + 2) * kstep; const char* b2 = last ? nB : cB + (size_t)(t + 2) * kstep;
            const char* a3 = a2 + kstep; const char* b3 = b2 + kstep;
            unsigned gsel[2][2];
#pragma unroll
            for (int _h = 0; _h < 2; ++_h) { gsel[_h][0] = last ? gofn[_h][0] : gofc[_h][0]; gsel[_h][1] = last ? gofn[_h][1] : gofc[_h][1]; }
            if (last && has_next) S.a_ready(nxt);
            if constexpr (SP2) {
            PG8_LDB(B0, 0, 0); PG8_LDB(B1, 0, 1); PG8_SCHED; PG8_LDA(At, 0, 0); PG8_STAGE_A(PG8_SA(1, 1), a1, 1, gofc);
            PG8_WAIT_V(8); PG8_WAIT_L(0); PG8_BAR; PG8_MMA(0, 0, At, B0); PG8_MMA(0, 1, At, B1); PG8_BAR; PG8_SCHED;
            PG8_LDA(At, 0, 1); PG8_STAGE(PG8_SB(0, 0), b2, voffB); PG8_STAGE(PG8_SB(0, 1), b2 + hstep, voffB); PG8_STAGE_A(PG8_SA(0, 0), a2, 0, gsel);
            PG8_WAIT_V(8); PG8_WAIT_L(0); PG8_BAR; PG8_MMA(1, 0, At, B0); PG8_MMA(1, 1, At, B1); PG8_BAR; PG8_SCHED;
            PG8_LDB(B0, 1, 0); PG8_LDB(B1, 1, 1); PG8_SCHED; PG8_LDA(At, 1, 0); PG8_STAGE_A(PG8_SA(0, 1), a2, 1, gsel);
            PG8_WAIT_V(8); PG8_WAIT_L(0); PG8_BAR; PG8_MMA(0, 0, At, B0); PG8_MMA(0, 1, At, B1); PG8_BAR; PG8_SCHED;
            PG8_LDA(At, 1, 1); PG8_STAGE(PG8_SB(1, 0), b3, voffB); PG8_STAGE(PG8_SB(1, 1), b3 + hstep, voffB); PG8_STAGE_A(PG8_SA(1, 0), a3, 0, gsel);
            PG8_WAIT_V(8); PG8_WAIT_L(0); PG8_BAR; PG8_MMA(1, 0, At, B0); PG8_MMA(1, 1, At, B1); PG8_BAR; PG8_SCHED;
            } else {
            PG8_LDB(B0, 0, 0); PG8_SCHED; PG8_LDA(At, 0, 0); PG8_STAGE_A(PG8_SA(1, 1), a1, 1, gofc);
            PG8_WAIT_L(8); PG8_BAR; PG8_WAIT_L(0); PG8_MMA(0, 0, At, B0); PG8_BAR; PG8_SCHED;
            PG8_LDB(B1, 0, 1); PG8_STAGE(PG8_SB(0, 0), b2, voffB);
            PG8_BAR; PG8_WAIT_L(0); PG8_MMA(0, 1, At, B1); PG8_BAR;
            PG8_LDA(At, 0, 1); PG8_STAGE_A(PG8_SA(0, 0), a2, 0, gsel);
            PG8_BAR; PG8_WAIT_L(0); PG8_MMA(1, 0, At, B0); PG8_BAR; PG8_SCHED;
            PG8_STAGE(PG8_SB(0, 1), b2 + hstep, voffB);
            PG8_WAIT_V(6); PG8_BAR; PG8_MMA(1, 1, At, B1); PG8_BAR;
            PG8_LDB(B0, 1, 0); PG8_SCHED; PG8_LDA(At, 1, 0); PG8_STAGE_A(PG8_SA(0, 1), a2, 1, gsel);
            PG8_WAIT_L(8); PG8_BAR; PG8_WAIT_L(0); PG8_MMA(0, 0, At, B0); PG8_BAR; PG8_SCHED;
            PG8_LDB(B1, 1, 1); PG8_STAGE(PG8_SB(1, 0), b3, voffB);
            PG8_BAR; PG8_WAIT_L(0); PG8_MMA(0, 1, At, B1); PG8_BAR;
            PG8_LDA(At, 1, 1); PG8_STAGE_A(PG8_SA(1, 0), a3, 0, gsel);
            PG8_BAR; PG8_WAIT_L(0); PG8_MMA(1, 0, At, B0); PG8_BAR; PG8_SCHED;
            PG8_STAGE(PG8_SB(1, 1), b3 + hstep, voffB);
            PG8_WAIT_V(6); PG8_BAR; PG8_MMA(1, 1, At, B1); PG8_BAR;
            }
        }
        if constexpr (FP8) asm volatile("s_nop 15\n\ts_nop 15" ::: "memory");
        if constexpr (ALIGN_EPI) { if (wr == 0) PG8_BAR; }
        if constexpr (!Epi::AFTER_DRAIN) { E(acc, cur, wr, wc, fr, fq); S.done(cur); }
        if (!has_next) break;
#pragma unroll
        for (int a = 0; a < 2; ++a)
#pragma unroll
            for (int b = 0; b < 2; ++b)
#pragma unroll
                for (int m = 0; m < 4; ++m)
#pragma unroll
                    for (int n = 0; n < 2; ++n) acc[a][b][m][n] = (f32x4){0.f, 0.f, 0.f, 0.f};
        cur = nxt; cA = nA; cB = nB; ++ui;
        if constexpr (GATHER) {
#pragma unroll
            for (int _h = 0; _h < 2; ++_h) { gofc[_h][0] = gofn[_h][0]; gofc[_h][1] = gofn[_h][1]; } }
        if constexpr (ALIGN_EPI) { if (wr == 1) PG8_BAR; }
    }
    PG8_WAIT_V(0);
    if constexpr (!ALIGN_EPI) { if (wr == 0) PG8_BAR; }
    PG8_BAR;
    if constexpr (Epi::AFTER_DRAIN) { E.fused(acc, cur, wr, wc, fr, fq, lds, wid, lane); S.done(cur); }
#undef PG8_SA
#undef PG8_SB
#undef PG8_STAGE
#undef PG8_STAGE_A
#undef PG8_GOFF
#undef PG8_LDA
#undef PG8_LDB
#undef PG8_MMA
#undef PG8_WAIT_V
#undef PG8_WAIT_L
#undef PG8_BAR
#undef PG8_SCHED
}
}

constexpr int NWAVES = 8, NTHR = 512;
constexpr int SEQ = 4096, D = 1024, M = 16384, DEPTH = 4;
constexpr int EVEN_IN = 2568, ODD_IN = 3088, NE_P = 2560, NO_P = 3072, LDP = 3072;
constexpr int NEXP = 32, MAXROWS = 65536 + 32 * 256;
constexpr float ALPHA = 1.6817928305074290f, LN_EPS = 1e-5f;
constexpr int NPH = 12, NPHASES = 1 + DEPTH * NPH;
#ifndef PROBE_DUP
#define PROBE_DUP 0
#endif
#ifndef MOE_FP8_DOWN
#define MOE_FP8_DOWN 1
#endif
#ifndef MOE_FP8_GU
#define MOE_FP8_GU 1
#endif
constexpr float WDN_SCALE = 128.0f, WGU_SCALE = 64.0f;
#ifndef IDLE_Q
#define IDLE_Q 0
#endif
#ifndef MK_SPLIT
#define MK_SPLIT 0
#endif

constexpr size_t MiB = 1u << 20;
constexpr size_t WS_CTL = 0, CTL_ZERO_BYTES = 1 * MiB;
constexpr size_t WS_WINE = 1 * MiB, WS_WINO = 11 * MiB, WS_WOUT = 23 * MiB, WS_WP = 31 * MiB, WS_WGU = 32 * MiB, WS_WDN = 544 * MiB;
constexpr size_t WS_X = 800 * MiB, WS_XB = 864 * MiB, WS_X1 = 896 * MiB, WS_X1B = 960 * MiB, WS_PRE = 992 * MiB, WS_P = 1056 * MiB, WS_MIX = 1152 * MiB;
constexpr size_t WS_QK = 1184 * MiB, WS_DD = 1216 * MiB, WS_GATES = 1232 * MiB, WS_H = 1234 * MiB, WS_TOKE = 1298 * MiB, WS_TOKPOS = WS_TOKE + 256 * 1024, WS_GATE = WS_TOKE + 512 * 1024, WS_SLOT = WS_TOKE + 768 * 1024;
constexpr size_t WS_XS = 1300 * MiB, WS_ACT = 1444 * MiB, WS_Y = 1588 * MiB, WS_END = 1876 * MiB;
constexpr size_t WS_X1F8 = WS_XS;
constexpr size_t WS_ACT8 = WS_ACT;
constexpr int CW_TMO = 0, CW_BAR = 4096, CW_CNT = 16384;

constexpr int RING_OFF = 0, RING_BYTES = 131072;
constexpr int MISC_OFF = RING_BYTES;
constexpr int GCACHE_OFF = RING_BYTES + 8192, GCACHE_SLOTS = 16;
constexpr int LDS_BYTES = GCACHE_OFF + GCACHE_SLOTS * 1024;
constexpr int MW_CNT = 16, MW_ROWBASE = 48, MW_TILEE = 96, MW_NTILES = 400, MW_LCNT = 416, MW_WBASE = 448, MW_PICK = 512, MW_TBASE = 1600;
constexpr size_t WS_LIST = WS_H + 2 * MiB;

#define GAS __attribute__((address_space(1)))
#define LAS __attribute__((address_space(3)))
typedef unsigned short bf16;
typedef unsigned v4u __attribute__((ext_vector_type(4)));
typedef unsigned v2u __attribute__((ext_vector_type(2)));
typedef float f32x4 __attribute__((ext_vector_type(4)));
typedef GAS unsigned gu32;
#define RLX_AGENT __ATOMIC_RELAXED, __HIP_MEMORY_SCOPE_AGENT
#define LDS_WAIT() asm volatile("s_waitcnt lgkmcnt(0)" ::: "memory")
#define VM_WAIT() asm volatile("s_waitcnt vmcnt(0)" ::: "memory")
typedef float f32x2_t __attribute__((ext_vector_type(2))); typedef __bf16 bf16x2_t __attribute__((ext_vector_type(2)));
__device__ __forceinline__ unsigned pk2(float lo, float hi) { f32x2_t v = {lo, hi}; bf16x2_t b = __builtin_convertvector(v, bf16x2_t); return __builtin_bit_cast(unsigned, b); }
__device__ __forceinline__ unsigned f2bf(float f) { return pk2(f, f) & 0xffffu; }
__device__ __forceinline__ float bf2f(unsigned short b) { return __builtin_bit_cast(float, (unsigned)b << 16); }
__device__ __forceinline__ float bflo(unsigned w) { return __builtin_bit_cast(float, w << 16); }
__device__ __forceinline__ float bfhi(unsigned w) { return __builtin_bit_cast(float, w & 0xffff0000u); }
__device__ __forceinline__ float sigmoidf_(float x) { return __builtin_amdgcn_rcpf(1.0f + __expf(-x)); }
__device__ __forceinline__ float logsigmoidf_(float x) { return fminf(x, 0.f) - __logf(1.0f + __expf(-fabsf(x))); }

#define XB_TMO      128
#define XB_XCNT(j)  (256  + 64 * (j))
#define XB_XSUB(j)  (1280 + 64 * (j))
#define XB_XGEN(j)  (2304 + 64 * (j))
#define XB_TOP      3328
#define XB_TOPGEN   3392
#define XCD_BAR_WORDS 3456
#define XB_SPIN_CAP (1u << 18)

__device__ __forceinline__ unsigned xb_ld(unsigned* p)              { return __hip_atomic_load(p, __ATOMIC_RELAXED, __HIP_MEMORY_SCOPE_AGENT); }
__device__ __forceinline__ unsigned xb_add(unsigned* p, unsigned v) { return __hip_atomic_fetch_add(p, v, __ATOMIC_RELAXED, __HIP_MEMORY_SCOPE_AGENT); }
__device__ __forceinline__ unsigned xb_xcc_id() { return (unsigned)__builtin_amdgcn_s_getreg((3 << 11) | 20) & 0xFu; }
#define XB_SPIN(cond, bar) do { unsigned _sp = 0; while (cond) { __builtin_amdgcn_s_sleep(1); \
    if ((++_sp & 255u) == 0u) { if (xb_ld(&(bar)[XB_TMO])) break; if (_sp > XB_SPIN_CAP) { atomicAdd(&(bar)[XB_TMO], 1u); break; } } } } while (0)

struct XcdBarrier {
    unsigned* bar; unsigned x;
    volatile LAS unsigned* st;
};

__device__ __forceinline__ XcdBarrier xcd_barrier_post(unsigned* bar, volatile LAS unsigned* st) {
    XcdBarrier b; b.bar = bar; b.x = xb_xcc_id(); b.st = st;
    if (threadIdx.x == 0) (void)xb_add(&bar[XB_XCNT(b.x)], 1u);
    return b;
}
__device__ __forceinline__ void xcd_barrier_complete(unsigned* bar, unsigned x, unsigned& nloc, unsigned& nx) {
    const unsigned G = gridDim.x * gridDim.y * gridDim.z;
    unsigned sum, cnt, mine, sp = 0u;
    for (;;) {
        sum = 0u; cnt = 0u; mine = 0u;
#pragma unroll
        for (unsigned j = 0; j < 16; ++j) { const unsigned c = xb_ld(&bar[XB_XCNT(j)]); sum += c; cnt += (c > 0u) ? 1u : 0u; mine = (j == x) ? c : mine; }
        if (sum == G) break;
        __builtin_amdgcn_s_sleep(1);
        if ((++sp & 255u) == 0u) { if (xb_ld(&bar[XB_TMO])) break; if (sp > XB_SPIN_CAP) { atomicAdd(&bar[XB_TMO], 1u); break; } }
    }
    nloc = mine > 0u ? mine : 1u; nx = cnt > 0u ? cnt : 1u;
}

__device__ __forceinline__ void xcd_barrier(const XcdBarrier& b) {
    asm volatile("s_waitcnt vmcnt(0)" ::: "memory");
    __syncthreads();
    if (threadIdx.x == 0) {
        unsigned* bar = b.bar;
        __builtin_amdgcn_s_waitcnt(0);
        unsigned nloc = b.st[0], nx = b.st[1];
        if (nloc == 0u) { xcd_barrier_complete(bar, b.x, nloc, nx); b.st[0] = nloc; b.st[1] = nx; }
        const unsigned old = xb_add(&bar[XB_XSUB(b.x)], 1u);
        const unsigned gen = old / nloc;
        if (old + 1u == (gen + 1u) * nloc) {
            __builtin_amdgcn_fence(__ATOMIC_RELEASE, "agent");
            asm volatile("s_waitcnt vmcnt(0)" ::: "memory");
            (void)xb_add(&bar[XB_TOP], 1u);
            const unsigned target = (gen + 1u) * nx;
            XB_SPIN((int)(xb_ld(&bar[XB_TOP]) - target) < 0, bar);
            __builtin_amdgcn_fence(__ATOMIC_ACQUIRE, "agent");
            xb_add(&bar[XB_XGEN(b.x)], 1u);
            asm volatile("s_waitcnt vmcnt(0)" ::: "memory");
        } else {
            XB_SPIN(xb_ld(&bar[XB_XGEN(b.x)]) == gen, bar);
            __builtin_amdgcn_fence(__ATOMIC_ACQUIRE, "agent");
            asm volatile("s_waitcnt vmcnt(0)" ::: "memory");
        }
    }
    __syncthreads();
}


typedef short s16x4 __attribute__((ext_vector_type(4)));
__device__ __forceinline__ pg8::bf16x8 tr8(const LAS unsigned char* p, int pitchB) {
    const s16x4 lo = __builtin_amdgcn_ds_read_tr16_b64_v4i16((LAS s16x4*)p);
    const s16x4 hi = __builtin_amdgcn_ds_read_tr16_b64_v4i16((LAS s16x4*)(p + 4 * pitchB));
    return __builtin_shufflevector(lo, hi, 0, 1, 2, 3, 4, 5, 6, 7);
}
struct Args { const float* in[25]; float* out; unsigned char* ws; int ph_lo, ph_hi; };
struct Frame {
    LAS unsigned char* lds;
    volatile LAS unsigned* MISC;
    gu32* ctl;
    int tid, lane, wave, vcu, G;
    float* out; unsigned char* ws;
};
__device__ __forceinline__ float dpp_add(float v, const int ctrl_sel) {
    const int x = __builtin_bit_cast(int, v); int y;
    if (ctrl_sel == 0) y = __builtin_amdgcn_update_dpp(x, x, 0xB1, 0xF, 0xF, false);
    else if (ctrl_sel == 1) y = __builtin_amdgcn_update_dpp(x, x, 0x4E, 0xF, 0xF, false);
    else if (ctrl_sel == 2) y = __builtin_amdgcn_update_dpp(x, x, 0x124, 0xF, 0xF, false);
    else y = __builtin_amdgcn_update_dpp(x, x, 0x128, 0xF, 0xF, false);
    return v + __builtin_bit_cast(float, y);
}
__device__ __forceinline__ float wave_sum(float v) {
    v = dpp_add(v, 0); v = dpp_add(v, 1); v = dpp_add(v, 2); v = dpp_add(v, 3);
    v += __shfl_xor(v, 16); v += __shfl_xor(v, 32);
    return v;
}
struct P0Tile { const float* src; size_t ldw; bf16* dst; size_t ldd; int fp8; };
constexpr int P0_PB = 528;
__device__ __forceinline__ P0Tile p0_tile(Frame& F, const Args& A, int t) {
    bf16* wine = (bf16*)(F.ws + WS_WINE); bf16* wino = (bf16*)(F.ws + WS_WINO); bf16* wout = (bf16*)(F.ws + WS_WOUT); bf16* wgu = (bf16*)(F.ws + WS_WGU); bf16* wdn = (bf16*)(F.ws + WS_WDN);
    constexpr int T_GU = 8 * 8, T_DN = 8 * 4, T_WE = 8 * 10, T_WO = 8 * 12, T_OUT = 8 * 4;
    constexpr int N_GU = 128 * T_GU, N_DN = 128 * T_DN, N_WE = 2 * T_WE, N_WO = 2 * T_WO;
    P0Tile o; int r = t, kt, nt; o.fp8 = 0;
    if (r < N_GU) { const int mtx = r / T_GU, q = r % T_GU; kt = q / 8; nt = q % 8; o.src = A.in[21] + (size_t)mtx * 1024 * 2048; o.ldw = 2048; o.dst = MOE_FP8_GU ? (bf16*)((unsigned char*)wgu + (size_t)mtx * 2048 * 1024) : wgu + (size_t)mtx * 2048 * 1024; o.fp8 = MOE_FP8_GU ? 2 : 0; }
    else if ((r -= N_GU) < N_DN) { const int mtx = r / T_DN, q = r % T_DN; kt = q / 4; nt = q % 4; o.src = A.in[23] + (size_t)mtx * 1024 * 1024; o.ldw = 1024; o.dst = MOE_FP8_DOWN ? (bf16*)((unsigned char*)wdn + (size_t)mtx * 1024 * 1024) : wdn + (size_t)mtx * 1024 * 1024; o.fp8 = MOE_FP8_DOWN; }
    else if ((r -= N_DN) < N_WE) { const int mtx = r / T_WE, q = r % T_WE; kt = q / 10; nt = q % 10; o.src = A.in[1] + (size_t)mtx * 1024 * EVEN_IN; o.ldw = EVEN_IN; o.dst = wine + (size_t)mtx * NE_P * 1024; }
    else if ((r -= N_WE) < N_WO) { const int mtx = r / T_WO, q = r % T_WO; kt = q / 12; nt = q % 12; o.src = A.in[10] + (size_t)mtx * 1024 * ODD_IN; o.ldw = ODD_IN; o.dst = wino + (size_t)mtx * NO_P * 1024; }
    else { r -= N_WO; const int l = r / T_OUT, q = r % T_OUT; kt = q / 4; nt = q % 4; o.src = ((l & 1) ? A.in[14] : A.in[9]) + (size_t)(l >> 1) * 1024 * 1024; o.ldw = 1024; o.dst = wout + (size_t)l * 1024 * 1024; }
    o.ldd = 1024; o.src += (size_t)(128 * kt) * o.ldw + 256 * nt;
    if (o.fp8) o.dst = (bf16*)((unsigned char*)o.dst + (size_t)(256 * nt) * 1024 + 128 * kt); else o.dst += (size_t)(256 * nt) * o.ldd + 128 * kt;
    return o;
}
__device__ __forceinline__ void p0_tile_load(const P0Tile& t, int wave, int lane, f32x4 (&v)[16]) {
#pragma unroll
    for (int i = 0; i < 16; ++i) v[i] = __builtin_nontemporal_load((const GAS f32x4*)(t.src + (size_t)(16 * wave + i) * t.ldw + 4 * lane));
}
__device__ __forceinline__ int p0_map(int layer, int j) { return layer < 0 ? j : (j < 1024 ? 8192 + layer * 1024 + j : layer * 2048 + (j - 1024)); }
__device__ __forceinline__ void p0_convert(Frame& F, const Args& A, int layer, int j0, int jstep, int jend) {
    LAS unsigned char* img = F.lds + RING_OFF;
    const int lane = F.lane, w = F.wave, g = lane >> 4, q = (lane & 15) >> 2, p = lane & 3, l15 = lane & 15;
    f32x4 v[16];
    int j = j0;
    if (j < jend) { const P0Tile cur = p0_tile(F, A, p0_map(layer, j)); p0_tile_load(cur, w, lane, v); }
    for (; j < jend; j += jstep) {
        const P0Tile cur = p0_tile(F, A, p0_map(layer, j));
#pragma unroll
        for (int i = 0; i < 16; ++i) { v2u o; o.x = pk2(v[i].x, v[i].y); o.y = pk2(v[i].z, v[i].w); *(LAS v2u*)(img + (16 * w + i) * P0_PB + lane * 8) = o; }
        __syncthreads();
        if (j + jstep < jend) { const P0Tile nx = p0_tile(F, A, p0_map(layer, j + jstep)); p0_tile_load(nx, w, lane, v); }
        if (cur.fp8) {
            const float sc_ = (cur.fp8 == 2) ? WGU_SCALE : WDN_SCALE;
#pragma unroll
            for (int kh = 0; kh < 2; ++kh)
#pragma unroll
                for (int c = 0; c < 2; ++c) {
                    const v4u f0 = __builtin_bit_cast(v4u, tr8(img + (64 * kh + 16 * g + q) * P0_PB + (32 * w + 16 * c + 4 * p) * 2, P0_PB));
                    const v4u f1 = __builtin_bit_cast(v4u, tr8(img + (64 * kh + 16 * g + 8 + q) * P0_PB + (32 * w + 16 * c + 4 * p) * 2, P0_PB));
                    v4u o8;
                    o8.x = pg8::pk4_fp8(bflo(f0.x) * sc_, bfhi(f0.x) * sc_, bflo(f0.y) * sc_, bfhi(f0.y) * sc_); o8.y = pg8::pk4_fp8(bflo(f0.z) * sc_, bfhi(f0.z) * sc_, bflo(f0.w) * sc_, bfhi(f0.w) * sc_);
                    o8.z = pg8::pk4_fp8(bflo(f1.x) * sc_, bfhi(f1.x) * sc_, bflo(f1.y) * sc_, bfhi(f1.y) * sc_); o8.w = pg8::pk4_fp8(bflo(f1.z) * sc_, bfhi(f1.z) * sc_, bflo(f1.w) * sc_, bfhi(f1.w) * sc_);
                    *(GAS v4u*)((unsigned char*)cur.dst + (size_t)(32 * w + 16 * c + l15) * 1024 + 64 * kh + 16 * g) = o8;
                }
        } else {
#pragma unroll
            for (int kb = 0; kb < 4; ++kb)
#pragma unroll
                for (int c = 0; c < 2; ++c) {
                    const pg8::bf16x8 fr = tr8(img + (32 * kb + 8 * g + q) * P0_PB + (32 * w + 16 * c + 4 * p) * 2, P0_PB);
                    *(GAS pg8::bf16x8*)(cur.dst + (size_t)(32 * w + 16 * c + l15) * cur.ldd + 32 * kb + 8 * g) = fr;
                }
        }
        __syncthreads();
    }
}
__device__ __forceinline__ void p0_weights(Frame& F, const Args& A) {
    bf16* wp = (bf16*)(F.ws + WS_WP);
    p0_convert(F, A, -1, 12288 + F.vcu, F.G, 12768);
    for (int i = F.vcu * NTHR + F.tid; i < 2 * 4 * 128 * 128; i += F.G * NTHR) { const int mtx = i >> 14, d = (i >> 7) & 127, c = i & 127, li = mtx >> 2, gg = mtx & 3;
        wp[(size_t)li * 512 * 512 + (size_t)(gg * 128 + d) * 512 + gg * 128 + c] = (bf16)f2bf(A.in[2][(size_t)mtx * 16384 + c * 128 + d]); }
    for (int i = (F.vcu * NTHR + F.tid); i < 2 * 512 * 64; i += F.G * NTHR) {
        const int li = i / (512 * 64), rem = i % (512 * 64), row = rem / 64, ch = rem % 64;
        if ((row >> 7) != (ch >> 4)) *(GAS v4u*)(wp + (size_t)li * 512 * 512 + (size_t)row * 512 + ch * 8) = (v4u){0u, 0u, 0u, 0u};
    }
}

__device__ __forceinline__ void moe_tables(Frame& F, int layer) {
    if (F.tid < 64) {
        const int e = F.tid & 31;
        const unsigned n = __hip_atomic_load((unsigned*)(F.ctl + CW_CNT + (layer * 32 + e) * 64), RLX_AGENT), t = (n + 255u) >> 8;
        unsigned incl = t;
#pragma unroll
        for (int o = 1; o < 32; o <<= 1) { const unsigned up = __shfl_up(incl, o, 32); if (e >= o) incl += up; }
        const unsigned tb = incl - t;
        if (F.tid < 32) {
            F.MISC[MW_CNT + e] = n; F.MISC[MW_ROWBASE + e] = tb * 256u; F.MISC[MW_TBASE + e] = tb;
            for (unsigned k = 0; k < t; ++k) F.MISC[MW_TILEE + tb + k] = (unsigned)e;
            if (e == 31) { F.MISC[MW_ROWBASE + 32] = incl * 256u; F.MISC[MW_NTILES] = incl; }
        }
    }
    __syncthreads();
}
constexpr int XS_LD = 1028;
template <int MODE>
__device__ __forceinline__ void rw_phase(Frame& F, const Args& A, int layer) {
    LAS float* xs = (LAS float*)(F.lds + RING_OFF);
    LAS float* part = (LAS float*)(F.lds + RING_OFF + 16 * XS_LD * 4);
    const int lane = F.lane, w = F.wave, tid = F.tid;
    const float* pw = nullptr; size_t ldw = 0; int ncols = 0; const float* pbias = nullptr;
    if (MODE == 1) { pw = A.in[19] + (size_t)layer * 1024 * 32; ldw = 32; ncols = 32; pbias = A.in[20] + layer * 32; }
    else { const int nl = (MODE == 0) ? 0 : layer + 1;
        if (nl < DEPTH) { if (nl & 1) { pw = A.in[10] + (size_t)(nl >> 1) * 1024 * ODD_IN + NO_P; ldw = ODD_IN; ncols = 16; } else { pw = A.in[1] + (size_t)(nl >> 1) * 1024 * EVEN_IN + NE_P; ldw = EVEN_IN; ncols = 8; } } }
    const float* lg = nullptr; const float* lb = nullptr;
    if (MODE == 1) { lg = A.in[15] + layer * D; lb = A.in[16] + layer * D; }
    if (MODE == 2) { lg = A.in[17] + layer * D; lb = A.in[18] + layer * D; }
    bf16* XB = (bf16*)(F.ws + WS_XB); bf16* X1B = (bf16*)(F.ws + WS_X1B);
    const bf16* PRE = (const bf16*)(F.ws + WS_PRE); const bf16* Y = (const bf16*)(F.ws + WS_Y); float* GATES = (float*)(F.ws + WS_GATES);
    float* GATE = (float*)(F.ws + WS_GATE); int* SLOT = (int*)(F.ws + WS_SLOT); int* LIST = (int*)(F.ws + WS_LIST);
    if (MODE == 1) { if (tid < 32) F.MISC[MW_LCNT + tid] = 0u; __syncthreads(); }
    if (MODE == 2 && MK_SPLIT) moe_tables(F, layer);
    float bw0[8][4], bw1[8][4];
    { const int kq = lane >> 4, c0 = lane & 15, c1 = 16 + (lane & 15);
#pragma unroll
        for (int st = 0; st < 8; ++st)
#pragma unroll
            for (int j = 0; j < 4; ++j) { const int k = 128 * w + 16 * st + 4 * kq + j;
                bw0[st][j] = (ncols > 0 && c0 < ncols) ? pw[(size_t)k * ldw + c0] : 0.f; bw1[st][j] = (MODE == 1 && ncols > 0 && c1 < ncols) ? pw[(size_t)k * ldw + c1] : 0.f; } }
    f32x4 lgv[4], lbv[4];
#pragma unroll
    for (int j = 0; j < 4; ++j) { lgv[j] = (MODE != 0) ? *((const GAS f32x4*)lg + lane + 64 * j) : (f32x4){1.f, 1.f, 1.f, 1.f}; lbv[j] = (MODE != 0) ? *((const GAS f32x4*)lb + lane + 64 * j) : (f32x4){0.f, 0.f, 0.f, 0.f}; }
    int srow = 0, gbits = 0;
    if (MODE == 2) { const int tl = F.vcu + (lane >> 3) * F.G;
        if (tl < M / 16) { const int tk = (tl * 16 + 2 * w + ((lane >> 2) & 1)) * 4 + (lane & 3); const int idx = SLOT[tk]; srow = (int)F.MISC[MW_TBASE + (idx >> 14)] * 256 + (idx & 16383); gbits = __builtin_bit_cast(int, GATE[tk]); } }
    f32x4 rx[2][4]; v2u xx[2][4], yy[2][4][4]; float gk[2][4];
#define RW_ISSUE(tile_, tc_) do { const int tok0_ = (tile_) * 16 + 2 * w; \
        if (MODE == 0) { _Pragma("unroll") for (int rr = 0; rr < 2; ++rr) { const GAS f32x4* xr = (const GAS f32x4*)(A.in[0] + (size_t)(tok0_ + rr) * D) + lane; _Pragma("unroll") for (int j = 0; j < 4; ++j) rx[rr][j] = xr[64 * j]; } } \
        else if (MODE == 1) { _Pragma("unroll") for (int rr = 0; rr < 2; ++rr) { const GAS v2u* xr = (const GAS v2u*)(PRE + (size_t)(tok0_ + rr) * D) + lane; _Pragma("unroll") for (int j = 0; j < 4; ++j) xx[rr][j] = xr[64 * j]; } } \
        else { _Pragma("unroll") for (int rr = 0; rr < 2; ++rr) _Pragma("unroll") for (int k = 0; k < 4; ++k) { const int li = (tc_) * 8 + rr * 4 + k; const int s = __builtin_amdgcn_readlane(srow, li); gk[rr][k] = __builtin_bit_cast(float, __builtin_amdgcn_readlane(gbits, li)); \
                    const GAS v2u* yr = (const GAS v2u*)(Y + (size_t)s * D) + lane; _Pragma("unroll") for (int j = 0; j < 4; ++j) yy[rr][k][j] = yr[64 * j]; } \
            _Pragma("unroll") for (int rr = 0; rr < 2; ++rr) { const GAS v2u* xr = (const GAS v2u*)(X1B + (size_t)(tok0_ + rr) * D) + lane; _Pragma("unroll") for (int j = 0; j < 4; ++j) xx[rr][j] = xr[64 * j]; } } } while (0)
    int tcount = 0;
    if (F.vcu < M / 16) RW_ISSUE(F.vcu, 0);
    for (int tile = F.vcu; tile < M / 16; tile += F.G, ++tcount) {
        f32x4 vv[2][4];
#pragma unroll
        for (int rr = 0; rr < 2; ++rr)
#pragma unroll
            for (int j = 0; j < 4; ++j) {
                if (MODE == 0) vv[rr][j] = rx[rr][j];
                else { f32x4 a = (f32x4){bflo(xx[rr][j].x), bfhi(xx[rr][j].x), bflo(xx[rr][j].y), bfhi(xx[rr][j].y)};
                    if (MODE == 2) { a = a * ALPHA;
#pragma unroll
                        for (int k = 0; k < 4; ++k) { const v2u y2 = yy[rr][k][j]; const float g = gk[rr][k]; a.x += bflo(y2.x) * g; a.y += bfhi(y2.x) * g; a.z += bflo(y2.y) * g; a.w += bfhi(y2.y) * g; } }
                    vv[rr][j] = a; } }
        if (tile + F.G < M / 16) RW_ISSUE(tile + F.G, tcount + 1);
#pragma unroll
        for (int rr = 0; rr < 2; ++rr) {
            const int r = 2 * w + rr, tok = tile * 16 + r;
            f32x4 v[4];
#pragma unroll
            for (int j = 0; j < 4; ++j) v[j] = vv[rr][j];
            if (MODE != 0) {
                float s = 0.f;
#pragma unroll
                for (int j = 0; j < 4; ++j) s += (v[j].x + v[j].y) + (v[j].z + v[j].w);
                const float mean = wave_sum(s) * (1.f / D); float s2 = 0.f;
#pragma unroll
                for (int j = 0; j < 4; ++j) { v[j] = v[j] - mean; s2 += (v[j].x * v[j].x + v[j].y * v[j].y) + (v[j].z * v[j].z + v[j].w * v[j].w); }
                const float rstd = __builtin_amdgcn_rsqf(wave_sum(s2) * (1.f / D) + LN_EPS);
#pragma unroll
                for (int j = 0; j < 4; ++j) v[j] = v[j] * rstd * lgv[j] + lbv[j];
                if (MODE == 2 && layer == DEPTH - 1) { GAS f32x4* o4 = (GAS f32x4*)(F.out + (size_t)tok * D) + lane;
#pragma unroll
                    for (int j = 0; j < 4; ++j) o4[64 * j] = v[j]; }
            }
            bf16* bo = (MODE == 1) ? X1B : XB;
            GAS v2u* o8 = (GAS v2u*)(bo + (size_t)tok * D) + lane;
            if (!(MODE == 2 && layer == DEPTH - 1)) {
#pragma unroll
                for (int j = 0; j < 4; ++j) { v2u p; p.x = pk2(v[j].x, v[j].y); p.y = pk2(v[j].z, v[j].w); o8[64 * j] = p; } }
            if (MODE == 1 && MOE_FP8_GU) { GAS unsigned* o4 = (GAS unsigned*)(F.ws + WS_X1F8 + (size_t)tok * D) + lane;
#pragma unroll
                for (int j = 0; j < 4; ++j) o4[64 * j] = pg8::pk4_fp8(v[j].x, v[j].y, v[j].z, v[j].w); }
            if (ncols > 0) {
#pragma unroll
                for (int j = 0; j < 4; ++j) *(LAS f32x4*)(xs + r * XS_LD + 4 * lane + 256 * j) = v[j]; }
        }
        if (ncols > 0) __syncthreads();
        if (ncols > 0) {
            f32x4 acc0 = {0.f, 0.f, 0.f, 0.f}, acc1 = {0.f, 0.f, 0.f, 0.f};
            const int prow = lane & 15, kq = lane >> 4, c0 = lane & 15, c1 = 16 + (lane & 15);
#pragma unroll
            for (int st = 0; st < 8; ++st) {
                const int k0 = 128 * w + 16 * st + 4 * kq;
                const f32x4 a = *(const LAS f32x4*)(xs + prow * XS_LD + k0);
#pragma unroll
                for (int j = 0; j < 4; ++j) {
                    acc0 = __builtin_amdgcn_mfma_f32_16x16x4f32(a[j], bw0[st][j], acc0, 0, 0, 0);
                    if (MODE == 1) acc1 = __builtin_amdgcn_mfma_f32_16x16x4f32(a[j], bw1[st][j], acc1, 0, 0, 0);
                }
            }
#pragma unroll
            for (int g = 0; g < 4; ++g) { part[(w * 16 + kq * 4 + g) * 32 + c0] = acc0[g]; part[(w * 16 + kq * 4 + g) * 32 + c1] = acc1[g]; }
        }
        __syncthreads();
        if (ncols > 0) {
            const int r = tid >> 5, c = tid & 31, tok = tile * 16 + r;
            float val = 0.f;
#pragma unroll
            for (int ww = 0; ww < 8; ++ww) val += part[(ww * 16 + r) * 32 + c];
            if (MODE != 1) { if (c < ncols) GATES[tok * 16 + c] = val; }
            else {
                val += pbias[c];
                float cur = val; float selv[4]; int seli[4];
#pragma unroll
                for (int k = 0; k < 4; ++k) {
                    float bv = cur; int bi = c;
#pragma unroll
                    for (int off = 16; off >= 1; off >>= 1) { const float ov = __shfl_xor(bv, off); const int oi = __shfl_xor(bi, off); if (ov > bv || (ov == bv && oi < bi)) { bv = ov; bi = oi; } }
                    selv[k] = bv; seli[k] = bi; if (c == bi) cur = -3.0e38f;
                }
                if (c < 4) {
                    const float e0 = 1.f, e1 = __expf(selv[1] - selv[0]), e2 = __expf(selv[2] - selv[0]), e3 = __expf(selv[3] - selv[0]);
                    const float inv = __builtin_amdgcn_rcpf(e0 + e1 + e2 + e3);
                    const float ge = (c == 0) ? e0 : (c == 1) ? e1 : (c == 2) ? e2 : e3;
                    const int ee = (c == 0) ? seli[0] : (c == 1) ? seli[1] : (c == 2) ? seli[2] : seli[3];
                    GATE[tok * 4 + c] = ge * inv;
                    const unsigned rank = __hip_atomic_fetch_add((LAS unsigned*)(F.lds + MISC_OFF) + MW_LCNT + ee, 1u, __ATOMIC_RELAXED, __HIP_MEMORY_SCOPE_WORKGROUP);
                    F.MISC[MW_PICK + tcount * 64 + r * 4 + c] = (unsigned)ee | (rank << 8);
                }
            }
        }
        __syncthreads();
    }
    if (MODE == 1) {
        if (tid < 32) { const unsigned n = F.MISC[MW_LCNT + tid]; unsigned base = 0u; if (n) base = __hip_atomic_fetch_add((unsigned*)(F.ctl + CW_CNT + (layer * 32 + tid) * 64), n, RLX_AGENT); F.MISC[MW_WBASE + tid] = base; }
        __syncthreads();
        for (int i = tid; i < tcount * 64; i += NTHR) { const int tc = i >> 6, r = (i >> 2) & 15, k = i & 3; const int tok = (F.vcu + tc * F.G) * 16 + r;
            const unsigned pk = F.MISC[MW_PICK + i]; const int idx = (int)((pk & 0xffu) * 16384u + F.MISC[MW_WBASE + (pk & 0xffu)] + (pk >> 8)); SLOT[tok * 4 + k] = idx; LIST[idx] = tok; }
        __syncthreads();
    }
}

constexpr size_t WS_QW = WS_QK, WS_KW = WS_QK + 16 * MiB, WS_ST = WS_XS;
constexpr size_t WS_BT = WS_H, WS_CM = WS_H + 256 * 1024, WS_RMAX = WS_H + 512 * 1024, WS_GC = WS_H + 516 * 1024, WS_MPREV = WS_H + 520 * 1024, WS_EBL = WS_H + 1 * MiB;
constexpr int KP = 136;

__device__ __forceinline__ pg8::f32x4 mma16(pg8::bf16x8 a, pg8::bf16x8 b, pg8::f32x4 c) { return __builtin_amdgcn_mfma_f32_16x16x32_bf16(a, b, c, 0, 0, 0); }

__device__ __forceinline__ void even_prep2(Frame& F, const Args& A, int li) {
    const bf16* P = (const bf16*)(F.ws + WS_P); bf16* QW = (bf16*)(F.ws + WS_QW); bf16* KW = (bf16*)(F.ws + WS_KW); bf16* DD = (bf16*)(F.ws + WS_DD);
    const float* GATES = (const float*)(F.ws + WS_GATES);
    float* BT = (float*)(F.ws + WS_BT); float* CM = (float*)(F.ws + WS_CM); float* RMAX = (float*)(F.ws + WS_RMAX); float* GC = (float*)(F.ws + WS_GC);
    const float* cw = A.in[4] + (size_t)li * 4 * 1024; const float* cb = A.in[5] + (size_t)li * 1024;
    LAS float* gs = (LAS float*)(F.lds + RING_OFF); LAS float* ls = gs + 256; LAS float* rs = ls + 256; LAS float* fac = rs + 256;
    const int tid = F.tid;
    for (int unit = F.vcu; unit < 256; unit += F.G) {
        const int tok0 = (unit >> 6) * SEQ + (unit & 63) * 64;
        v4u rows[19];
        { const int ch = (tid & 127) * 8, tb = tok0 + 16 * (tid >> 7), s0 = tb & (SEQ - 1);
#pragma unroll
            for (int r = 0; r < 19; ++r) { rows[r] = (v4u){0u, 0u, 0u, 0u}; if (s0 - 3 + r >= 0) rows[r] = *(const GAS v4u*)(P + (size_t)(tb - 3 + r) * LDP + 512 + ch); } }
        if (tid < 256) { const int t = tid >> 2, h = tid & 3; gs[tid] = GATES[(size_t)(tok0 + t) * 16 + h] + A.in[6][li * 4 + h]; ls[tid] = logsigmoidf_(GATES[(size_t)(tok0 + t) * 16 + 4 + h] + A.in[7][li * 4 + h]); }
        __syncthreads();
        if (tid < 256) {
            const int h = tid >> 6, t = tid & 63;
            float bs = ls[t * 4 + h];
#pragma unroll
            for (int o = 1; o < 64; o <<= 1) { const float up = __shfl_up(bs, o); if (t >= o) bs += up; }
            const float r = gs[t * 4 + h] - bs; float cm = r;
#pragma unroll
            for (int o = 1; o < 64; o <<= 1) { const float up = __shfl_up(cm, o); if (t >= o) cm = fmaxf(cm, up); }
            const float rmax = __shfl(cm, 63), gsum = __shfl(bs, 63);
            BT[(size_t)(tok0 + t) * 4 + h] = bs; CM[(size_t)(tok0 + t) * 4 + h] = cm;
            if (t == 0) { RMAX[unit * 4 + h] = rmax; GC[unit * 4 + h] = gsum; }
            fac[t * 4 + h] = __expf(r - rmax) * 0.08838834764831845f;
        }
        __syncthreads();
        {
            const int ch = (tid & 127) * 8, tb = tok0 + 16 * (tid >> 7);
            float wv[4][8], bv[8];
#pragma unroll
            for (int i = 0; i < 8; ++i) { bv[i] = cb[ch + i];
#pragma unroll
                for (int jj = 0; jj < 4; ++jj) wv[jj][i] = cw[jj * 1024 + ch + i]; }
#pragma unroll
            for (int t = 0; t < 16; ++t) {
                float acc[8];
#pragma unroll
                for (int i = 0; i < 8; ++i) acc[i] = bv[i];
#pragma unroll
                for (int jj = 0; jj < 4; ++jj) { const v4u pv = rows[t + jj];
                    acc[0] += wv[jj][0] * bflo(pv.x); acc[1] += wv[jj][1] * bfhi(pv.x); acc[2] += wv[jj][2] * bflo(pv.y); acc[3] += wv[jj][3] * bfhi(pv.y);
                    acc[4] += wv[jj][4] * bflo(pv.z); acc[5] += wv[jj][5] * bfhi(pv.z); acc[6] += wv[jj][6] * bflo(pv.w); acc[7] += wv[jj][7] * bfhi(pv.w); }
                const int tl = 16 * (tid >> 7) + t;
                const float sc = (ch >= 512) ? fac[tl * 4 + ((ch - 512) >> 7)] : 1.0f;
#pragma unroll
                for (int i = 0; i < 8; ++i) acc[i] = acc[i] * sigmoidf_(acc[i]) * sc;
                v4u o; o.x = pk2(acc[0], acc[1]); o.y = pk2(acc[2], acc[3]); o.z = pk2(acc[4], acc[5]); o.w = pk2(acc[6], acc[7]);
                if (ch < 512) *(GAS v4u*)(QW + (size_t)(tb + t) * 512 + ch) = o; else *(GAS v4u*)(KW + (size_t)(tb + t) * 512 + ch - 512) = o;
            }
        }
        {
            const int ch = (tid & 63) * 8, tb = tok0 + 8 * (tid >> 6), s0 = tb & (SEQ - 1), win = 2 << (ch >> 7);
            v4u rows[23];
#pragma unroll
            for (int r = 0; r < 23; ++r) { rows[r] = (v4u){0u, 0u, 0u, 0u}; if (r >= 16 - win && s0 - 15 + r >= 0) rows[r] = *(const GAS v4u*)(P + (size_t)(tb - 15 + r) * LDP + ch); }
#pragma unroll
            for (int t = 0; t < 8; ++t) {
                const int s = s0 + t, n = (s + 1 < win) ? (s + 1) : win;
                float acc[8] = {0.f, 0.f, 0.f, 0.f, 0.f, 0.f, 0.f, 0.f};
#pragma unroll
                for (int jj = 0; jj < 16; ++jj) { if (jj < win) { const v4u pv = rows[15 + t - jj];
                        acc[0] += bflo(pv.x); acc[1] += bfhi(pv.x); acc[2] += bflo(pv.y); acc[3] += bfhi(pv.y); acc[4] += bflo(pv.z); acc[5] += bfhi(pv.z); acc[6] += bflo(pv.w); acc[7] += bfhi(pv.w); } }
                const v4u u = rows[15 + t]; const float inv = __builtin_amdgcn_rcpf((float)n);
                const float u0[8] = {bflo(u.x), bfhi(u.x), bflo(u.y), bfhi(u.y), bflo(u.z), bfhi(u.z), bflo(u.w), bfhi(u.w)};
#pragma unroll
                for (int i = 0; i < 8; ++i) acc[i] = acc[i] * inv - u0[i];
                v4u o; o.x = pk2(acc[0], acc[1]); o.y = pk2(acc[2], acc[3]); o.z = pk2(acc[4], acc[5]); o.w = pk2(acc[6], acc[7]);
                *(GAS v4u*)(DD + (size_t)(tb + t) * 512 + ch) = o;
            }
        }
        __syncthreads();
    }
}
__device__ __forceinline__ void odd_prep(Frame& F, const Args& A, int li) {
    const bf16* P = (const bf16*)(F.ws + WS_P); bf16* QW = (bf16*)(F.ws + WS_QW); bf16* KW = (bf16*)(F.ws + WS_KW); float* EBL = (float*)(F.ws + WS_EBL);
    const float* GATES = (const float*)(F.ws + WS_GATES);
    const float* w2 = A.in[11] + (size_t)li * 16 * 512; const float* gb = A.in[12] + (size_t)li * 512;
    LAS float* gl = (LAS float*)(F.lds + RING_OFF);
    const int tid = F.tid, d = tid;
    float wc[16];
#pragma unroll
    for (int r = 0; r < 16; ++r) wc[r] = w2[r * 512 + d];
    const float gbv = gb[d];
    for (int unit = F.vcu; unit < 256; unit += F.G) {
        const int tok0 = (unit >> 6) * SEQ + (unit & 63) * 64;
        for (int i = tid; i < 1024; i += NTHR) gl[i] = GATES[(size_t)(tok0 + (i >> 4)) * 16 + (i & 15)];
        __syncthreads();
        float Bc = 0.f;
        unsigned short qn[8], kn[8];
#pragma unroll
        for (int j = 0; j < 8; ++j) { qn[j] = P[(size_t)(tok0 + j) * LDP + d]; kn[j] = P[(size_t)(tok0 + j) * LDP + 512 + d]; }
        for (int t0 = 0; t0 < 64; t0 += 8) {
            unsigned short qv[8], kv[8];
#pragma unroll
            for (int j = 0; j < 8; ++j) { qv[j] = qn[j]; kv[j] = kn[j]; }
            { const int tn = (t0 + 8 < 64) ? t0 + 8 : t0;
#pragma unroll
                for (int j = 0; j < 8; ++j) { qn[j] = P[(size_t)(tok0 + tn + j) * LDP + d]; kn[j] = P[(size_t)(tok0 + tn + j) * LDP + 512 + d]; } }
#pragma unroll
            for (int j = 0; j < 8; ++j) {
                const int t = t0 + j;
                float z = gbv;
#pragma unroll
                for (int r = 0; r < 16; ++r) z += gl[t * 16 + r] * wc[r];
                Bc += logsigmoidf_(z) * 0.0625f;
                QW[(size_t)(tok0 + t) * 512 + d] = (bf16)f2bf(bf2f(qv[j]) * 0.08838834764831845f * __expf(Bc));
                KW[(size_t)(tok0 + t) * 512 + d] = (bf16)f2bf(bf2f(kv[j]) * __expf(-Bc));
            }
        }
        EBL[unit * 512 + d] = __expf(Bc);
        __syncthreads();
    }
}
template <bool EVEN>
__device__ __forceinline__ void stage_rows128(Frame& F, const bf16* src, int tok0, int h, LAS unsigned char* dst) {
    for (int i = F.tid; i < 1024; i += NTHR) { const int t = i >> 4, ch = i & 15; const v4u x = *(const GAS v4u*)(src + (size_t)(tok0 + t) * 512 + h * 128 + ch * 8); *(LAS v4u*)(dst + t * (KP * 2) + ch * 16) = x; }
}
template <bool EVEN>
__device__ __forceinline__ void stage_v(Frame& F, int tok0, int h, LAS unsigned char* Vs) {
    constexpr int DV = EVEN ? 128 : 256, DVP = EVEN ? 144 : 256, VPB = (DVP + 8) * 2, CH = DV / 8;
    const bf16* P = (const bf16*)(F.ws + WS_P) + (EVEN ? 1536 : 1024) + h * DV;
    for (int i = F.tid; i < 64 * CH; i += NTHR) { const int t = i / CH, ch = i % CH; const v4u x = *(const GAS v4u*)(P + (size_t)(tok0 + t) * LDP + ch * 8); *(LAS v4u*)(Vs + t * VPB + ch * 16) = x; }
    if (EVEN) { if (F.tid < 128) { const int t = F.tid >> 1, ch = F.tid & 1; v4u x = {0u, 0u, 0u, 0u}; if (ch == 0) x.x = 0x00003F80u; *(LAS v4u*)(Vs + t * VPB + (128 + ch * 8) * 2) = x; } }
}
__device__ __forceinline__ void ld_rows128(Frame& F, const bf16* src, int tok0, int h, v4u (&r)[2]) {
#pragma unroll
    for (int k = 0; k < 2; ++k) { const int i = F.tid + NTHR * k, t = i >> 4, ch = i & 15; r[k] = *(const GAS v4u*)(src + (size_t)(tok0 + t) * 512 + h * 128 + ch * 8); }
}
__device__ __forceinline__ void st_rows128(Frame& F, LAS unsigned char* dst, const v4u (&r)[2]) {
#pragma unroll
    for (int k = 0; k < 2; ++k) { const int i = F.tid + NTHR * k, t = i >> 4, ch = i & 15; *(LAS v4u*)(dst + t * (KP * 2) + ch * 16) = r[k]; }
}
template <bool EVEN>
__device__ __forceinline__ void ld_v(Frame& F, int tok0, int h, v4u (&r)[EVEN ? 2 : 4]) {
    constexpr int DV = EVEN ? 128 : 256, CH = DV / 8, NK = EVEN ? 2 : 4;
    const bf16* P = (const bf16*)(F.ws + WS_P) + (EVEN ? 1536 : 1024) + h * DV;
#pragma unroll
    for (int k = 0; k < NK; ++k) { const int i = F.tid + NTHR * k, t = i / CH, ch = i % CH; r[k] = *(const GAS v4u*)(P + (size_t)(tok0 + t) * LDP + ch * 8); }
}
template <bool EVEN>
__device__ __forceinline__ void st_v(Frame& F, LAS unsigned char* Vs, const v4u (&r)[EVEN ? 2 : 4]) {
    constexpr int DV = EVEN ? 128 : 256, DVP = EVEN ? 144 : 256, VPB = (DVP + 8) * 2, CH = DV / 8, NK = EVEN ? 2 : 4;
#pragma unroll
    for (int k = 0; k < NK; ++k) { const int i = F.tid + NTHR * k, t = i / CH, ch = i % CH; *(LAS v4u*)(Vs + t * VPB + ch * 16) = r[k]; }
    if (EVEN) { if (F.tid < 128) { const int t = F.tid >> 1, ch = F.tid & 1; v4u x = {0u, 0u, 0u, 0u}; if (ch == 0) x.x = 0x00003F80u; *(LAS v4u*)(Vs + t * VPB + (128 + ch * 8) * 2) = x; } }
}
template <bool EVEN>
__device__ __forceinline__ void mix_phaseA(Frame& F) {
    constexpr int DVP = EVEN ? 144 : 256, NTW = EVEN ? 1 : 2, VPB = (DVP + 8) * 2, KPB = KP * 2;
    LAS unsigned char* KWs = F.lds + RING_OFF; LAS unsigned char* Vs = KWs + 64 * KPB;
    const bf16* KW = (const bf16*)(F.ws + WS_KW); bf16* ST = (bf16*)(F.ws + WS_ST);
    const int lane = F.lane, w = F.wave, g = lane >> 4, q = (lane & 15) >> 2, p = lane & 3;
    v4u rk[2], rv[EVEN ? 2 : 4];
    if (F.vcu * 4 < 1024) { const int unit = F.vcu, b = unit >> 6, c = unit & 63; ld_rows128(F, KW, b * SEQ + c * 64, 0, rk); ld_v<EVEN>(F, b * SEQ + c * 64, 0, rv); }
    for (int uu = F.vcu * 4; uu < 1024; uu += F.G * 4)
    for (int h = 0; h < 4; ++h) {
        const int unit = uu >> 2, b = unit >> 6, c = unit & 63, bh = b * 4 + h, u = bh * 64 + c, tok0 = b * SEQ + c * 64;
        st_rows128(F, KWs, rk); st_v<EVEN>(F, Vs, rv);
        __syncthreads();
        { const int nh = (h + 1) & 3, nuu = (h == 3) ? uu + F.G * 4 : uu;
            if (nuu < 1024) { const int nunit = nuu >> 2, nb = nunit >> 6, nc = nunit & 63; ld_rows128(F, KW, nb * SEQ + nc * 64, nh, rk); ld_v<EVEN>(F, nb * SEQ + nc * 64, nh, rv); } }
        pg8::f32x4 acc[NTW][8]; pg8::f32x4 accx = {0.f, 0.f, 0.f, 0.f};
#pragma unroll
        for (int j = 0; j < NTW; ++j)
#pragma unroll
            for (int mt = 0; mt < 8; ++mt) acc[j][mt] = (pg8::f32x4){0.f, 0.f, 0.f, 0.f};
#pragma unroll
        for (int ks = 0; ks < 2; ++ks) {
            pg8::bf16x8 bv[NTW], bx;
#pragma unroll
            for (int j = 0; j < NTW; ++j) bv[j] = tr8(Vs + (32 * ks + 8 * g + q) * VPB + (16 * (w * NTW + j) + 4 * p) * 2, VPB);
            if (EVEN) bx = tr8(Vs + (32 * ks + 8 * g + q) * VPB + (128 + 4 * p) * 2, VPB);
#pragma unroll
            for (int mt = 0; mt < 8; ++mt) {
                const pg8::bf16x8 a = tr8(KWs + (32 * ks + 8 * g + q) * KPB + (16 * mt + 4 * p) * 2, KPB);
#pragma unroll
                for (int j = 0; j < NTW; ++j) acc[j][mt] = mma16(a, bv[j], acc[j][mt]);
                if (EVEN) { if (mt == w) accx = mma16(a, bx, accx); }
            }
        }
#pragma unroll
        for (int j = 0; j < NTW; ++j)
#pragma unroll
            for (int mt = 0; mt < 8; ++mt) { v2u o; o.x = pk2(acc[j][mt][0], acc[j][mt][1]); o.y = pk2(acc[j][mt][2], acc[j][mt][3]);
                *(GAS v2u*)(ST + ((size_t)u * DVP + 16 * (w * NTW + j) + (lane & 15)) * 128 + 16 * mt + 4 * g) = o; }
        if (EVEN) { v2u o; o.x = pk2(accx[0], accx[1]); o.y = pk2(accx[2], accx[3]); *(GAS v2u*)(ST + ((size_t)u * DVP + 128 + (lane & 15)) * 128 + 16 * w + 4 * g) = o; }
        __syncthreads();
    }
}
template <bool EVEN>
__device__ __forceinline__ void mix_scan(Frame& F, int nwg_s, int idx_s) {
    constexpr int DVP = EVEN ? 144 : 256, NTK = DVP * 16;
    bf16* ST = (bf16*)(F.ws + WS_ST);
    const float* RMAX = (const float*)(F.ws + WS_RMAX); const float* GC = (const float*)(F.ws + WS_GC); float* MPREV = (float*)(F.ws + WS_MPREV); const float* EBL = (const float*)(F.ws + WS_EBL);
    if (idx_s >= 0)
    for (int gi = (F.wave * nwg_s + idx_s) * 64 + F.lane; gi < 16 * NTK; gi += nwg_s * NTHR) {
        const int bh = gi / NTK, rem = gi % NTK, dv = rem >> 4, d8 = rem & 15, b = bh >> 2, h = bh & 3;
        bf16* base = ST + ((size_t)(bh * 64) * DVP + dv) * 128 + d8 * 8;
        float s[8];
#pragma unroll
        for (int i = 0; i < 8; ++i) s[i] = 0.f;
        float m = 0.f;
        for (int c0 = 0; c0 < 64; c0 += 8) {
            v4u uu[8];
#pragma unroll
            for (int k = 0; k < 8; ++k) uu[k] = *(const GAS v4u*)(base + (size_t)(c0 + k) * DVP * 128);
#pragma unroll
            for (int k = 0; k < 8; ++k) {
                const int c = c0 + k;
                const float u8[8] = {bflo(uu[k].x), bfhi(uu[k].x), bflo(uu[k].y), bfhi(uu[k].y), bflo(uu[k].z), bfhi(uu[k].z), bflo(uu[k].w), bfhi(uu[k].w)};
                v4u o;
                if (EVEN) {
                    const float rmax = RMAX[(b * 64 + c) * 4 + h], gc = GC[(b * 64 + c) * 4 + h];
                    const float Mc = fmaxf(m, rmax), al = __expf(m - Mc), be = __expf(rmax - Mc), kap = __expf(m - rmax);
                    o.x = pk2(kap * s[0], kap * s[1]); o.y = pk2(kap * s[2], kap * s[3]); o.z = pk2(kap * s[4], kap * s[5]); o.w = pk2(kap * s[6], kap * s[7]);
                    if (dv == 0 && d8 == 0) MPREV[bh * 64 + c] = m;
#pragma unroll
                    for (int i = 0; i < 8; ++i) s[i] = al * s[i] + be * u8[i];
                    m = gc + Mc;
                } else {
                    o.x = pk2(s[0], s[1]); o.y = pk2(s[2], s[3]); o.z = pk2(s[4], s[5]); o.w = pk2(s[6], s[7]);
                    const f32x4 a0 = *(const GAS f32x4*)(EBL + (size_t)(b * 64 + c) * 512 + h * 128 + d8 * 8), a1 = *(const GAS f32x4*)(EBL + (size_t)(b * 64 + c) * 512 + h * 128 + d8 * 8 + 4);
                    const float al[8] = {a0.x, a0.y, a0.z, a0.w, a1.x, a1.y, a1.z, a1.w};
#pragma unroll
                    for (int i = 0; i < 8; ++i) s[i] = al[i] * (s[i] + u8[i]);
                }
                *(GAS v4u*)(base + (size_t)c * DVP * 128) = o;
            }
        }
    }
}
template <bool EVEN>
__device__ __forceinline__ void mix_phaseC(Frame& F, const Args& A, int li) {
    constexpr int DV = EVEN ? 128 : 256, DVP = EVEN ? 144 : 256, NTW = EVEN ? 1 : 2, VPB = (DVP + 8) * 2, KPB = KP * 2, PPB = 72 * 2, OP = DVP + 4;
    LAS unsigned char* QWs = F.lds + RING_OFF; LAS unsigned char* KWs = QWs + 64 * KPB; LAS unsigned char* Vs = KWs + 64 * KPB; LAS unsigned char* PS = F.lds + RING_OFF + 68608;
    LAS float* rho = (LAS float*)(F.lds + RING_OFF + 77824); LAS float* thr = rho + 64; LAS float* OUT = (LAS float*)(F.lds + RING_OFF);
    static_assert(64 * KPB * 2 + 64 * VPB <= 68608 && 64 * OP * 4 <= 68608, "phase C LDS map");
    const bf16* QW = (const bf16*)(F.ws + WS_QW); const bf16* KW = (const bf16*)(F.ws + WS_KW); const bf16* ST = (const bf16*)(F.ws + WS_ST);
    const bf16* P = (const bf16*)(F.ws + WS_P); bf16* MIX = (bf16*)(F.ws + WS_MIX);
    const float* gn = EVEN ? A.in[8] + (size_t)li * 512 : A.in[13] + (size_t)li * 1024;
    const int lane = F.lane, w = F.wave, g = lane >> 4, q = (lane & 15) >> 2, p = lane & 3, l15 = lane & 15;
    v4u rq[2], rk[2], rv[EVEN ? 2 : 4];
    if (F.vcu < 1024) { const int u = F.vcu, bh = u >> 6, c = u & 63, tok0 = (bh >> 2) * SEQ + c * 64, h = bh & 3; ld_rows128(F, QW, tok0, h, rq); ld_rows128(F, KW, tok0, h, rk); ld_v<EVEN>(F, tok0, h, rv); }
    for (int u = F.vcu; u < 1024; u += F.G) {
        const int bh = u >> 6, c = u & 63, b = bh >> 2, h = bh & 3, tok0 = b * SEQ + c * 64;
        pg8::bf16x8 sb[4][NTW], sbx[4];
#pragma unroll
        for (int ks = 0; ks < 4; ++ks) {
#pragma unroll
            for (int j = 0; j < NTW; ++j) sb[ks][j] = *(const GAS pg8::bf16x8*)(ST + ((size_t)u * DVP + 16 * (w * NTW + j) + l15) * 128 + 32 * ks + 8 * g);
            if (EVEN) sbx[ks] = *(const GAS pg8::bf16x8*)(ST + ((size_t)u * DVP + 128 + l15) * 128 + 32 * ks + 8 * g);
        }
        st_rows128(F, QWs, rq); st_rows128(F, KWs, rk); st_v<EVEN>(F, Vs, rv);
        if (EVEN) { if (F.tid < 64) { const int t = F.tid;
                const float cm = ((const float*)(F.ws + WS_CM))[(size_t)(tok0 + t) * 4 + h], bt = ((const float*)(F.ws + WS_BT))[(size_t)(tok0 + t) * 4 + h];
                const float rmax = ((const float*)(F.ws + WS_RMAX))[(b * 64 + c) * 4 + h], mp = ((const float*)(F.ws + WS_MPREV))[u];
                const float Mt = fmaxf(mp, cm); rho[t] = __expf(rmax - Mt); thr[t] = __expf(-(bt + Mt)); } }
        __syncthreads();
        if (u + F.G < 1024) { const int nu = u + F.G, nbh = nu >> 6, nc = nu & 63, ntok0 = (nbh >> 2) * SEQ + nc * 64, nh = nbh & 3;
            ld_rows128(F, QW, ntok0, nh, rq); ld_rows128(F, KW, ntok0, nh, rk); ld_v<EVEN>(F, ntok0, nh, rv); }
        {
            const int mt = w >> 1;
            pg8::f32x4 pa[2] = {{0.f, 0.f, 0.f, 0.f}, {0.f, 0.f, 0.f, 0.f}};
#pragma unroll
            for (int ks = 0; ks < 4; ++ks) {
                const pg8::bf16x8 a = *(const LAS pg8::bf16x8*)(QWs + (16 * mt + l15) * KPB + (32 * ks + 8 * g) * 2);
#pragma unroll
                for (int jj = 0; jj < 2; ++jj) { const int nt = 2 * (w & 1) + jj; const pg8::bf16x8 bb = *(const LAS pg8::bf16x8*)(KWs + (16 * nt + l15) * KPB + (32 * ks + 8 * g) * 2); pa[jj] = mma16(a, bb, pa[jj]); }
            }
#pragma unroll
            for (int jj = 0; jj < 2; ++jj) { const int nt = 2 * (w & 1) + jj, s = 16 * nt + l15;
#pragma unroll
                for (int r = 0; r < 4; ++r) { const int t = 16 * mt + 4 * g + r; *(LAS bf16*)(PS + t * PPB + s * 2) = (bf16)((s <= t) ? f2bf(pa[jj][r]) : 0u); } }
        }
        __syncthreads();
        pg8::f32x4 acc[NTW][4]; pg8::f32x4 accx = {0.f, 0.f, 0.f, 0.f};
#pragma unroll
        for (int j = 0; j < NTW; ++j)
#pragma unroll
            for (int mt = 0; mt < 4; ++mt) acc[j][mt] = (pg8::f32x4){0.f, 0.f, 0.f, 0.f};
#pragma unroll
        for (int ks = 0; ks < 2; ++ks) {
            pg8::bf16x8 bv[NTW], bx;
#pragma unroll
            for (int j = 0; j < NTW; ++j) bv[j] = tr8(Vs + (32 * ks + 8 * g + q) * VPB + (16 * (w * NTW + j) + 4 * p) * 2, VPB);
            if (EVEN) bx = tr8(Vs + (32 * ks + 8 * g + q) * VPB + (128 + 4 * p) * 2, VPB);
#pragma unroll
            for (int mt = 0; mt < 4; ++mt) {
                const pg8::bf16x8 a = *(const LAS pg8::bf16x8*)(PS + (16 * mt + l15) * PPB + (32 * ks + 8 * g) * 2);
#pragma unroll
                for (int j = 0; j < NTW; ++j) acc[j][mt] = mma16(a, bv[j], acc[j][mt]);
                if (EVEN) { if (mt == w) accx = mma16(a, bx, accx); }
            }
        }
#pragma unroll
        for (int ks = 0; ks < 4; ++ks) {
#pragma unroll
            for (int mt = 0; mt < 4; ++mt) {
                const pg8::bf16x8 a = *(const LAS pg8::bf16x8*)(QWs + (16 * mt + l15) * KPB + (32 * ks + 8 * g) * 2);
#pragma unroll
                for (int j = 0; j < NTW; ++j) acc[j][mt] = mma16(a, sb[ks][j], acc[j][mt]);
                if (EVEN) { if (mt == w) accx = mma16(a, sbx[ks], accx); }
            }
        }
        __syncthreads();
#pragma unroll
        for (int j = 0; j < NTW; ++j)
#pragma unroll
            for (int mt = 0; mt < 4; ++mt)
#pragma unroll
                for (int r = 0; r < 4; ++r) OUT[(16 * mt + 4 * g + r) * OP + 16 * (w * NTW + j) + l15] = acc[j][mt][r];
        if (EVEN) { if (w < 4) {
#pragma unroll
                for (int r = 0; r < 4; ++r) OUT[(16 * w + 4 * g + r) * OP + 128 + l15] = accx[r]; } }
        __syncthreads();
        if (EVEN) {
            unsigned og[8];
#pragma unroll
            for (int rr = 0; rr < 8; ++rr) og[rr] = *(const GAS unsigned*)(P + (size_t)(tok0 + 8 * w + rr) * LDP + 2048 + h * 128 + 2 * lane);
            const float g0 = gn[h * 128 + 2 * lane], g1 = gn[h * 128 + 2 * lane + 1];
#pragma unroll
            for (int rr = 0; rr < 8; ++rr) {
                const int t = 8 * w + rr; const size_t tok = (size_t)(tok0 + t);
                const float v0 = OUT[t * OP + 2 * lane], v1 = OUT[t * OP + 2 * lane + 1], den = OUT[t * OP + 128], rh = rho[t];
                const float dd = __builtin_amdgcn_rcpf(fmaxf(fabsf(rh * den), thr[t]));
                float h0 = rh * v0 * dd, h1 = rh * v1 * dd;
                const float mu = wave_sum(h0 + h1) * (1.f / 128.f); h0 -= mu; h1 -= mu;
                const float rs = __builtin_amdgcn_rsqf(wave_sum(h0 * h0 + h1 * h1) * (1.f / 128.f) + LN_EPS);
                const float o0 = h0 * rs * g0 * sigmoidf_(bflo(og[rr])), o1 = h1 * rs * g1 * sigmoidf_(bfhi(og[rr]));
                *(GAS unsigned*)(MIX + tok * 1024 + 512 + h * 128 + 2 * lane) = pk2(o0, o1);
            }
        } else {
            v2u rg[8];
#pragma unroll
            for (int rr = 0; rr < 8; ++rr) rg[rr] = *(const GAS v2u*)(P + (size_t)(tok0 + 8 * w + rr) * LDP + 2048 + h * 256 + 4 * lane);
            const f32x4 gg = *(const GAS f32x4*)(gn + h * 256 + 4 * lane);
#pragma unroll
            for (int rr = 0; rr < 8; ++rr) {
                const int t = 8 * w + rr; const size_t tok = (size_t)(tok0 + t);
                f32x4 v = *(const LAS f32x4*)(OUT + t * OP + 4 * lane);
                const float mu = wave_sum((v.x + v.y) + (v.z + v.w)) * (1.f / 256.f); v = v - mu;
                const float rs = __builtin_amdgcn_rsqf(wave_sum((v.x * v.x + v.y * v.y) + (v.z * v.z + v.w * v.w)) * (1.f / 256.f) + LN_EPS);
                const float r0 = bflo(rg[rr].x), r1 = bfhi(rg[rr].x), r2 = bflo(rg[rr].y), r3 = bfhi(rg[rr].y);
                v2u o; o.x = pk2(v.x * rs * gg.x * (r0 * sigmoidf_(r0)), v.y * rs * gg.y * (r1 * sigmoidf_(r1))); o.y = pk2(v.z * rs * gg.z * (r2 * sigmoidf_(r2)), v.w * rs * gg.w * (r3 * sigmoidf_(r3)));
                *(GAS v2u*)(MIX + tok * 1024 + h * 256 + 4 * lane) = o;
            }
        }
        __syncthreads();
    }
}

#define IN(k) (lo <= (k) && (k) < hi)
#define SEAM(k) do { if (!MK_SPLIT && (k) + 1 < hi) xcd_barrier(bar); } while (0)
template <int layer>
__device__ __forceinline__ void layer_body(Frame& F, const Args& args, const XcdBarrier& bar, const int lo, const int hi) {
        { int t_ = threadIdx.x; asm volatile("" : "+v"(t_)); F.tid = t_; F.lane = t_ & 63; F.wave = __builtin_amdgcn_readfirstlane(t_ >> 6);
          int v_ = F.vcu, g_ = F.G; asm volatile("" : "+s"(v_), "+s"(g_)); F.vcu = v_; F.G = g_; F.ws = args.ws; F.ctl = (gu32*)(args.ws + WS_CTL); }
        const int pb = 1 + layer * NPH, li = layer >> 1; const bool odd = layer & 1;
        bf16* XB = (bf16*)(F.ws + WS_XB); bf16* P = (bf16*)(F.ws + WS_P); bf16* MIX = (bf16*)(F.ws + WS_MIX);
        if (IN(pb + 0)) {
            const bf16* wt = odd ? (const bf16*)(F.ws + WS_WINO) + (size_t)li * NO_P * 1024 : (const bf16*)(F.ws + WS_WINE) + (size_t)li * NE_P * 1024;
            const int N = odd ? NO_P : NE_P;
            pg8::Gemm g{XB, wt, M, N, D}; pg8::StaticOrder S; S.init(M, N, F.G, (int)blockIdx.x);
            pg8::EpiStoreBf16 E{P, LDP, nullptr, 0};
            for (int rep = 0; rep < (PROBE_DUP == 5 ? 2 : 1); ++rep) pg8::gemm_phase<pg8::EpiStoreBf16, pg8::StaticOrder, true, true>(F.lds + RING_OFF, g, S, E);
            SEAM(pb + 0);
        }
        if (IN(pb + 1)) {
            if (odd) odd_prep(F, args, li); else even_prep2(F, args, li);
            if (PROBE_DUP == 4) { if (odd) odd_prep(F, args, li); else even_prep2(F, args, li); }
            VM_WAIT(); __syncthreads();
            if (odd) mix_phaseA<false>(F); else mix_phaseA<true>(F);
            if (PROBE_DUP == 2) { if (odd) mix_phaseA<false>(F); else mix_phaseA<true>(F); }
            SEAM(pb + 1);
        }
        if (IN(pb + 4)) {
            const bool split = !odd && F.G == 256;
            if (odd) mix_scan<false>(F, F.G, F.vcu); else mix_scan<true>(F, split ? 128 : F.G, split ? (int)blockIdx.x - 128 : F.vcu);
            if (!odd) {
                pg8::Gemm g{(const bf16*)(F.ws + WS_DD), (const bf16*)(F.ws + WS_WP) + (size_t)li * 512 * 512, M, 512, 512}; pg8::StaticOrder S; S.init(M, 512, F.G, (int)blockIdx.x);
                pg8::EpiStoreBf16 E{MIX, 1024, args.in[3] + (size_t)li * 512, 0};
                for (int rep = 0; rep < (PROBE_DUP == 5 ? 2 : 1); ++rep) pg8::gemm_phase<pg8::EpiStoreBf16, pg8::StaticOrder, true, true>(F.lds + RING_OFF, g, S, E);
            }
            SEAM(pb + 4);
        }
        if (IN(pb + 5)) { if (odd) mix_phaseC<false>(F, args, li); else mix_phaseC<true>(F, args, li); if (PROBE_DUP == 2) { if (odd) mix_phaseC<false>(F, args, li); else mix_phaseC<true>(F, args, li); } SEAM(pb + 5); }
        if (IN(pb + 6)) {
            pg8::Gemm g{MIX, (const bf16*)(F.ws + WS_WOUT) + (size_t)layer * 1024 * 1024, M, D, D}; pg8::StaticOrder S; S.init(M, D, F.G, (int)blockIdx.x);
            pg8::EpiResBf16 E{(const bf16*)(F.ws + WS_XB), (bf16*)(F.ws + WS_PRE), D, ALPHA};
            for (int rep = 0; rep < (PROBE_DUP == 5 ? 2 : 1); ++rep) pg8::gemm_phase<pg8::EpiResBf16, pg8::StaticOrder, true, true>(F.lds + RING_OFF, g, S, E);
            SEAM(pb + 6);
        }
#ifndef X_NO_RW
        if (IN(pb + 7)) {
            p0_convert(F, args, layer, 1024 + F.vcu, F.G, 3072); __syncthreads();
            rw_phase<1>(F, args, layer); SEAM(pb + 7); }
#endif
        if (IN(pb + 9)) {
            moe_tables(F, layer);
            pg8::Gemm g{(const bf16*)(F.ws + (MOE_FP8_GU ? WS_X1F8 : WS_X1B)), (const bf16*)(F.ws + WS_WGU) + (size_t)layer * 32 * 2048 * 1024 / (MOE_FP8_GU ? 2 : 1), MAXROWS, 32 * 2048, MOE_FP8_GU ? D / 2 : D};
            pg8::MoeOrder S{8, F.G, F.vcu, (int)F.MISC[MW_NTILES] * 8, (const LAS int*)(F.lds + MISC_OFF) + MW_TILEE, (const LAS int*)(F.lds + MISC_OFF) + MW_TBASE, (const LAS int*)(F.lds + MISC_OFF) + MW_CNT, 0, 0};
            pg8::EpiSwiglu E{(bf16*)(F.ws + WS_ACT), args.in[22] + (size_t)layer * 32 * 2048, 0, MOE_FP8_DOWN ? (unsigned char*)(F.ws + WS_ACT8) : nullptr, MOE_FP8_GU ? 1.0f / WGU_SCALE : 1.0f};
            {
                LAS int* gc = (LAS int*)(F.lds + GCACHE_OFF); const int* LIST = (const int*)(F.ws + WS_LIST);
                const int r = F.tid & 255, s0 = F.tid >> 8; int tk[GCACHE_SLOTS / 2];
#pragma unroll
                for (int i = 0; i < GCACHE_SLOTS / 2; ++i) { pg8::Unit uu; const bool ok = S.next(2 * i + s0, uu); const bool valid = ok && (r < uu.nval); const int ai = valid ? (uu.aidx + r) : 0; const int t = LIST[ai]; tk[i] = valid ? t : 0; }
#pragma unroll
                for (int i = 0; i < GCACHE_SLOTS / 2; ++i) gc[(2 * i + s0) * 256 + r] = tk[i];
                __syncthreads();
            }
            for (int rep = 0; rep < (PROBE_DUP == 3 ? 2 : 1); ++rep) pg8::gemm_phase<pg8::EpiSwiglu, pg8::MoeOrder, true, true, true, MOE_FP8_GU != 0>(F.lds + RING_OFF, g, S, E, (const LAS int*)(F.lds + GCACHE_OFF));
            if (PROBE_DUP == 6 || PROBE_DUP == 7 || PROBE_DUP == 8) { pg8::MoeOrder S2 = S; S2.force0 = (PROBE_DUP == 6) ? 1 : 0; pg8::EpiSwiglu E2{(bf16*)(F.ws + WS_END), args.in[22] + (size_t)layer * 32 * 2048, (PROBE_DUP == 7) ? (args.ph_hi > 0) : 0, nullptr, MOE_FP8_GU ? 1.0f / WGU_SCALE : 1.0f}; pg8::gemm_phase<pg8::EpiSwiglu, pg8::MoeOrder, true, true, true, MOE_FP8_GU != 0>(F.lds + RING_OFF, g, S2, E2, (const LAS int*)(F.lds + GCACHE_OFF)); }
            {
                const int total = (int)F.MISC[MW_NTILES] * 8, rem = (F.G == 256) ? (total & 255) : 0, nidle = rem ? 256 - rem : 0, nbusy = F.G - nidle;
                int x = (F.G == 256) ? (1024 - 4 * nidle) / 256 : 1024 / F.G; if (x < 0) x = 0;
                const int left = 1024 - nbusy * x, q = nidle ? (left + nidle - 1) / nidle : 0;
                int j0, j1;
                if (nidle == 0 || F.vcu < rem) { j0 = F.vcu * x; j1 = j0 + x; if (nidle == 0 && F.vcu == F.G - 1) j1 = 1024; }
                else { j0 = nbusy * x + (F.vcu - rem) * q; j1 = j0 + q; }
                if (j1 > 1024) j1 = 1024;
                p0_convert(F, args, layer, j0, 1, j1);
            }
            SEAM(pb + 9);
        }
        if (IN(pb + 10)) {
            if (MK_SPLIT) moe_tables(F, layer);
            pg8::Gemm g{(const bf16*)(F.ws + (MOE_FP8_DOWN ? WS_ACT8 : WS_ACT)), (const bf16*)(F.ws + WS_WDN) + (size_t)layer * 32 * 1024 * 1024 / (MOE_FP8_DOWN ? 2 : 1), MAXROWS, 32 * 1024, MOE_FP8_DOWN ? D / 2 : D};
            pg8::MoeOrder S{4, F.G, F.vcu, (int)F.MISC[MW_NTILES] * 4, (const LAS int*)(F.lds + MISC_OFF) + MW_TILEE, (const LAS int*)(F.lds + MISC_OFF) + MW_TBASE, (const LAS int*)(F.lds + MISC_OFF) + MW_CNT, 0, 1};
            pg8::EpiDown E{(bf16*)(F.ws + WS_Y), args.in[24] + (size_t)layer * 32 * 1024, 0, MOE_FP8_DOWN ? 1.0f / WDN_SCALE : 1.0f};
            for (int rep = 0; rep < (PROBE_DUP == 3 ? 2 : 1); ++rep) pg8::gemm_phase<pg8::EpiDown, pg8::MoeOrder, true, true, false, MOE_FP8_DOWN != 0>(F.lds + RING_OFF, g, S, E);
            if (PROBE_DUP == 6 || PROBE_DUP == 7 || PROBE_DUP == 8) { pg8::MoeOrder S2 = S; S2.force0 = (PROBE_DUP == 6) ? 1 : 0; pg8::EpiDown E2{(bf16*)(F.ws + WS_END), args.in[24] + (size_t)layer * 32 * 1024, (PROBE_DUP == 7) ? (args.ph_hi > 0) : 0, MOE_FP8_DOWN ? 1.0f / WDN_SCALE : 1.0f}; pg8::gemm_phase<pg8::EpiDown, pg8::MoeOrder, true, true, false, MOE_FP8_DOWN != 0>(F.lds + RING_OFF, g, S2, E2); }
            SEAM(pb + 10);
        }
#ifndef X_NO_RW
        if (IN(pb + 11)) { rw_phase<2>(F, args, layer); if (PROBE_DUP == 4) rw_phase<2>(F, args, layer); SEAM(pb + 11); }
#endif
}
__global__ void __launch_bounds__(NTHR, 2) fwd_kernel(Args args) {
    extern __shared__ __attribute__((aligned(16))) unsigned char lds[];
    Frame F;
    F.lds = (LAS unsigned char*)lds; F.MISC = (volatile LAS unsigned*)(F.lds + MISC_OFF);
    F.tid = threadIdx.x; F.lane = F.tid & 63; F.wave = __builtin_amdgcn_readfirstlane(F.tid >> 6);
    F.G = gridDim.x; { const int bx = blockIdx.x; F.vcu = (F.G % 8 == 0) ? (bx % 8) * (F.G / 8) + bx / 8 : bx; }
    F.ws = args.ws; F.ctl = (gu32*)(args.ws + WS_CTL); F.out = args.out;
    for (int u = F.tid; u < 2048; u += NTHR) ((LAS unsigned*)(F.lds + MISC_OFF))[u] = 0u;
    __syncthreads();
    const int lo = args.ph_lo, hi = args.ph_hi;
    XcdBarrier bar; bar.bar = (unsigned*)(F.ctl + CW_BAR); bar.x = 0; bar.st = nullptr;
    if (!MK_SPLIT) bar = xcd_barrier_post((unsigned*)(F.ctl + CW_BAR), F.MISC + 8);

    #ifndef X_NO_P0
    if (IN(0)) { p0_weights(F, args); __syncthreads(); if (PROBE_DUP == 1) { p0_weights(F, args); __syncthreads(); }
        if (PROBE_DUP == 9) { const size_t n4 = ((size_t)4 * 32 * 1024 * 2048 + (size_t)4 * 32 * 1024 * 1024) / 4; const size_t n4a = (size_t)4 * 32 * 1024 * 2048 / 4;
            for (size_t i = (size_t)F.vcu * NTHR + F.tid; i < n4; i += (size_t)F.G * NTHR) { const f32x4 v = __builtin_nontemporal_load((const GAS f32x4*)(i < n4a ? args.in[21] : args.in[23] - n4a * 4) + i);
                v2u o; o.x = pk2(v.x, v.y); o.y = pk2(v.z, v.w); *((GAS v2u*)(F.ws + WS_END) + i) = o; } } rw_phase<0>(F, args, 0); SEAM(0); }
#endif

    layer_body<0>(F, args, bar, lo, hi);
    layer_body<1>(F, args, bar, lo, hi);
    layer_body<2>(F, args, bar, lo, hi);
    layer_body<3>(F, args, bar, lo, hi);
#undef IN
#undef SEAM
}

extern "C" void kernel_launch(void* const* d_in, const int* in_sizes, int n_in, void* d_out, int out_size, void* d_ws, size_t ws_size, hipStream_t stream) {
    static int grid = 0;
    if (grid == 0) {
        if (n_in != 25 || in_sizes[0] != M * D || out_size != M * D || ws_size < WS_END + 1024 * MiB) { fprintf(stderr, "kernel_launch: unexpected shapes (n_in %d, in0 %d, out %d, ws %zu)\n", n_in, n_in > 0 ? in_sizes[0] : -1, out_size, ws_size); grid = -1; return; }
        int dev = 0, cus = 0, per_cu = 0;
        if (hipGetDevice(&dev) != hipSuccess || hipDeviceGetAttribute(&cus, hipDeviceAttributeMultiprocessorCount, dev) != hipSuccess) { grid = -1; return; }
        if (hipFuncSetAttribute((const void*)fwd_kernel, hipFuncAttributeMaxDynamicSharedMemorySize, LDS_BYTES) != hipSuccess) { fprintf(stderr, "kernel_launch: hipFuncSetAttribute failed\n"); grid = -1; return; }
        if (hipOccupancyMaxActiveBlocksPerMultiprocessor(&per_cu, (const void*)fwd_kernel, NTHR, LDS_BYTES) != hipSuccess || per_cu < 1) { fprintf(stderr, "kernel_launch: occupancy query says %d\n", per_cu); }
        (void)hipGetLastError();
        grid = cus;
    }
    if (grid < 0) return;
    if (hipMemsetAsync((char*)d_ws + WS_CTL, 0, CTL_ZERO_BYTES, stream) != hipSuccess) return;
    Args a{};
    for (int i = 0; i < 25; ++i) a.in[i] = (const float*)d_in[i];
    a.out = (float*)d_out; a.ws = (unsigned char*)d_ws;
#if MK_SPLIT
    for (int k = 0; k < NPHASES; ++k) {
        if (k >= 1) { const int j = (k - 1) % NPH, layer = (k - 1) / NPH; if (j == 2 || j == 3 || j == 8) continue; }
        a.ph_lo = k; a.ph_hi = k + 1;
        hipLaunchKernelGGL(fwd_kernel, dim3(grid), dim3(NTHR), LDS_BYTES, stream, a);
    }
#else
    a.ph_lo = 0; a.ph_hi = NPHASES;
    hipLaunchKernelGGL(fwd_kernel, dim3(grid), dim3(NTHR), LDS_BYTES, stream, a);
#endif
}
```

```cpp
#include <hip/hip_runtime.h>
#include <cstdio>
#include <cstdint>
namespace pg8 {
#define PG8_LAS __attribute__((address_space(3)))
typedef unsigned short bf16_t;
typedef short bf16x8 __attribute__((ext_vector_type(8)));
typedef float f32x4 __attribute__((ext_vector_type(4)));
typedef unsigned u32x4 __attribute__((ext_vector_type(4)));
constexpr int BM = 256, BK = 64, HALF = 128, HTB = HALF * BK * 2  , STAGE_BYTES = 8 * HTB, NXCD = 8, WGM = 8;

__host__ __device__ __forceinline__ int lds_byte(int r, int c) { const int st = (r >> 4) * 2 + (c >> 5), rr = r & 15, cc = c & 31, ob = rr * 64 + cc * 2; return st * 1024 + (ob ^ (((ob >> 9) & 1) << 5)); }
__host__ __device__ __forceinline__ void stage_rc(int b, int& R, int& C) { const int st = b / 1024, sb = b % 1024, swz = sb ^ (((sb >> 9) & 1) << 5); R = (st >> 1) * 16 + swz / 64; C = (st & 1) * 32 + (swz % 64) / 2; }
__host__ __device__ __forceinline__ int perm32(int rho) { const int n = rho >> 4, i = rho & 15; return 8 * (i >> 2) + 4 * n + (i & 3); }

struct Unit { int pm, pn, aidx, nval, slot; };
struct Gemm { const bf16_t* A; const bf16_t* Bt; int M, N, K; };

struct StaticOrder {
    int nM, nN, nwg, G, c;
    __host__ __device__ void init(int M, int N, int G_, int c_) { nM = M / BM; nN = N / BM; nwg = nM * nN; G = G_; c = c_; }
    __host__ __device__ bool next(int i, Unit& u) const {
        const long L = (long)i * G + c; if (L >= nwg) return false;
        int wgid = (int)L; { const int q = nwg / NXCD, r = nwg % NXCD, xcd = wgid % NXCD, off = wgid / NXCD; wgid = (xcd < r ? xcd * (q + 1) : r * (q + 1) + (xcd - r) * q) + off; }
        const int nig = WGM * nN, gid = wgid / nig, fm = gid * WGM, gsz = (nM - fm) < WGM ? (nM - fm) : WGM;
        u.pm = fm + ((wgid % nig) % gsz); u.pn = (wgid % nig) / gsz; return true;
    }
    __device__ __forceinline__ void a_ready(const Unit&) const {}
    __device__ __forceinline__ void done(const Unit&) const {}
};

typedef float f32x2c_t __attribute__((ext_vector_type(2))); typedef __bf16 bf16x2c_t __attribute__((ext_vector_type(2)));
__device__ __forceinline__ unsigned cvt_pk_bf16(float lo, float hi) { f32x2c_t v = {lo, hi}; bf16x2c_t b = __builtin_convertvector(v, bf16x2c_t); return __builtin_bit_cast(unsigned, b); }
typedef float f32x2 __attribute__((ext_vector_type(2)));

struct EpiStoreBf16 {
    static constexpr bool PERM = true, AFTER_DRAIN = false;
    bf16_t* O; int ldc; const float* scale; int col_off;
    __device__ __forceinline__ void operator()(const f32x4 (&acc)[2][2][4][2], const Unit& u, int wr, int wc, int fr, int fq) const {
        const int row0 = u.pm * BM + wr * 64 + fr, col0 = u.pn * BM + wc * 32 + 8 * fq;
        f32x4 sv[2][2];
#pragma unroll
        for (int bj = 0; bj < 2; ++bj)
#pragma unroll
            for (int n = 0; n < 2; ++n) sv[bj][n] = scale ? *(const f32x4*)(scale + col0 + bj * HALF + 4 * n) : (f32x4){1.f, 1.f, 1.f, 1.f};
#pragma unroll
        for (int ai = 0; ai < 2; ++ai)
#pragma unroll
            for (int m = 0; m < 4; ++m) { bf16_t* rowp = O + (size_t)(row0 + ai * HALF + m * 16) * ldc + col_off + col0;
#pragma unroll
                for (int bj = 0; bj < 2; ++bj) { const f32x4 v0 = acc[ai][bj][m][0] * sv[bj][0], v1 = acc[ai][bj][m][1] * sv[bj][1];
                    u32x4 w; w.x = cvt_pk_bf16(v0[0], v0[1]); w.y = cvt_pk_bf16(v0[2], v0[3]); w.z = cvt_pk_bf16(v1[0], v1[1]); w.w = cvt_pk_bf16(v1[2], v1[3]);
                    *(u32x4*)(rowp + bj * HALF) = w; } }
    }
};
struct EpiResBf16 {
    static constexpr bool PERM = true, AFTER_DRAIN = false;
    const bf16_t* X; bf16_t* O; int ldc; float alpha;
    __device__ __forceinline__ void operator()(const f32x4 (&acc)[2][2][4][2], const Unit& u, int wr, int wc, int fr, int fq) const {
        const int row0 = u.pm * BM + wr * 64 + fr, col0 = u.pn * BM + wc * 32 + 8 * fq;
        u32x4 xr[2][4][2];
#pragma unroll
        for (int ai = 0; ai < 2; ++ai)
#pragma unroll
            for (int m = 0; m < 4; ++m)
#pragma unroll
                for (int bj = 0; bj < 2; ++bj) xr[ai][m][bj] = *(const u32x4*)(X + (size_t)(row0 + ai * HALF + m * 16) * ldc + col0 + bj * HALF);
#pragma unroll
        for (int ai = 0; ai < 2; ++ai)
#pragma unroll
            for (int m = 0; m < 4; ++m) { const size_t off = (size_t)(row0 + ai * HALF + m * 16) * ldc + col0;
#pragma unroll
                for (int bj = 0; bj < 2; ++bj) { const u32x4 xx = xr[ai][m][bj];
                    const f32x4 x0 = {__builtin_bit_cast(float, xx.x << 16), __builtin_bit_cast(float, xx.x & 0xffff0000u), __builtin_bit_cast(float, xx.y << 16), __builtin_bit_cast(float, xx.y & 0xffff0000u)};
                    const f32x4 x1 = {__builtin_bit_cast(float, xx.z << 16), __builtin_bit_cast(float, xx.z & 0xffff0000u), __builtin_bit_cast(float, xx.w << 16), __builtin_bit_cast(float, xx.w & 0xffff0000u)};
                    const f32x4 v0 = x0 * alpha + acc[ai][bj][m][0], v1 = x1 * alpha + acc[ai][bj][m][1];
                    u32x4 w; w.x = cvt_pk_bf16(v0[0], v0[1]); w.y = cvt_pk_bf16(v0[2], v0[3]); w.z = cvt_pk_bf16(v1[0], v1[1]); w.w = cvt_pk_bf16(v1[2], v1[3]);
                    *(u32x4*)(O + off + bj * HALF) = w; } }
    }
};
__device__ __forceinline__ f32x2 swiglu2(f32x4 h) {
    f32x2 g = {fminf(h[0], 7.0f), fminf(h[2], 7.0f)}, l = {fminf(fmaxf(h[1], -7.0f), 7.0f), fminf(fmaxf(h[3], -7.0f), 7.0f)};
    const f32x2 t = g * (-2.4554669595930156f);
    f32x2 e2; e2.x = __builtin_amdgcn_exp2f(t.x); e2.y = __builtin_amdgcn_exp2f(t.y);
    const f32x2 d = e2 + 1.0f;
    f32x2 r; r.x = __builtin_amdgcn_rcpf(d.x); r.y = __builtin_amdgcn_rcpf(d.y);
    return (g * r) * (l + 1.0f);
}
__device__ __forceinline__ unsigned pk4_fp8(float a, float b, float c, float d) { int v = __builtin_amdgcn_cvt_pk_fp8_f32(a, b, 0, false); v = __builtin_amdgcn_cvt_pk_fp8_f32(c, d, v, true); return (unsigned)v; }
struct EpiSwiglu {
    static constexpr bool PERM = true, AFTER_DRAIN = false;
    bf16_t* ACT; const float* bgu; int skip; unsigned char* ACT8; float ascale;
    __device__ __forceinline__ void operator()(const f32x4 (&acc)[2][2][4][2], const Unit& u, int wr, int wc, int fr, int fq) const {
        if (skip && u.pm >= 0) return;
        const int e = u.pn >> 3, pnl = u.pn & 7;
        const int row0 = u.pm * BM + wr * 64 + fr, hcol0 = pnl * BM + wc * 32 + 8 * fq;
        f32x4 bv[2][2];
#pragma unroll
        for (int bj = 0; bj < 2; ++bj)
#pragma unroll
            for (int n = 0; n < 2; ++n) bv[bj][n] = *(const f32x4*)(bgu + (size_t)e * 2048 + hcol0 + bj * HALF + 4 * n);
#pragma unroll
        for (int ai = 0; ai < 2; ++ai)
#pragma unroll
            for (int m = 0; m < 4; ++m) { bf16_t* rowp = ACT + (size_t)(row0 + ai * HALF + m * 16) * 1024 + (hcol0 >> 1);
#pragma unroll
                for (int bj = 0; bj < 2; ++bj) { const f32x4 v0 = acc[ai][bj][m][0] * ascale + bv[bj][0], v1 = acc[ai][bj][m][1] * ascale + bv[bj][1];
                    typedef unsigned u32x2v __attribute__((ext_vector_type(2)));
                    const f32x2 a0 = swiglu2(v0), a1 = swiglu2(v1);
                    if (ACT8) *(unsigned*)(ACT8 + (size_t)(row0 + ai * HALF + m * 16) * 1024 + (hcol0 >> 1) + bj * (HALF / 2)) = pk4_fp8(a0.x, a0.y, a1.x, a1.y);
                    else { u32x2v w; w.x = cvt_pk_bf16(a0.x, a0.y); w.y = cvt_pk_bf16(a1.x, a1.y); *(u32x2v*)(rowp + bj * (HALF / 2)) = w; } } }
    }
};
struct EpiDown {
    static constexpr bool PERM = true, AFTER_DRAIN = false;
    bf16_t* Y; const float* bdn; int skip; float ascale;
    __device__ __forceinline__ void operator()(const f32x4 (&acc)[2][2][4][2], const Unit& u, int wr, int wc, int fr, int fq) const {
        if (skip && u.pm >= 0) return;
        const int e = u.pn >> 2, pnl = u.pn & 3;
        const int row0 = u.pm * BM + wr * 64 + fr, col0 = pnl * BM + wc * 32 + 8 * fq;
        f32x4 bv[2][2];
#pragma unroll
        for (int bj = 0; bj < 2; ++bj)
#pragma unroll
            for (int n = 0; n < 2; ++n) bv[bj][n] = *(const f32x4*)(bdn + (size_t)e * 1024 + col0 + bj * HALF + 4 * n);
#pragma unroll
        for (int ai = 0; ai < 2; ++ai)
#pragma unroll
            for (int m = 0; m < 4; ++m) { bf16_t* rowp = Y + (size_t)(row0 + ai * HALF + m * 16) * 1024 + col0;
#pragma unroll
                for (int bj = 0; bj < 2; ++bj) { const f32x4 v0 = acc[ai][bj][m][0] * ascale + bv[bj][0], v1 = acc[ai][bj][m][1] * ascale + bv[bj][1];
                    u32x4 w; w.x = cvt_pk_bf16(v0[0], v0[1]); w.y = cvt_pk_bf16(v0[2], v0[3]); w.z = cvt_pk_bf16(v1[0], v1[1]); w.w = cvt_pk_bf16(v1[2], v1[3]);
                    *(u32x4*)(rowp + bj * HALF) = w; } }
    }
};
struct MoeOrder {
    int NT, G, c, total; const PG8_LAS int* tile_e; const PG8_LAS int* tbase; const PG8_LAS int* cnt; int force0, rev;
    __device__ __forceinline__ bool next(int i, Unit& u) const {
        const int L = i * G + c; if (L >= total) return false;
        const int pm0 = L / NT, pnl = L - pm0 * NT, pm = rev ? (total / NT - 1 - pm0) : pm0; const int e = __builtin_amdgcn_readfirstlane(tile_e[pm]);
        const int pml = pm - __builtin_amdgcn_readfirstlane(tbase[e]);
        u.pm = pm; u.pn = (force0 ? 0 : e) * NT + pnl; u.aidx = e * 16384 + pml * 256; u.nval = __builtin_amdgcn_readfirstlane(cnt[e]) - pml * 256; u.slot = i; return true;
    }
    __device__ __forceinline__ void a_ready(const Unit&) const {}
    __device__ __forceinline__ void done(const Unit&) const {}
};
template <class Epi, class Sched, bool ALIGN_EPI = false, bool SP2 = false, bool GATHER = false, bool FP8 = false>
__device__ __forceinline__ void gemm_phase(PG8_LAS unsigned char* lds, const Gemm g, const Sched& S, const Epi& E, const PG8_LAS int* gcache = nullptr) {
    int tid_ = threadIdx.x; asm volatile("" : "+v"(tid_));
    const int tid = tid_, wid = __builtin_amdgcn_readfirstlane(tid >> 6), lane = tid & 63, wr = wid >> 2, wc = wid & 3, fr = lane & 15, fq = lane >> 4;
    const int K = g.K, nt = K / BK;
    unsigned voffA[2], voffB[2]; int rA[2]; unsigned cA2[2];
#pragma unroll
    for (int i = 0; i < 2; ++i) { int R, C; stage_rc(tid * 16 + i * 8192, R, C); const int Rb = Epi::PERM ? ((R & ~31) + perm32(R & 31)) : R;
        voffA[i] = (unsigned)(R * K + C) * 2u; voffB[i] = (unsigned)(Rb * K + C) * 2u; rA[i] = R; cA2[i] = (unsigned)C * 2u; }
    const size_t kstep = (size_t)(BK * 2);
    const size_t hstep = (size_t)HALF * K * 2;
    const size_t tstep = 2 * hstep;
    const unsigned ldsw = (unsigned)wid * 1024u;
    const int aoff = lds_byte(wr * 64 + fr, fq * 8), boff = lds_byte(wc * 32 + fr, fq * 8);
#define PG8_SA(b, h) (((b) * 2 + (h)) * HTB)
#define PG8_SB(b, h) ((4 + (b) * 2 + (h)) * HTB)
#define PG8_STAGE(bufoff, gbase, voff) do { _Pragma("unroll") for (int _i = 0; _i < 2; ++_i) \
        __builtin_amdgcn_global_load_lds((const unsigned*)((const char*)(gbase) + (voff)[_i]), (PG8_LAS unsigned*)(lds + (bufoff) + ldsw + _i * 8192), 16, 0, 0); } while (0)
#define PG8_STAGE_A(bufoff, ubase, half, gsel_) do { if constexpr (GATHER) { PG8_STAGE(bufoff, ubase, (gsel_)[half]); } else { PG8_STAGE(bufoff, (ubase) + (half) * hstep, voffA); } } while (0)
#define PG8_GOFF(u_, dst_) do { _Pragma("unroll") for (int _h = 0; _h < 2; ++_h) _Pragma("unroll") for (int _i = 0; _i < 2; ++_i) { const int _r = 128 * _h + rA[_i]; \
        const int _tok = gcache[(u_).slot * 256 + _r]; (dst_)[_h][_i] = (unsigned)_tok * (unsigned)(K * 2) + cA2[_i]; } } while (0)
#define PG8_LDA(dst, b, h) do { _Pragma("unroll") for (int m = 0; m < 4; ++m) { const i32x4_ lo_ = *(const PG8_LAS i32x4_*)(lds + PG8_SA(b, h) + aoff + m * 2048), hi_ = *(const PG8_LAS i32x4_*)(lds + PG8_SA(b, h) + aoff + m * 2048 + 1024); \
        dst[m] = __builtin_shufflevector(lo_, hi_, 0, 1, 2, 3, 4, 5, 6, 7); } } while (0)
#define PG8_LDB(dst, b, h) do { _Pragma("unroll") for (int n = 0; n < 2; ++n) { const i32x4_ lo_ = *(const PG8_LAS i32x4_*)(lds + PG8_SB(b, h) + boff + n * 2048), hi_ = *(const PG8_LAS i32x4_*)(lds + PG8_SB(b, h) + boff + n * 2048 + 1024); \
        dst[n] = __builtin_shufflevector(lo_, hi_, 0, 1, 2, 3, 4, 5, 6, 7); } } while (0)
#define PG8_MMA(ai, bj, At, Bt) do { __builtin_amdgcn_s_setprio(1); \
        if constexpr (FP8) { _Pragma("unroll") for (int m = 0; m < 4; ++m) _Pragma("unroll") for (int n = 0; n < 2; ++n) \
                asm volatile("v_mfma_scale_f32_16x16x128_f8f6f4 %0, %1, %2, %0, %3, %3 op_sel_hi:[0,0,0]" : "+v"(acc[ai][bj][m][n]) : "v"(Bt[n]), "v"(At[m]), "v"(mxscale)); } \
        else { _Pragma("unroll") for (int m = 0; m < 4; ++m) _Pragma("unroll") for (int n = 0; n < 2; ++n) { \
                acc[ai][bj][m][n] = __builtin_amdgcn_mfma_f32_16x16x32_bf16(__builtin_bit_cast(bf16x8, __builtin_shufflevector(Bt[n], Bt[n], 0, 1, 2, 3)), __builtin_bit_cast(bf16x8, __builtin_shufflevector(At[m], At[m], 0, 1, 2, 3)), acc[ai][bj][m][n], 0, 0, 0); \
                acc[ai][bj][m][n] = __builtin_amdgcn_mfma_f32_16x16x32_bf16(__builtin_bit_cast(bf16x8, __builtin_shufflevector(Bt[n], Bt[n], 4, 5, 6, 7)), __builtin_bit_cast(bf16x8, __builtin_shufflevector(At[m], At[m], 4, 5, 6, 7)), acc[ai][bj][m][n], 0, 0, 0); } } \
        __builtin_amdgcn_s_setprio(0); } while (0)
#define PG8_WAIT_V(n) asm volatile("s_waitcnt vmcnt(" #n ")" ::: "memory")
#define PG8_WAIT_L(n) asm volatile("s_waitcnt lgkmcnt(" #n ")" ::: "memory")
#define PG8_BAR __builtin_amdgcn_s_barrier()
#define PG8_SCHED __builtin_amdgcn_sched_barrier(0)
    Unit cur, nxt; int ui = 0; int mxscale = 0x7F7F7F7F; asm volatile("" : "+v"(mxscale));
    if (!S.next(0, cur)) return;
    f32x4 acc[2][2][4][2];
#pragma unroll
    for (int a = 0; a < 2; ++a)
#pragma unroll
        for (int b = 0; b < 2; ++b)
#pragma unroll
            for (int m = 0; m < 4; ++m)
#pragma unroll
                for (int n = 0; n < 2; ++n) acc[a][b][m][n] = (f32x4){0.f, 0.f, 0.f, 0.f};
    typedef int i32x4_ __attribute__((ext_vector_type(4))); typedef int i32x8_ __attribute__((ext_vector_type(8)));
    i32x8_ At[4], B0[2], B1[2];
    const char* cA = (const char*)g.A + (GATHER ? (size_t)0 : (size_t)cur.pm * tstep); const char* cB = (const char*)g.Bt + (size_t)cur.pn * tstep;
    unsigned gofc[2][2] = {{0u, 0u}, {0u, 0u}}, gofn[2][2] = {{0u, 0u}, {0u, 0u}};
    if constexpr (GATHER) PG8_GOFF(cur, gofc);
    S.a_ready(cur);
    if constexpr (SP2) {
        PG8_STAGE(PG8_SB(0, 0), cB, voffB); PG8_STAGE(PG8_SB(0, 1), cB + hstep, voffB); PG8_STAGE_A(PG8_SA(0, 0), cA, 0, gofc); PG8_STAGE_A(PG8_SA(0, 1), cA, 1, gofc);
        if (wr == 1) PG8_BAR;
        PG8_WAIT_V(2); PG8_BAR;
        PG8_STAGE(PG8_SB(1, 0), cB + kstep, voffB); PG8_STAGE_A(PG8_SA(1, 0), cA + kstep, 0, gofc); PG8_STAGE(PG8_SB(1, 1), cB + hstep + kstep, voffB);
        PG8_WAIT_V(6); PG8_BAR;
    } else {
        PG8_STAGE(PG8_SB(0, 0), cB, voffB); PG8_STAGE_A(PG8_SA(0, 0), cA, 0, gofc); PG8_STAGE(PG8_SB(0, 1), cB + hstep, voffB); PG8_STAGE_A(PG8_SA(0, 1), cA, 1, gofc);
        if (wr == 1) PG8_BAR;
        PG8_WAIT_V(4); PG8_BAR;
        PG8_STAGE(PG8_SB(1, 0), cB + kstep, voffB); PG8_STAGE_A(PG8_SA(1, 0), cA + kstep, 0, gofc); PG8_STAGE(PG8_SB(1, 1), cB + hstep + kstep, voffB);
        PG8_WAIT_V(6); PG8_BAR;
    }
    for (;;) {
        const bool has_next = S.next(ui + 1, nxt);
        const char* nA = (has_next && !GATHER) ? (const char*)g.A + (size_t)nxt.pm * tstep : cA; const char* nB = has_next ? (const char*)g.Bt + (size_t)nxt.pn * tstep : cB;
        if constexpr (GATHER) { if (has_next) PG8_GOFF(nxt, gofn); else {
#pragma unroll
                for (int _h = 0; _h < 2; ++_h) { gofn[_h][0] = gofc[_h][0]; gofn[_h][1] = gofc[_h][1]; } } }
#pragma unroll 1
        for (int t = 0; t < nt; t += 2) {
            const bool last = (t == nt - 2);
            const char* a1 = cA + (size_t)(t + 1) * kstep;
            const char* a2 = last ? nA : cA + (size_t)(t + 2) * kstep; const char* b2 = last ? nB : cB + (size_t)(t + 2) * kstep;
            const char* a3 = a2 + kstep; const char* b3 = b2 + kstep;
            unsigned gsel[2][2];
#pragma unroll
            for (int _h = 0; _h < 2; ++_h) { gsel[_h][0] = last ? gofn[_h][0] : gofc[_h][0]; gsel[_h][1] = last ? gofn[_h][1] : gofc[_h][1]; }
            if (last && has_next) S.a_ready(nxt);
            if constexpr (SP2) {
            PG8_LDB(B0, 0, 0); PG8_LDB(B1, 0, 1); PG8_SCHED; PG8_LDA(At, 0, 0); PG8_STAGE_A(PG8_SA(1, 1), a1, 1, gofc);
            PG8_WAIT_V(8); PG8_WAIT_L(0); PG8_BAR; PG8_MMA(0, 0, At, B0); PG8_MMA(0, 1, At, B1); PG8_BAR; PG8_SCHED;
            PG8_LDA(At, 0, 1); PG8_STAGE(PG8_SB(0, 0), b2, voffB); PG8_STAGE(PG8_SB(0, 1), b2 + hstep, voffB); PG8_STAGE_A(PG8_SA(0, 0), a2, 0, gsel);
            PG8_WAIT_V(8); PG8_WAIT_L(0); PG8_BAR; PG8_MMA(1, 0, At, B0); PG8_MMA(1, 1, At, B1); PG8_BAR; PG8_SCHED;
            PG8_LDB(B0, 1, 0); PG8_LDB(B1, 1, 1); PG8_SCHED; PG8_LDA(At, 1, 0); PG8_STAGE_A(PG8_SA(0, 1), a2, 1, gsel);
            PG8_WAIT_V(8); PG8_WAIT_L(0); PG8_BAR; PG8_MMA(0, 0, At, B0); PG8_MMA(0, 1, At, B1); PG8_BAR; PG8_SCHED;
            PG8_LDA(At, 1, 1); PG8_STAGE(PG8_SB(1, 0), b3, voffB); PG8_STAGE(PG8_SB(1, 1), b3 + hstep, voffB); PG8_STAGE_A(PG8_SA(1, 0), a3, 0, gsel);
            PG8_WAIT_V(8); PG8_WAIT_L(0); PG8_BAR; PG8_MMA(1, 0, At, B0); PG8_MMA(1, 1, At, B1); PG8_BAR; PG8_SCHED;
            } else {
            PG8_LDB(B0, 0, 0); PG8_SCHED; PG8_LDA(At, 0, 0); PG8_STAGE_A(PG8_SA(1, 1), a1, 1, gofc);
            PG8_WAIT_L(8); PG8_BAR; PG8_WAIT_L(0); PG8_MMA(0, 0, At, B0); PG8_BAR; PG8_SCHED;
            PG8_LDB(B1, 0, 1); PG8_STAGE(PG8_SB(0, 0), b2, voffB);
            PG8_BAR; PG8_WAIT_L(0); PG8_MMA(0, 1, At, B1); PG8_BAR;
            PG8_LDA(At, 0, 1); PG8_STAGE_A(PG8_SA(0, 0), a2, 0, gsel);
            PG8_BAR; PG8_WAIT_L(0); PG8_MMA(1, 0, At, B0); PG8_BAR; PG8_SCHED;
            PG8_STAGE(PG8_SB(0, 1), b2 + hstep, voffB);
            PG8_WAIT_V(6); PG8_BAR; PG8_MMA(1, 1, At, B1); PG8_BAR;
            PG8_LDB(B0, 1, 0); PG8_SCHED; PG8_LDA(At, 1, 0); PG8_STAGE_A(PG8_SA(0, 1), a2, 1, gsel);
            PG8_WAIT_L(8); PG8_BAR; PG8_WAIT_L(0); PG8_MMA(0, 0, At, B0); PG8_BAR; PG8_SCHED;
            PG8_LDB(B1, 1, 1); PG8_STAGE(PG8_SB(1, 0), b3, voffB);
            PG8_BAR; PG8_WAIT_L(0); PG8_MMA(0, 1, At, B1); PG8_BAR;
            PG8_LDA(At, 1, 1); PG8_STAGE_A(PG8_SA(1, 0), a3, 0, gsel);
            PG8_BAR; PG8_WAIT_L(0); PG8_MMA(1, 0, At, B0); PG8_BAR; PG8_SCHED;
            PG8_STAGE(PG8_SB(1, 1), b3 + hstep, voffB);
            PG8_WAIT_V(6); PG8_BAR; PG8_MMA(1, 1, At, B1); PG8_BAR;
            }
        }
        if constexpr (FP8) asm volatile("s_nop 15\n\ts_nop 15" ::: "memory");
        if constexpr (ALIGN_EPI) { if (wr == 0) PG8_BAR; }
        if constexpr (!Epi::AFTER_DRAIN) { E(acc, cur, wr, wc, fr, fq); S.done(cur); }
        if (!has_next) break;
#pragma unroll
        for (int a = 0; a < 2; ++a)
#pragma unroll
            for (int b = 0; b < 2; ++b)
#pragma unroll
                for (int m = 0; m < 4; ++m)
#pragma unroll
                    for (int n = 0; n < 2; ++n) acc[a][b][m][n] = (f32x4){0.f, 0.f, 0.f, 0.f};
        cur = nxt; cA = nA; cB = nB; ++ui;
        if constexpr (GATHER) {
#pragma unroll
            for (int _h = 0; _h < 2; ++_h) { gofc[_h][0] = gofn[_h][0]; gofc[_h][1] = gofn[_h][1]; } }
        if constexpr (ALIGN_EPI) { if (wr == 1) PG8_BAR; }
    }
    PG8_WAIT_V(0);
    if constexpr (!ALIGN_EPI) { if (wr == 0) PG8_BAR; }
    PG8_BAR;
    if constexpr (Epi::AFTER_DRAIN) { E.fused(acc, cur, wr, wc, fr, fq, lds, wid, lane); S.done(cur); }
#undef PG8_SA
#undef PG8_SB
#undef PG8_STAGE
#undef PG8_STAGE_A
#undef PG8_GOFF
#undef PG8_LDA
#undef PG8_LDB
#undef PG8_MMA
#undef PG8_WAIT_V
#undef PG8_WAIT_L
#undef PG8_BAR
#undef PG8_SCHED
}
}

constexpr int NWAVES = 8, NTHR = 512;
constexpr int SEQ = 4096, D = 1024, M = 16384, DEPTH = 4;
constexpr int EVEN_IN = 2568, ODD_IN = 3088, NE_P = 2560, NO_P = 3072, LDP = 3072;
constexpr int NEXP = 32, MAXROWS = 65536 + 32 * 256;
constexpr float ALPHA = 1.6817928305074290f, LN_EPS = 1e-5f;
constexpr int NPH = 12, NPHASES = 1 + DEPTH * NPH;
#ifndef PROBE_DUP
#define PROBE_DUP 0
#endif
#ifndef MOE_FP8_DOWN
#define MOE_FP8_DOWN 1
#endif
#ifndef MOE_FP8_GU
#define MOE_FP8_GU 1
#endif
constexpr float WDN_SCALE = 128.0f, WGU_SCALE = 64.0f;
#ifndef IDLE_Q
#define IDLE_Q 0
#endif
#ifndef MK_SPLIT
#define MK_SPLIT 0
#endif

constexpr size_t MiB = 1u << 20;
constexpr size_t WS_CTL = 0, CTL_ZERO_BYTES = 1 * MiB;
constexpr size_t WS_WINE = 1 * MiB, WS_WINO = 11 * MiB, WS_WOUT = 23 * MiB, WS_WP = 31 * MiB, WS_WGU = 32 * MiB, WS_WDN = 544 * MiB;
constexpr size_t WS_X = 800 * MiB, WS_XB = 864 * MiB, WS_X1 = 896 * MiB, WS_X1B = 960 * MiB, WS_PRE = 992 * MiB, WS_P = 1056 * MiB, WS_MIX = 1152 * MiB;
constexpr size_t WS_QK = 1184 * MiB, WS_DD = 1216 * MiB, WS_GATES = 1232 * MiB, WS_H = 1234 * MiB, WS_TOKE = 1298 * MiB, WS_TOKPOS = WS_TOKE + 256 * 1024, WS_GATE = WS_TOKE + 512 * 1024, WS_SLOT = WS_TOKE + 768 * 1024;
constexpr size_t WS_XS = 1300 * MiB, WS_ACT = 1444 * MiB, WS_Y = 1588 * MiB, WS_END = 1876 * MiB;
constexpr size_t WS_X1F8 = WS_XS;
constexpr size_t WS_ACT8 = WS_ACT;
constexpr int CW_TMO = 0, CW_BAR = 4096, CW_CNT = 16384;

constexpr int RING_OFF = 0, RING_BYTES = 131072;
constexpr int MISC_OFF = RING_BYTES;
constexpr int GCACHE_OFF = RING_BYTES + 8192, GCACHE_SLOTS = 16;
constexpr int LDS_BYTES = GCACHE_OFF + GCACHE_SLOTS * 1024;
constexpr int MW_CNT = 16, MW_ROWBASE = 48, MW_TILEE = 96, MW_NTILES = 400, MW_LCNT = 416, MW_WBASE = 448, MW_PICK = 512, MW_TBASE = 1600;
constexpr size_t WS_LIST = WS_H + 2 * MiB;

#define GAS __attribute__((address_space(1)))
#define LAS __attribute__((address_space(3)))
typedef unsigned short bf16;
typedef unsigned v4u __attribute__((ext_vector_type(4)));
typedef unsigned v2u __attribute__((ext_vector_type(2)));
typedef float f32x4 __attribute__((ext_vector_type(4)));
typedef GAS unsigned gu32;
#define RLX_AGENT __ATOMIC_RELAXED, __HIP_MEMORY_SCOPE_AGENT
#define LDS_WAIT() asm volatile("s_waitcnt lgkmcnt(0)" ::: "memory")
#define VM_WAIT() asm volatile("s_waitcnt vmcnt(0)" ::: "memory")
typedef float f32x2_t __attribute__((ext_vector_type(2))); typedef __bf16 bf16x2_t __attribute__((ext_vector_type(2)));
__device__ __forceinline__ unsigned pk2(float lo, float hi) { f32x2_t v = {lo, hi}; bf16x2_t b = __builtin_convertvector(v, bf16x2_t); return __builtin_bit_cast(unsigned, b); }
__device__ __forceinline__ unsigned f2bf(float f) { return pk2(f, f) & 0xffffu; }
__device__ __forceinline__ float bf2f(unsigned short b) { return __builtin_bit_cast(float, (unsigned)b << 16); }
__device__ __forceinline__ float bflo(unsigned w) { return __builtin_bit_cast(float, w << 16); }
__device__ __forceinline__ float bfhi(unsigned w) { return __builtin_bit_cast(float, w & 0xffff0000u); }
__device__ __forceinline__ float sigmoidf_(float x) { return __builtin_amdgcn_rcpf(1.0f + __expf(-x)); }
__device__ __forceinline__ float logsigmoidf_(float x) { return fminf(x, 0.f) - __logf(1.0f + __expf(-fabsf(x))); }

#define XB_TMO      128
#define XB_XCNT(j)  (256  + 64 * (j))
#define XB_XSUB(j)  (1280 + 64 * (j))
#define XB_XGEN(j)  (2304 + 64 * (j))
#define XB_TOP      3328
#define XB_TOPGEN   3392
#define XCD_BAR_WORDS 3456
#define XB_SPIN_CAP (1u << 18)

__device__ __forceinline__ unsigned xb_ld(unsigned* p)              { return __hip_atomic_load(p, __ATOMIC_RELAXED, __HIP_MEMORY_SCOPE_AGENT); }
__device__ __forceinline__ unsigned xb_add(unsigned* p, unsigned v) { return __hip_atomic_fetch_add(p, v, __ATOMIC_RELAXED, __HIP_MEMORY_SCOPE_AGENT); }
__device__ __forceinline__ unsigned xb_xcc_id() { return (unsigned)__builtin_amdgcn_s_getreg((3 << 11) | 20) & 0xFu; }
#define XB_SPIN(cond, bar) do { unsigned _sp = 0; while (cond) { __builtin_amdgcn_s_sleep(1); \
    if ((++_sp & 255u) == 0u) { if (xb_ld(&(bar)[XB_TMO])) break; if (_sp > XB_SPIN_CAP) { atomicAdd(&(bar)[XB_TMO], 1u); break; } } } } while (0)

struct XcdBarrier {
    unsigned* bar; unsigned x;
    volatile LAS unsigned* st;
};

__device__ __forceinline__ XcdBarrier xcd_barrier_post(unsigned* bar, volatile LAS unsigned* st) {
    XcdBarrier b; b.bar = bar; b.x = xb_xcc_id(); b.st = st;
    if (threadIdx.x == 0) (void)xb_add(&bar[XB_XCNT(b.x)], 1u);
    return b;
}
__device__ __forceinline__ void xcd_barrier_complete(unsigned* bar, unsigned x, unsigned& nloc, unsigned& nx) {
    const unsigned G = gridDim.x * gridDim.y * gridDim.z;
    unsigned sum, cnt, mine, sp = 0u;
    for (;;) {
        sum = 0u; cnt = 0u; mine = 0u;
#pragma unroll
        for (unsigned j = 0; j < 16; ++j) { const unsigned c = xb_ld(&bar[XB_XCNT(j)]); sum += c; cnt += (c > 0u) ? 1u : 0u; mine = (j == x) ? c : mine; }
        if (sum == G) break;
        __builtin_amdgcn_s_sleep(1);
        if ((++sp & 255u) == 0u) { if (xb_ld(&bar[XB_TMO])) break; if (sp > XB_SPIN_CAP) { atomicAdd(&bar[XB_TMO], 1u); break; } }
    }
    nloc = mine > 0u ? mine : 1u; nx = cnt > 0u ? cnt : 1u;
}

__device__ __forceinline__ void xcd_barrier(const XcdBarrier& b) {
    asm volatile("s_waitcnt vmcnt(0)" ::: "memory");
    __syncthreads();
    if (threadIdx.x == 0) {
        unsigned* bar = b.bar;
        __builtin_amdgcn_s_waitcnt(0);
        unsigned nloc = b.st[0], nx = b.st[1];
        if (nloc == 0u) { xcd_barrier_complete(bar, b.x, nloc, nx); b.st[0] = nloc; b.st[1] = nx; }
        const unsigned old = xb_add(&bar[XB_XSUB(b.x)], 1u);
        const unsigned gen = old / nloc;
        if (old + 1u == (gen + 1u) * nloc) {
            __builtin_amdgcn_fence(__ATOMIC_RELEASE, "agent");
            asm volatile("s_waitcnt vmcnt(0)" ::: "memory");
            (void)xb_add(&bar[XB_TOP], 1u);
            const unsigned target = (gen + 1u) * nx;
            XB_SPIN((int)(xb_ld(&bar[XB_TOP]) - target) < 0, bar);
            __builtin_amdgcn_fence(__ATOMIC_ACQUIRE, "agent");
            xb_add(&bar[XB_XGEN(b.x)], 1u);
            asm volatile("s_waitcnt vmcnt(0)" ::: "memory");
        } else {
            XB_SPIN(xb_ld(&bar[XB_XGEN(b.x)]) == gen, bar);
            __builtin_amdgcn_fence(__ATOMIC_ACQUIRE, "agent");
            asm volatile("s_waitcnt vmcnt(0)" ::: "memory");
        }
    }
    __syncthreads();
}


typedef short s16x4 __attribute__((ext_vector_type(4)));
__device__ __forceinline__ pg8::bf16x8 tr8(const LAS unsigned char* p, int pitchB) {
    const s16x4 lo = __builtin_amdgcn_ds_read_tr16_b64_v4i16((LAS s16x4*)p);
    const s16x4 hi = __builtin_amdgcn_ds_read_tr16_b64_v4i16((LAS s16x4*)(p + 4 * pitchB));
    return __builtin_shufflevector(lo, hi, 0, 1, 2, 3, 4, 5, 6, 7);
}
struct Args { const float* in[25]; float* out; unsigned char* ws; int ph_lo, ph_hi; };
struct Frame {
    LAS unsigned char* lds;
    volatile LAS unsigned* MISC;
    gu32* ctl;
    int tid, lane, wave, vcu, G;
    float* out; unsigned char* ws;
};
__device__ __forceinline__ float dpp_add(float v, const int ctrl_sel) {
    const int x = __builtin_bit_cast(int, v); int y;
    if (ctrl_sel == 0) y = __builtin_amdgcn_update_dpp(x, x, 0xB1, 0xF, 0xF, false);
    else if (ctrl_sel == 1) y = __builtin_amdgcn_update_dpp(x, x, 0x4E, 0xF, 0xF, false);
    else if (ctrl_sel == 2) y = __builtin_amdgcn_update_dpp(x, x, 0x124, 0xF, 0xF, false);
    else y = __builtin_amdgcn_update_dpp(x, x, 0x128, 0xF, 0xF, false);
    return v + __builtin_bit_cast(float, y);
}
__device__ __forceinline__ float wave_sum(float v) {
    v = dpp_add(v, 0); v = dpp_add(v, 1); v = dpp_add(v, 2); v = dpp_add(v, 3);
    v += __shfl_xor(v, 16); v += __shfl_xor(v, 32);
    return v;
}
struct P0Tile { const float* src; size_t ldw; bf16* dst; size_t ldd; int fp8; };
constexpr int P0_PB = 528;
__device__ __forceinline__ P0Tile p0_tile(Frame& F, const Args& A, int t) {
    bf16* wine = (bf16*)(F.ws + WS_WINE); bf16* wino = (bf16*)(F.ws + WS_WINO); bf16* wout = (bf16*)(F.ws + WS_WOUT); bf16* wgu = (bf16*)(F.ws + WS_WGU); bf16* wdn = (bf16*)(F.ws + WS_WDN);
    constexpr int T_GU = 8 * 8, T_DN = 8 * 4, T_WE = 8 * 10, T_WO = 8 * 12, T_OUT = 8 * 4;
    constexpr int N_GU = 128 * T_GU, N_DN = 128 * T_DN, N_WE = 2 * T_WE, N_WO = 2 * T_WO;
    P0Tile o; int r = t, kt, nt; o.fp8 = 0;
    if (r < N_GU) { const int mtx = r / T_GU, q = r % T_GU; kt = q / 8; nt = q % 8; o.src = A.in[21] + (size_t)mtx * 1024 * 2048; o.ldw = 2048; o.dst = MOE_FP8_GU ? (bf16*)((unsigned char*)wgu + (size_t)mtx * 2048 * 1024) : wgu + (size_t)mtx * 2048 * 1024; o.fp8 = MOE_FP8_GU ? 2 : 0; }
    else if ((r -= N_GU) < N_DN) { const int mtx = r / T_DN, q = r % T_DN; kt = q / 4; nt = q % 4; o.src = A.in[23] + (size_t)mtx * 1024 * 1024; o.ldw = 1024; o.dst = MOE_FP8_DOWN ? (bf16*)((unsigned char*)wdn + (size_t)mtx * 1024 * 1024) : wdn + (size_t)mtx * 1024 * 1024; o.fp8 = MOE_FP8_DOWN; }
    else if ((r -= N_DN) < N_WE) { const int mtx = r / T_WE, q = r % T_WE; kt = q / 10; nt = q % 10; o.src = A.in[1] + (size_t)mtx * 1024 * EVEN_IN; o.ldw = EVEN_IN; o.dst = wine + (size_t)mtx * NE_P * 1024; }
    else if ((r -= N_WE) < N_WO) { const int mtx = r / T_WO, q = r % T_WO; kt = q / 12; nt = q % 12; o.src = A.in[10] + (size_t)mtx * 1024 * ODD_IN; o.ldw = ODD_IN; o.dst = wino + (size_t)mtx * NO_P * 1024; }
    else { r -= N_WO; const int l = r / T_OUT, q = r % T_OUT; kt = q / 4; nt = q % 4; o.src = ((l & 1) ? A.in[14] : A.in[9]) + (size_t)(l >> 1) * 1024 * 1024; o.ldw = 1024; o.dst = wout + (size_t)l * 1024 * 1024; }
    o.ldd = 1024; o.src += (size_t)(128 * kt) * o.ldw + 256 * nt;
    if (o.fp8) o.dst = (bf16*)((unsigned char*)o.dst + (size_t)(256 * nt) * 1024 + 128 * kt); else o.dst += (size_t)(256 * nt) * o.ldd + 128 * kt;
    return o;
}
__device__ __forceinline__ void p0_tile_load(const P0Tile& t, int wave, int lane, f32x4 (&v)[16]) {
#pragma unroll
    for (int i = 0; i < 16; ++i) v[i] = __builtin_nontemporal_load((const GAS f32x4*)(t.src + (size_t)(16 * wave + i) * t.ldw + 4 * lane));
}
__device__ __forceinline__ int p0_map(int layer, int j) { return layer < 0 ? j : (j < 1024 ? 8192 + layer * 1024 + j : layer * 2048 + (j - 1024)); }
__device__ __forceinline__ void p0_convert(Frame& F, const Args& A, int layer, int j0, int jstep, int jend) {
    LAS unsigned char* img = F.lds + RING_OFF;
    const int lane = F.lane, w = F.wave, g = lane >> 4, q = (lane & 15) >> 2, p = lane & 3, l15 = lane & 15;
    f32x4 v[16];
    int j = j0;
    if (j < jend) { const P0Tile cur = p0_tile(F, A, p0_map(layer, j)); p0_tile_load(cur, w, lane, v); }
    for (; j < jend; j += jstep) {
        const P0Tile cur = p0_tile(F, A, p0_map(layer, j));
#pragma unroll
        for (int i = 0; i < 16; ++i) { v2u o; o.x = pk2(v[i].x, v[i].y); o.y = pk2(v[i].z, v[i].w); *(LAS v2u*)(img + (16 * w + i) * P0_PB + lane * 8) = o; }
        __syncthreads();
        if (j + jstep < jend) { const P0Tile nx = p0_tile(F, A, p0_map(layer, j + jstep)); p0_tile_load(nx, w, lane, v); }
        if (cur.fp8) {
            const float sc_ = (cur.fp8 == 2) ? WGU_SCALE : WDN_SCALE;
#pragma unroll
            for (int kh = 0; kh < 2; ++kh)
#pragma unroll
                for (int c = 0; c < 2; ++c) {
                    const v4u f0 = __builtin_bit_cast(v4u, tr8(img + (64 * kh + 16 * g + q) * P0_PB + (32 * w + 16 * c + 4 * p) * 2, P0_PB));
                    const v4u f1 = __builtin_bit_cast(v4u, tr8(img + (64 * kh + 16 * g + 8 + q) * P0_PB + (32 * w + 16 * c + 4 * p) * 2, P0_PB));
                    v4u o8;
                    o8.x = pg8::pk4_fp8(bflo(f0.x) * sc_, bfhi(f0.x) * sc_, bflo(f0.y) * sc_, bfhi(f0.y) * sc_); o8.y = pg8::pk4_fp8(bflo(f0.z) * sc_, bfhi(f0.z) * sc_, bflo(f0.w) * sc_, bfhi(f0.w) * sc_);
                    o8.z = pg8::pk4_fp8(bflo(f1.x) * sc_, bfhi(f1.x) * sc_, bflo(f1.y) * sc_, bfhi(f1.y) * sc_); o8.w = pg8::pk4_fp8(bflo(f1.z) * sc_, bfhi(f1.z) * sc_, bflo(f1.w) * sc_, bfhi(f1.w) * sc_);
                    *(GAS v4u*)((unsigned char*)cur.dst + (size_t)(32 * w + 16 * c + l15) * 1024 + 64 * kh + 16 * g) = o8;
                }
        } else {
#pragma unroll
            for (int kb = 0; kb < 4; ++kb)
#pragma unroll
                for (int c = 0; c < 2; ++c) {
                    const pg8::bf16x8 fr = tr8(img + (32 * kb + 8 * g + q) * P0_PB + (32 * w + 16 * c + 4 * p) * 2, P0_PB);
                    *(GAS pg8::bf16x8*)(cur.dst + (size_t)(32 * w + 16 * c + l15) * cur.ldd + 32 * kb + 8 * g) = fr;
                }
        }
        __syncthreads();
    }
}
__device__ __forceinline__ void p0_weights(Frame& F, const Args& A) {
    bf16* wp = (bf16*)(F.ws + WS_WP);
    p0_convert(F, A, -1, 12288 + F.vcu, F.G, 12768);
    for (int i = F.vcu * NTHR + F.tid; i < 2 * 4 * 128 * 128; i += F.G * NTHR) { const int mtx = i >> 14, d = (i >> 7) & 127, c = i & 127, li = mtx >> 2, gg = mtx & 3;
        wp[(size_t)li * 512 * 512 + (size_t)(gg * 128 + d) * 512 + gg * 128 + c] = (bf16)f2bf(A.in[2][(size_t)mtx * 16384 + c * 128 + d]); }
    for (int i = (F.vcu * NTHR + F.tid); i < 2 * 512 * 64; i += F.G * NTHR) {
        const int li = i / (512 * 64), rem = i % (512 * 64), row = rem / 64, ch = rem % 64;
        if ((row >> 7) != (ch >> 4)) *(GAS v4u*)(wp + (size_t)li * 512 * 512 + (size_t)row * 512 + ch * 8) = (v4u){0u, 0u, 0u, 0u};
    }
}

__device__ __forceinline__ void moe_tables(Frame& F, int layer) {
    if (F.tid < 64) {
        const int e = F.tid & 31;
        const unsigned n = __hip_atomic_load((unsigned*)(F.ctl + CW_CNT + (layer * 32 + e) * 64), RLX_AGENT), t = (n + 255u) >> 8;
        unsigned incl = t;
#pragma unroll
        for (int o = 1; o < 32; o <<= 1) { const unsigned up = __shfl_up(incl, o, 32); if (e >= o) incl += up; }
        const unsigned tb = incl - t;
        if (F.tid < 32) {
            F.MISC[MW_CNT + e] = n; F.MISC[MW_ROWBASE + e] = tb * 256u; F.MISC[MW_TBASE + e] = tb;
            for (unsigned k = 0; k < t; ++k) F.MISC[MW_TILEE + tb + k] = (unsigned)e;
            if (e == 31) { F.MISC[MW_ROWBASE + 32] = incl * 256u; F.MISC[MW_NTILES] = incl; }
        }
    }
    __syncthreads();
}
constexpr int XS_LD = 1028;
template <int MODE>
__device__ __forceinline__ void rw_phase(Frame& F, const Args& A, int layer) {
    LAS float* xs = (LAS float*)(F.lds + RING_OFF);
    LAS float* part = (LAS float*)(F.lds + RING_OFF + 16 * XS_LD * 4);
    const int lane = F.lane, w = F.wave, tid = F.tid;
    const float* pw = nullptr; size_t ldw = 0; int ncols = 0; const float* pbias = nullptr;
    if (MODE == 1) { pw = A.in[19] + (size_t)layer * 1024 * 32; ldw = 32; ncols = 32; pbias = A.in[20] + layer * 32; }
    else { const int nl = (MODE == 0) ? 0 : layer + 1;
        if (nl < DEPTH) { if (nl & 1) { pw = A.in[10] + (size_t)(nl >> 1) * 1024 * ODD_IN + NO_P; ldw = ODD_IN; ncols = 16; } else { pw = A.in[1] + (size_t)(nl >> 1) * 1024 * EVEN_IN + NE_P; ldw = EVEN_IN; ncols = 8; } } }
    const float* lg = nullptr; const float* lb = nullptr;
    if (MODE == 1) { lg = A.in[15] + layer * D; lb = A.in[16] + layer * D; }
    if (MODE == 2) { lg = A.in[17] + layer * D; lb = A.in[18] + layer * D; }
    bf16* XB = (bf16*)(F.ws + WS_XB); bf16* X1B = (bf16*)(F.ws + WS_X1B);
    const bf16* PRE = (const bf16*)(F.ws + WS_PRE); const bf16* Y = (const bf16*)(F.ws + WS_Y); float* GATES = (float*)(F.ws + WS_GATES);
    float* GATE = (float*)(F.ws + WS_GATE); int* SLOT = (int*)(F.ws + WS_SLOT); int* LIST = (int*)(F.ws + WS_LIST);
    if (MODE == 1) { if (tid < 32) F.MISC[MW_LCNT + tid] = 0u; __syncthreads(); }
    if (MODE == 2 && MK_SPLIT) moe_tables(F, layer);
    float bw0[8][4], bw1[8][4];
    { const int kq = lane >> 4, c0 = lane & 15, c1 = 16 + (lane & 15);
#pragma unroll
        for (int st = 0; st < 8; ++st)
#pragma unroll
            for (int j = 0; j < 4; ++j) { const int k = 128 * w + 16 * st + 4 * kq + j;
                bw0[st][j] = (ncols > 0 && c0 < ncols) ? pw[(size_t)k * ldw + c0] : 0.f; bw1[st][j] = (MODE == 1 && ncols > 0 && c1 < ncols) ? pw[(size_t)k * ldw + c1] : 0.f; } }
    f32x4 lgv[4], lbv[4];
#pragma unroll
    for (int j = 0; j < 4; ++j) { lgv[j] = (MODE != 0) ? *((const GAS f32x4*)lg + lane + 64 * j) : (f32x4){1.f, 1.f, 1.f, 1.f}; lbv[j] = (MODE != 0) ? *((const GAS f32x4*)lb + lane + 64 * j) : (f32x4){0.f, 0.f, 0.f, 0.f}; }
    int srow = 0, gbits = 0;
    if (MODE == 2) { const int tl = F.vcu + (lane >> 3) * F.G;
        if (tl < M / 16) { const int tk = (tl * 16 + 2 * w + ((lane >> 2) & 1)) * 4 + (lane & 3); const int idx = SLOT[tk]; srow = (int)F.MISC[MW_TBASE + (idx >> 14)] * 256 + (idx & 16383); gbits = __builtin_bit_cast(int, GATE[tk]); } }
    f32x4 rx[2][4]; v2u xx[2][4], yy[2][4][4]; float gk[2][4];
#define RW_ISSUE(tile_, tc_) do { const int tok0_ = (tile_) * 16 + 2 * w; \
        if (MODE == 0) { _Pragma("unroll") for (int rr = 0; rr < 2; ++rr) { const GAS f32x4* xr = (const GAS f32x4*)(A.in[0] + (size_t)(tok0_ + rr) * D) + lane; _Pragma("unroll") for (int j = 0; j < 4; ++j) rx[rr][j] = xr[64 * j]; } } \
        else if (MODE == 1) { _Pragma("unroll") for (int rr = 0; rr < 2; ++rr) { const GAS v2u* xr = (const GAS v2u*)(PRE + (size_t)(tok0_ + rr) * D) + lane; _Pragma("unroll") for (int j = 0; j < 4; ++j) xx[rr][j] = xr[64 * j]; } } \
        else { _Pragma("unroll") for (int rr = 0; rr < 2; ++rr) _Pragma("unroll") for (int k = 0; k < 4; ++k) { const int li = (tc_) * 8 + rr * 4 + k; const int s = __builtin_amdgcn_readlane(srow, li); gk[rr][k] = __builtin_bit_cast(float, __builtin_amdgcn_readlane(gbits, li)); \
                    const GAS v2u* yr = (const GAS v2u*)(Y + (size_t)s * D) + lane; _Pragma("unroll") for (int j = 0; j < 4; ++j) yy[rr][k][j] = yr[64 * j]; } \
            _Pragma("unroll") for (int rr = 0; rr < 2; ++rr) { const GAS v2u* xr = (const GAS v2u*)(X1B + (size_t)(tok0_ + rr) * D) + lane; _Pragma("unroll") for (int j = 0; j < 4; ++j) xx[rr][j] = xr[64 * j]; } } } while (0)
    int tcount = 0;
    if (F.vcu < M / 16) RW_ISSUE(F.vcu, 0);
    for (int tile = F.vcu; tile < M / 16; tile += F.G, ++tcount) {
        f32x4 vv[2][4];
#pragma unroll
        for (int rr = 0; rr < 2; ++rr)
#pragma unroll
            for (int j = 0; j < 4; ++j) {
                if (MODE == 0) vv[rr][j] = rx[rr][j];
                else { f32x4 a = (f32x4){bflo(xx[rr][j].x), bfhi(xx[rr][j].x), bflo(xx[rr][j].y), bfhi(xx[rr][j].y)};
                    if (MODE == 2) { a = a * ALPHA;
#pragma unroll
                        for (int k = 0; k < 4; ++k) { const v2u y2 = yy[rr][k][j]; const float g = gk[rr][k]; a.x += bflo(y2.x) * g; a.y += bfhi(y2.x) * g; a.z += bflo(y2.y) * g; a.w += bfhi(y2.y) * g; } }
                    vv[rr][j] = a; } }
        if (tile + F.G < M / 16) RW_ISSUE(tile + F.G, tcount + 1);
#pragma unroll
        for (int rr = 0; rr < 2; ++rr) {
            const int r = 2 * w + rr, tok = tile * 16 + r;
            f32x4 v[4];
#pragma unroll
            for (int j = 0; j < 4; ++j) v[j] = vv[rr][j];
            if (MODE != 0) {
                float s = 0.f;
#pragma unroll
                for (int j = 0; j < 4; ++j) s += (v[j].x + v[j].y) + (v[j].z + v[j].w);
                const float mean = wave_sum(s) * (1.f / D); float s2 = 0.f;
#pragma unroll
                for (int j = 0; j < 4; ++j) { v[j] = v[j] - mean; s2 += (v[j].x * v[j].x + v[j].y * v[j].y) + (v[j].z * v[j].z + v[j].w * v[j].w); }
                const float rstd = __builtin_amdgcn_rsqf(wave_sum(s2) * (1.f / D) + LN_EPS);
#pragma unroll
                for (int j = 0; j < 4; ++j) v[j] = v[j] * rstd * lgv[j] + lbv[j];
                if (MODE == 2 && layer == DEPTH - 1) { GAS f32x4* o4 = (GAS f32x4*)(F.out + (size_t)tok * D) + lane;
#pragma unroll
                    for (int j = 0; j < 4; ++j) o4[64 * j] = v[j]; }
            }
            bf16* bo = (MODE == 1) ? X1B : XB;
            GAS v2u* o8 = (GAS v2u*)(bo + (size_t)tok * D) + lane;
            if (!(MODE == 2 && layer == DEPTH - 1)) {
#pragma unroll
                for (int j = 0; j < 4; ++j) { v2u p; p.x = pk2(v[j].x, v[j].y); p.y = pk2(v[j].z, v[j].w); o8[64 * j] = p; } }
            if (MODE == 1 && MOE_FP8_GU) { GAS unsigned* o4 = (GAS unsigned*)(F.ws + WS_X1F8 + (size_t)tok * D) + lane;
#pragma unroll
                for (int j = 0; j < 4; ++j) o4[64 * j] = pg8::pk4_fp8(v[j].x, v[j].y, v[j].z, v[j].w); }
            if (ncols > 0) {
#pragma unroll
                for (int j = 0; j < 4; ++j) *(LAS f32x4*)(xs + r * XS_LD + 4 * lane + 256 * j) = v[j]; }
        }
        if (ncols > 0) __syncthreads();
        if (ncols > 0) {
            f32x4 acc0 = {0.f, 0.f, 0.f, 0.f}, acc1 = {0.f, 0.f, 0.f, 0.f};
            const int prow = lane & 15, kq = lane >> 4, c0 = lane & 15, c1 = 16 + (lane & 15);
#pragma unroll
            for (int st = 0; st < 8; ++st) {
                const int k0 = 128 * w + 16 * st + 4 * kq;
                const f32x4 a = *(const LAS f32x4*)(xs + prow * XS_LD + k0);
#pragma unroll
                for (int j = 0; j < 4; ++j) {
                    acc0 = __builtin_amdgcn_mfma_f32_16x16x4f32(a[j], bw0[st][j], acc0, 0, 0, 0);
                    if (MODE == 1) acc1 = __builtin_amdgcn_mfma_f32_16x16x4f32(a[j], bw1[st][j], acc1, 0, 0, 0);
                }
            }
#pragma unroll
            for (int g = 0; g < 4; ++g) { part[(w * 16 + kq * 4 + g) * 32 + c0] = acc0[g]; part[(w * 16 + kq * 4 + g) * 32 + c1] = acc1[g]; }
        }
        __syncthreads();
        if (ncols > 0) {
            const int r = tid >> 5, c = tid & 31, tok = tile * 16 + r;
            float val = 0.f;
#pragma unroll
            for (int ww = 0; ww < 8; ++ww) val += part[(ww * 16 + r) * 32 + c];
            if (MODE != 1) { if (c < ncols) GATES[tok * 16 + c] = val; }
            else {
                val += pbias[c];
                float cur = val; float selv[4]; int seli[4];
#pragma unroll
                for (int k = 0; k < 4; ++k) {
                    float bv = cur; int bi = c;
#pragma unroll
                    for (int off = 16; off >= 1; off >>= 1) { const float ov = __shfl_xor(bv, off); const int oi = __shfl_xor(bi, off); if (ov > bv || (ov == bv && oi < bi)) { bv = ov; bi = oi; } }
                    selv[k] = bv; seli[k] = bi; if (c == bi) cur = -3.0e38f;
                }
                if (c < 4) {
                    const float e0 = 1.f, e1 = __expf(selv[1] - selv[0]), e2 = __expf(selv[2] - selv[0]), e3 = __expf(selv[3] - selv[0]);
                    const float inv = __builtin_amdgcn_rcpf(e0 + e1 + e2 + e3);
                    const float ge = (c == 0) ? e0 : (c == 1) ? e1 : (c == 2) ? e2 : e3;
                    const int ee = (c == 0) ? seli[0] : (c == 1) ? seli[1] : (c == 2) ? seli[2] : seli[3];
                    GATE[tok * 4 + c] = ge * inv;
                    const unsigned rank = __hip_atomic_fetch_add((LAS unsigned*)(F.lds + MISC_OFF) + MW_LCNT + ee, 1u, __ATOMIC_RELAXED, __HIP_MEMORY_SCOPE_WORKGROUP);
                    F.MISC[MW_PICK + tcount * 64 + r * 4 + c] = (unsigned)ee | (rank << 8);
                }
            }
        }
        __syncthreads();
    }
    if (MODE == 1) {
        if (tid < 32) { const unsigned n = F.MISC[MW_LCNT + tid]; unsigned base = 0u; if (n) base = __hip_atomic_fetch_add((unsigned*)(F.ctl + CW_CNT + (layer * 32 + tid) * 64), n, RLX_AGENT); F.MISC[MW_WBASE + tid] = base; }
        __syncthreads();
        for (int i = tid; i < tcount * 64; i += NTHR) { const int tc = i >> 6, r = (i >> 2) & 15, k = i & 3; const int tok = (F.vcu + tc * F.G) * 16 + r;
            const unsigned pk = F.MISC[MW_PICK + i]; const int idx = (int)((pk & 0xffu) * 16384u + F.MISC[MW_WBASE + (pk & 0xffu)] + (pk >> 8)); SLOT[tok * 4 + k] = idx; LIST[idx] = tok; }
        __syncthreads();
    }
}

constexpr size_t WS_QW = WS_QK, WS_KW = WS_QK + 16 * MiB, WS_ST = WS_XS;
constexpr size_t WS_BT = WS_H, WS_CM = WS_H + 256 * 1024, WS_RMAX = WS_H + 512 * 1024, WS_GC = WS_H + 516 * 1024, WS_MPREV = WS_H + 520 * 1024, WS_EBL = WS_H + 1 * MiB;
constexpr int KP = 136;

__device__ __forceinline__ pg8::f32x4 mma16(pg8::bf16x8 a, pg8::bf16x8 b, pg8::f32x4 c) { return __builtin_amdgcn_mfma_f32_16x16x32_bf16(a, b, c, 0, 0, 0); }

__device__ __forceinline__ void even_prep2(Frame& F, const Args& A, int li) {
    const bf16* P = (const bf16*)(F.ws + WS_P); bf16* QW = (bf16*)(F.ws + WS_QW); bf16* KW = (bf16*)(F.ws + WS_KW); bf16* DD = (bf16*)(F.ws + WS_DD);
    const float* GATES = (const float*)(F.ws + WS_GATES);
    float* BT = (float*)(F.ws + WS_BT); float* CM = (float*)(F.ws + WS_CM); float* RMAX = (float*)(F.ws + WS_RMAX); float* GC = (float*)(F.ws + WS_GC);
    const float* cw = A.in[4] + (size_t)li * 4 * 1024; const float* cb = A.in[5] + (size_t)li * 1024;
    LAS float* gs = (LAS float*)(F.lds + RING_OFF); LAS float* ls = gs + 256; LAS float* rs = ls + 256; LAS float* fac = rs + 256;
    const int tid = F.tid;
    for (int unit = F.vcu; unit < 256; unit += F.G) {
        const int tok0 = (unit >> 6) * SEQ + (unit & 63) * 64;
        v4u rows[19];
        { const int ch = (tid & 127) * 8, tb = tok0 + 16 * (tid >> 7), s0 = tb & (SEQ - 1);
#pragma unroll
            for (int r = 0; r < 19; ++r) { rows[r] = (v4u){0u, 0u, 0u, 0u}; if (s0 - 3 + r >= 0) rows[r] = *(const GAS v4u*)(P + (size_t)(tb - 3 + r) * LDP + 512 + ch); } }
        if (tid < 256) { const int t = tid >> 2, h = tid & 3; gs[tid] = GATES[(size_t)(tok0 + t) * 16 + h] + A.in[6][li * 4 + h]; ls[tid] = logsigmoidf_(GATES[(size_t)(tok0 + t) * 16 + 4 + h] + A.in[7][li * 4 + h]); }
        __syncthreads();
        if (tid < 256) {
            const int h = tid >> 6, t = tid & 63;
            float bs = ls[t * 4 + h];
#pragma unroll
            for (int o = 1; o < 64; o <<= 1) { const float up = __shfl_up(bs, o); if (t >= o) bs += up; }
            const float r = gs[t * 4 + h] - bs; float cm = r;
#pragma unroll
            for (int o = 1; o < 64; o <<= 1) { const float up = __shfl_up(cm, o); if (t >= o) cm = fmaxf(cm, up); }
            const float rmax = __shfl(cm, 63), gsum = __shfl(bs, 63);
            BT[(size_t)(tok0 + t) * 4 + h] = bs; CM[(size_t)(tok0 + t) * 4 + h] = cm;
            if (t == 0) { RMAX[unit * 4 + h] = rmax; GC[unit * 4 + h] = gsum; }
            fac[t * 4 + h] = __expf(r - rmax) * 0.08838834764831845f;
        }
        __syncthreads();
        {
            const int ch = (tid & 127) * 8, tb = tok0 + 16 * (tid >> 7);
            float wv[4][8], bv[8];
#pragma unroll
            for (int i = 0; i < 8; ++i) { bv[i] = cb[ch + i];
#pragma unroll
                for (int jj = 0; jj < 4; ++jj) wv[jj][i] = cw[jj * 1024 + ch + i]; }
#pragma unroll
            for (int t = 0; t < 16; ++t) {
                float acc[8];
#pragma unroll
                for (int i = 0; i < 8; ++i) acc[i] = bv[i];
#pragma unroll
                for (int jj = 0; jj < 4; ++jj) { const v4u pv = rows[t + jj];
                    acc[0] += wv[jj][0] * bflo(pv.x); acc[1] += wv[jj][1] * bfhi(pv.x); acc[2] += wv[jj][2] * bflo(pv.y); acc[3] += wv[jj][3] * bfhi(pv.y);
                    acc[4] += wv[jj][4] * bflo(pv.z); acc[5] += wv[jj][5] * bfhi(pv.z); acc[6] += wv[jj][6] * bflo(pv.w); acc[7] += wv[jj][7] * bfhi(pv.w); }
                const int tl = 16 * (tid >> 7) + t;
                const float sc = (ch >= 512) ? fac[tl * 4 + ((ch - 512) >> 7)] : 1.0f;
#pragma unroll
                for (int i = 0; i < 8; ++i) acc[i] = acc[i] * sigmoidf_(acc[i]) * sc;
                v4u o; o.x = pk2(acc[0], acc[1]); o.y = pk2(acc[2], acc[3]); o.z = pk2(acc[4], acc[5]); o.w = pk2(acc[6], acc[7]);
                if (ch < 512) *(GAS v4u*)(QW + (size_t)(tb + t) * 512 + ch) = o; else *(GAS v4u*)(KW + (size_t)(tb + t) * 512 + ch - 512) = o;
            }
        }
        {
            const int ch = (tid & 63) * 8, tb = tok0 + 8 * (tid >> 6), s0 = tb & (SEQ - 1), win = 2 << (ch >> 7);
            v4u rows[23];
#pragma unroll
            for (int r = 0; r < 23; ++r) { rows[r] = (v4u){0u, 0u, 0u, 0u}; if (r >= 16 - win && s0 - 15 + r >= 0) rows[r] = *(const GAS v4u*)(P + (size_t)(tb - 15 + r) * LDP + ch); }
#pragma unroll
            for (int t = 0; t < 8; ++t) {
                const int s = s0 + t, n = (s + 1 < win) ? (s + 1) : win;
                float acc[8] = {0.f, 0.f, 0.f, 0.f, 0.f, 0.f, 0.f, 0.f};
#pragma unroll
                for (int jj = 0; jj < 16; ++jj) { if (jj < win) { const v4u pv = rows[15 + t - jj];
                        acc[0] += bflo(pv.x); acc[1] += bfhi(pv.x); acc[2] += bflo(pv.y); acc[3] += bfhi(pv.y); acc[4] += bflo(pv.z); acc[5] += bfhi(pv.z); acc[6] += bflo(pv.w); acc[7] += bfhi(pv.w); } }
                const v4u u = rows[15 + t]; const float inv = __builtin_amdgcn_rcpf((float)n);
                const float u0[8] = {bflo(u.x), bfhi(u.x), bflo(u.y), bfhi(u.y), bflo(u.z), bfhi(u.z), bflo(u.w), bfhi(u.w)};
#pragma unroll
                for (int i = 0; i < 8; ++i) acc[i] = acc[i] * inv - u0[i];
                v4u o; o.x = pk2(acc[0], acc[1]); o.y = pk2(acc[2], acc[3]); o.z = pk2(acc[4], acc[5]); o.w = pk2(acc[6], acc[7]);
                *(GAS v4u*)(DD + (size_t)(tb + t) * 512 + ch) = o;
            }
        }
        __syncthreads();
    }
}
__device__ __forceinline__ void odd_prep(Frame& F, const Args& A, int li) {
    const bf16* P = (const bf16*)(F.ws + WS_P); bf16* QW = (bf16*)(F.ws + WS_QW); bf16* KW = (bf16*)(F.ws + WS_KW); float* EBL = (float*)(F.ws + WS_EBL);
    const float* GATES = (const float*)(F.ws + WS_GATES);
    const float* w2 = A.in[11] + (size_t)li * 16 * 512; const float* gb = A.in[12] + (size_t)li * 512;
    LAS float* gl = (LAS float*)(F.lds + RING_OFF);
    const int tid = F.tid, d = tid;
    float wc[16];
#pragma unroll
    for (int r = 0; r < 16; ++r) wc[r] = w2[r * 512 + d];
    const float gbv = gb[d];
    for (int unit = F.vcu; unit < 256; unit += F.G) {
        const int tok0 = (unit >> 6) * SEQ + (unit & 63) * 64;
        for (int i = tid; i < 1024; i += NTHR) gl[i] = GATES[(size_t)(tok0 + (i >> 4)) * 16 + (i & 15)];
        __syncthreads();
        float Bc = 0.f;
        unsigned short qn[8], kn[8];
#pragma unroll
        for (int j = 0; j < 8; ++j) { qn[j] = P[(size_t)(tok0 + j) * LDP + d]; kn[j] = P[(size_t)(tok0 + j) * LDP + 512 + d]; }
        for (int t0 = 0; t0 < 64; t0 += 8) {
            unsigned short qv[8], kv[8];
#pragma unroll
            for (int j = 0; j < 8; ++j) { qv[j] = qn[j]; kv[j] = kn[j]; }
            { const int tn = (t0 + 8 < 64) ? t0 + 8 : t0;
#pragma unroll
                for (int j = 0; j < 8; ++j) { qn[j] = P[(size_t)(tok0 + tn + j) * LDP + d]; kn[j] = P[(size_t)(tok0 + tn + j) * LDP + 512 + d]; } }
#pragma unroll
            for (int j = 0; j < 8; ++j) {
                const int t = t0 + j;
                float z = gbv;
#pragma unroll
                for (int r = 0; r < 16; ++r) z += gl[t * 16 + r] * wc[r];
                Bc += logsigmoidf_(z) * 0.0625f;
                QW[(size_t)(tok0 + t) * 512 + d] = (bf16)f2bf(bf2f(qv[j]) * 0.08838834764831845f * __expf(Bc));
                KW[(size_t)(tok0 + t) * 512 + d] = (bf16)f2bf(bf2f(kv[j]) * __expf(-Bc));
            }
        }
        EBL[unit * 512 + d] = __expf(Bc);
        __syncthreads();
    }
}
template <bool EVEN>
__device__ __forceinline__ void stage_rows128(Frame& F, const bf16* src, int tok0, int h, LAS unsigned char* dst) {
    for (int i = F.tid; i < 1024; i += NTHR) { const int t = i >> 4, ch = i & 15; const v4u x = *(const GAS v4u*)(src + (size_t)(tok0 + t) * 512 + h * 128 + ch * 8); *(LAS v4u*)(dst + t * (KP * 2) + ch * 16) = x; }
}
template <bool EVEN>
__device__ __forceinline__ void stage_v(Frame& F, int tok0, int h, LAS unsigned char* Vs) {
    constexpr int DV = EVEN ? 128 : 256, DVP = EVEN ? 144 : 256, VPB = (DVP + 8) * 2, CH = DV / 8;
    const bf16* P = (const bf16*)(F.ws + WS_P) + (EVEN ? 1536 : 1024) + h * DV;
    for (int i = F.tid; i < 64 * CH; i += NTHR) { const int t = i / CH, ch = i % CH; const v4u x = *(const GAS v4u*)(P + (size_t)(tok0 + t) * LDP + ch * 8); *(LAS v4u*)(Vs + t * VPB + ch * 16) = x; }
    if (EVEN) { if (F.tid < 128) { const int t = F.tid >> 1, ch = F.tid & 1; v4u x = {0u, 0u, 0u, 0u}; if (ch == 0) x.x = 0x00003F80u; *(LAS v4u*)(Vs + t * VPB + (128 + ch * 8) * 2) = x; } }
}
__device__ __forceinline__ void ld_rows128(Frame& F, const bf16* src, int tok0, int h, v4u (&r)[2]) {
#pragma unroll
    for (int k = 0; k < 2; ++k) { const int i = F.tid + NTHR * k, t = i >> 4, ch = i & 15; r[k] = *(const GAS v4u*)(src + (size_t)(tok0 + t) * 512 + h * 128 + ch * 8); }
}
__device__ __forceinline__ void st_rows128(Frame& F, LAS unsigned char* dst, const v4u (&r)[2]) {
#pragma unroll
    for (int k = 0; k < 2; ++k) { const int i = F.tid + NTHR * k, t = i >> 4, ch = i & 15; *(LAS v4u*)(dst + t * (KP * 2) + ch * 16) = r[k]; }
}
template <bool EVEN>
__device__ __forceinline__ void ld_v(Frame& F, int tok0, int h, v4u (&r)[EVEN ? 2 : 4]) {
    constexpr int DV = EVEN ? 128 : 256, CH = DV / 8, NK = EVEN ? 2 : 4;
    const bf16* P = (const bf16*)(F.ws + WS_P) + (EVEN ? 1536 : 1024) + h * DV;
#pragma unroll
    for (int k = 0; k < NK; ++k) { const int i = F.tid + NTHR * k, t = i / CH, ch = i % CH; r[k] = *(const GAS v4u*)(P + (size_t)(tok0 + t) * LDP + ch * 8); }
}
template <bool EVEN>
__device__ __forceinline__ void st_v(Frame& F, LAS unsigned char* Vs, const v4u (&r)[EVEN ? 2 : 4]) {
    constexpr int DV = EVEN ? 128 : 256, DVP = EVEN ? 144 : 256, VPB = (DVP + 8) * 2, CH = DV / 8, NK = EVEN ? 2 : 4;
#pragma unroll
    for (int k = 0; k < NK; ++k) { const int i = F.tid + NTHR * k, t = i / CH, ch = i % CH; *(LAS v4u*)(Vs + t * VPB + ch * 16) = r[k]; }
    if (EVEN) { if (F.tid < 128) { const int t = F.tid >> 1, ch = F.tid & 1; v4u x = {0u, 0u, 0u, 0u}; if (ch == 0) x.x = 0x00003F80u; *(LAS v4u*)(Vs + t * VPB + (128 + ch * 8) * 2) = x; } }
}
template <bool EVEN>
__device__ __forceinline__ void mix_phaseA(Frame& F) {
    constexpr int DVP = EVEN ? 144 : 256, NTW = EVEN ? 1 : 2, VPB = (DVP + 8) * 2, KPB = KP * 2;
    LAS unsigned char* KWs = F.lds + RING_OFF; LAS unsigned char* Vs = KWs + 64 * KPB;
    const bf16* KW = (const bf16*)(F.ws + WS_KW); bf16* ST = (bf16*)(F.ws + WS_ST);
    const int lane = F.lane, w = F.wave, g = lane >> 4, q = (lane & 15) >> 2, p = lane & 3;
    v4u rk[2], rv[EVEN ? 2 : 4];
    if (F.vcu * 4 < 1024) { const int unit = F.vcu, b = unit >> 6, c = unit & 63; ld_rows128(F, KW, b * SEQ + c * 64, 0, rk); ld_v<EVEN>(F, b * SEQ + c * 64, 0, rv); }
    for (int uu = F.vcu * 4; uu < 1024; uu += F.G * 4)
    for (int h = 0; h < 4; ++h) {
        const int unit = uu >> 2, b = unit >> 6, c = unit & 63, bh = b * 4 + h, u = bh * 64 + c, tok0 = b * SEQ + c * 64;
        st_rows128(F, KWs, rk); st_v<EVEN>(F, Vs, rv);
        __syncthreads();
        { const int nh = (h + 1) & 3, nuu = (h == 3) ? uu + F.G * 4 : uu;
            if (nuu < 1024) { const int nunit = nuu >> 2, nb = nunit >> 6, nc = nunit & 63; ld_rows128(F, KW, nb * SEQ + nc * 64, nh, rk); ld_v<EVEN>(F, nb * SEQ + nc * 64, nh, rv); } }
        pg8::f32x4 acc[NTW][8]; pg8::f32x4 accx = {0.f, 0.f, 0.f, 0.f};
#pragma unroll
        for (int j = 0; j < NTW; ++j)
#pragma unroll
            for (int mt = 0; mt < 8; ++mt) acc[j][mt] = (pg8::f32x4){0.f, 0.f, 0.f, 0.f};
#pragma unroll
        for (int ks = 0; ks < 2; ++ks) {
            pg8::bf16x8 bv[NTW], bx;
#pragma unroll
            for (int j = 0; j < NTW; ++j) bv[j] = tr8(Vs + (32 * ks + 8 * g + q) * VPB + (16 * (w * NTW + j) + 4 * p) * 2, VPB);
            if (EVEN) bx = tr8(Vs + (32 * ks + 8 * g + q) * VPB + (128 + 4 * p) * 2, VPB);
#pragma unroll
            for (int mt = 0; mt < 8; ++mt) {
                const pg8::bf16x8 a = tr8(KWs + (32 * ks + 8 * g + q) * KPB + (16 * mt + 4 * p) * 2, KPB);
#pragma unroll
                for (int j = 0; j < NTW; ++j) acc[j][mt] = mma16(a, bv[j], acc[j][mt]);
                if (EVEN) { if (mt == w) accx = mma16(a, bx, accx); }
            }
        }
#pragma unroll
        for (int j = 0; j < NTW; ++j)
#pragma unroll
            for (int mt = 0; mt < 8; ++mt) { v2u o; o.x = pk2(acc[j][mt][0], acc[j][mt][1]); o.y = pk2(acc[j][mt][2], acc[j][mt][3]);
                *(GAS v2u*)(ST + ((size_t)u * DVP + 16 * (w * NTW + j) + (lane & 15)) * 128 + 16 * mt + 4 * g) = o; }
        if (EVEN) { v2u o; o.x = pk2(accx[0], accx[1]); o.y = pk2(accx[2], accx[3]); *(GAS v2u*)(ST + ((size_t)u * DVP + 128 + (lane & 15)) * 128 + 16 * w + 4 * g) = o; }
        __syncthreads();
    }
}
template <bool EVEN>
__device__ __forceinline__ void mix_scan(Frame& F, int nwg_s, int idx_s) {
    constexpr int DVP = EVEN ? 144 : 256, NTK = DVP * 16;
    bf16* ST = (bf16*)(F.ws + WS_ST);
    const float* RMAX = (const float*)(F.ws + WS_RMAX); const float* GC = (const float*)(F.ws + WS_GC); float* MPREV = (float*)(F.ws + WS_MPREV); const float* EBL = (const float*)(F.ws + WS_EBL);
    if (idx_s >= 0)
    for (int gi = (F.wave * nwg_s + idx_s) * 64 + F.lane; gi < 16 * NTK; gi += nwg_s * NTHR) {
        const int bh = gi / NTK, rem = gi % NTK, dv = rem >> 4, d8 = rem & 15, b = bh >> 2, h = bh & 3;
        bf16* base = ST + ((size_t)(bh * 64) * DVP + dv) * 128 + d8 * 8;
        float s[8];
#pragma unroll
        for (int i = 0; i < 8; ++i) s[i] = 0.f;
        float m = 0.f;
        for (int c0 = 0; c0 < 64; c0 += 8) {
            v4u uu[8];
#pragma unroll
            for (int k = 0; k < 8; ++k) uu[k] = *(const GAS v4u*)(base + (size_t)(c0 + k) * DVP * 128);
#pragma unroll
            for (int k = 0; k < 8; ++k) {
                const int c = c0 + k;
                const float u8[8] = {bflo(uu[k].x), bfhi(uu[k].x), bflo(uu[k].y), bfhi(uu[k].y), bflo(uu[k].z), bfhi(uu[k].z), bflo(uu[k].w), bfhi(uu[k].w)};
                v4u o;
                if (EVEN) {
                    const float rmax = RMAX[(b * 64 + c) * 4 + h], gc = GC[(b * 64 + c) * 4 + h];
                    const float Mc = fmaxf(m, rmax), al = __expf(m - Mc), be = __expf(rmax - Mc), kap = __expf(m - rmax);
                    o.x = pk2(kap * s[0], kap * s[1]); o.y = pk2(kap * s[2], kap * s[3]); o.z = pk2(kap * s[4], kap * s[5]); o.w = pk2(kap * s[6], kap * s[7]);
                    if (dv == 0 && d8 == 0) MPREV[bh * 64 + c] = m;
#pragma unroll
                    for (int i = 0; i < 8; ++i) s[i] = al * s[i] + be * u8[i];
                    m = gc + Mc;
                } else {
                    o.x = pk2(s[0], s[1]); o.y = pk2(s[2], s[3]); o.z = pk2(s[4], s[5]); o.w = pk2(s[6], s[7]);
                    const f32x4 a0 = *(const GAS f32x4*)(EBL + (size_t)(b * 64 + c) * 512 + h * 128 + d8 * 8), a1 = *(const GAS f32x4*)(EBL + (size_t)(b * 64 + c) * 512 + h * 128 + d8 * 8 + 4);
                    const float al[8] = {a0.x, a0.y, a0.z, a0.w, a1.x, a1.y, a1.z, a1.w};
#pragma unroll
                    for (int i = 0; i < 8; ++i) s[i] = al[i] * (s[i] + u8[i]);
                }
                *(GAS v4u*)(base + (size_t)c * DVP * 128) = o;
            }
        }
    }
}
template <bool EVEN>
__device__ __forceinline__ void mix_phaseC(Frame& F, const Args& A, int li) {
    constexpr int DV = EVEN ? 128 : 256, DVP = EVEN ? 144 : 256, NTW = EVEN ? 1 : 2, VPB = (DVP + 8) * 2, KPB = KP * 2, PPB = 72 * 2, OP = DVP + 4;
    LAS unsigned char* QWs = F.lds + RING_OFF; LAS unsigned char* KWs = QWs + 64 * KPB; LAS unsigned char* Vs = KWs + 64 * KPB; LAS unsigned char* PS = F.lds + RING_OFF + 68608;
    LAS float* rho = (LAS float*)(F.lds + RING_OFF + 77824); LAS float* thr = rho + 64; LAS float* OUT = (LAS float*)(F.lds + RING_OFF);
    static_assert(64 * KPB * 2 + 64 * VPB <= 68608 && 64 * OP * 4 <= 68608, "phase C LDS map");
    const bf16* QW = (const bf16*)(F.ws + WS_QW); const bf16* KW = (const bf16*)(F.ws + WS_KW); const bf16* ST = (const bf16*)(F.ws + WS_ST);
    const bf16* P = (const bf16*)(F.ws + WS_P); bf16* MIX = (bf16*)(F.ws + WS_MIX);
    const float* gn = EVEN ? A.in[8] + (size_t)li * 512 : A.in[13] + (size_t)li * 1024;
    const int lane = F.lane, w = F.wave, g = lane >> 4, q = (lane & 15) >> 2, p = lane & 3, l15 = lane & 15;
    v4u rq[2], rk[2], rv[EVEN ? 2 : 4];
    float pcm = 0.f, pbt = 0.f, prmax = 0.f, pmp = 0.f;
    if (F.vcu < 1024) { const int u = F.vcu, bh = u >> 6, c = u & 63, tok0 = (bh >> 2) * SEQ + c * 64, h = bh & 3; ld_rows128(F, QW, tok0, h, rq); ld_rows128(F, KW, tok0, h, rk); ld_v<EVEN>(F, tok0, h, rv);
        if (EVEN) { if (F.tid < 64) { const int t = F.tid; pcm = ((const float*)(F.ws + WS_CM))[(size_t)(tok0 + t) * 4 + h]; pbt = ((const float*)(F.ws + WS_BT))[(size_t)(tok0 + t) * 4 + h];
                prmax = ((const float*)(F.ws + WS_RMAX))[((bh >> 2) * 64 + c) * 4 + h]; pmp = ((const float*)(F.ws + WS_MPREV))[u]; } } }
    for (int u = F.vcu; u < 1024; u += F.G) {
        const int bh = u >> 6, c = u & 63, b = bh >> 2, h = bh & 3, tok0 = b * SEQ + c * 64;
        pg8::bf16x8 sb[4][NTW], sbx[4];
#pragma unroll
        for (int ks = 0; ks < 4; ++ks) {
#pragma unroll
            for (int j = 0; j < NTW; ++j) sb[ks][j] = *(const GAS pg8::bf16x8*)(ST + ((size_t)u * DVP + 16 * (w * NTW + j) + l15) * 128 + 32 * ks + 8 * g);
            if (EVEN) sbx[ks] = *(const GAS pg8::bf16x8*)(ST + ((size_t)u * DVP + 128 + l15) * 128 + 32 * ks + 8 * g);
        }
        st_rows128(F, QWs, rq); st_rows128(F, KWs, rk); st_v<EVEN>(F, Vs, rv);
        if (EVEN) { if (F.tid < 64) { const int t = F.tid;
                const float cm = pcm, bt = pbt, rmax = prmax, mp = pmp;
                const float Mt = fmaxf(mp, cm); rho[t] = __expf(rmax - Mt); thr[t] = __expf(-(bt + Mt)); } }
        __syncthreads();
        if (u + F.G < 1024) { const int nu = u + F.G, nbh = nu >> 6, nc = nu & 63, ntok0 = (nbh >> 2) * SEQ + nc * 64, nh = nbh & 3;
            ld_rows128(F, QW, ntok0, nh, rq); ld_rows128(F, KW, ntok0, nh, rk); ld_v<EVEN>(F, ntok0, nh, rv);
            if (EVEN) { if (F.tid < 64) { const int t = F.tid; pcm = ((const float*)(F.ws + WS_CM))[(size_t)(ntok0 + t) * 4 + nh]; pbt = ((const float*)(F.ws + WS_BT))[(size_t)(ntok0 + t) * 4 + nh];
                    prmax = ((const float*)(F.ws + WS_RMAX))[((nbh >> 2) * 64 + nc) * 4 + nh]; pmp = ((const float*)(F.ws + WS_MPREV))[nu]; } } }
        {
            const int mt = w >> 1;
            pg8::f32x4 pa[2] = {{0.f, 0.f, 0.f, 0.f}, {0.f, 0.f, 0.f, 0.f}};
#pragma unroll
            for (int ks = 0; ks < 4; ++ks) {
                const pg8::bf16x8 a = *(const LAS pg8::bf16x8*)(QWs + (16 * mt + l15) * KPB + (32 * ks + 8 * g) * 2);
#pragma unroll
                for (int jj = 0; jj < 2; ++jj) { const int nt = 2 * (w & 1) + jj; const pg8::bf16x8 bb = *(const LAS pg8::bf16x8*)(KWs + (16 * nt + l15) * KPB + (32 * ks + 8 * g) * 2); pa[jj] = mma16(a, bb, pa[jj]); }
            }
#pragma unroll
            for (int jj = 0; jj < 2; ++jj) { const int nt = 2 * (w & 1) + jj, s = 16 * nt + l15;
#pragma unroll
                for (int r = 0; r < 4; ++r) { const int t = 16 * mt + 4 * g + r; *(LAS bf16*)(PS + t * PPB + s * 2) = (bf16)((s <= t) ? f2bf(pa[jj][r]) : 0u); } }
        }
        __syncthreads();
        unsigned og[8]; v2u rg[8];
#pragma unroll
        for (int rr = 0; rr < 8; ++rr) { if (EVEN) og[rr] = *(const GAS unsigned*)(P + (size_t)(tok0 + 8 * w + rr) * LDP + 2048 + h * 128 + 2 * lane); else rg[rr] = *(const GAS v2u*)(P + (size_t)(tok0 + 8 * w + rr) * LDP + 2048 + h * 256 + 4 * lane); }
        pg8::f32x4 acc[NTW][4]; pg8::f32x4 accx = {0.f, 0.f, 0.f, 0.f};
#pragma unroll
        for (int j = 0; j < NTW; ++j)
#pragma unroll
            for (int mt = 0; mt < 4; ++mt) acc[j][mt] = (pg8::f32x4){0.f, 0.f, 0.f, 0.f};
#pragma unroll
        for (int ks = 0; ks < 2; ++ks) {
            pg8::bf16x8 bv[NTW], bx;
#pragma unroll
            for (int j = 0; j < NTW; ++j) bv[j] = tr8(Vs + (32 * ks + 8 * g + q) * VPB + (16 * (w * NTW + j) + 4 * p) * 2, VPB);
            if (EVEN) bx = tr8(Vs + (32 * ks + 8 * g + q) * VPB + (128 + 4 * p) * 2, VPB);
#pragma unroll
            for (int mt = 0; mt < 4; ++mt) {
                const pg8::bf16x8 a = *(const LAS pg8::bf16x8*)(PS + (16 * mt + l15) * PPB + (32 * ks + 8 * g) * 2);
#pragma unroll
                for (int j = 0; j < NTW; ++j) acc[j][mt] = mma16(a, bv[j], acc[j][mt]);
                if (EVEN) { if (mt == w) accx = mma16(a, bx, accx); }
            }
        }
#pragma unroll
        for (int ks = 0; ks < 4; ++ks) {
#pragma unroll
            for (int mt = 0; mt < 4; ++mt) {
                const pg8::bf16x8 a = *(const LAS pg8::bf16x8*)(QWs + (16 * mt + l15) * KPB + (32 * ks + 8 * g) * 2);
#pragma unroll
                for (int j = 0; j < NTW; ++j) acc[j][mt] = mma16(a, sb[ks][j], acc[j][mt]);
                if (EVEN) { if (mt == w) accx = mma16(a, sbx[ks], accx); }
            }
        }
        __syncthreads();
#pragma unroll
        for (int j = 0; j < NTW; ++j)
#pragma unroll
            for (int mt = 0; mt < 4; ++mt)
#pragma unroll
                for (int r = 0; r < 4; ++r) OUT[(16 * mt + 4 * g + r) * OP + 16 * (w * NTW + j) + l15] = acc[j][mt][r];
        if (EVEN) { if (w < 4) {
#pragma unroll
                for (int r = 0; r < 4; ++r) OUT[(16 * w + 4 * g + r) * OP + 128 + l15] = accx[r]; } }
        __syncthreads();
        if (EVEN) {
            const float g0 = gn[h * 128 + 2 * lane], g1 = gn[h * 128 + 2 * lane + 1];
#pragma unroll
            for (int rr = 0; rr < 8; ++rr) {
                const int t = 8 * w + rr; const size_t tok = (size_t)(tok0 + t);
                const float v0 = OUT[t * OP + 2 * lane], v1 = OUT[t * OP + 2 * lane + 1], den = OUT[t * OP + 128], rh = rho[t];
                const float dd = __builtin_amdgcn_rcpf(fmaxf(fabsf(rh * den), thr[t]));
                float h0 = rh * v0 * dd, h1 = rh * v1 * dd;
                const float mu = wave_sum(h0 + h1) * (1.f / 128.f); h0 -= mu; h1 -= mu;
                const float rs = __builtin_amdgcn_rsqf(wave_sum(h0 * h0 + h1 * h1) * (1.f / 128.f) + LN_EPS);
                const float o0 = h0 * rs * g0 * sigmoidf_(bflo(og[rr])), o1 = h1 * rs * g1 * sigmoidf_(bfhi(og[rr]));
                *(GAS unsigned*)(MIX + tok * 1024 + 512 + h * 128 + 2 * lane) = pk2(o0, o1);
            }
        } else {
            const f32x4 gg = *(const GAS f32x4*)(gn + h * 256 + 4 * lane);
#pragma unroll
            for (int rr = 0; rr < 8; ++rr) {
                const int t = 8 * w + rr; const size_t tok = (size_t)(tok0 + t);
                f32x4 v = *(const LAS f32x4*)(OUT + t * OP + 4 * lane);
                const float mu = wave_sum((v.x + v.y) + (v.z + v.w)) * (1.f / 256.f); v = v - mu;
                const float rs = __builtin_amdgcn_rsqf(wave_sum((v.x * v.x + v.y * v.y) + (v.z * v.z + v.w * v.w)) * (1.f / 256.f) + LN_EPS);
                const float r0 = bflo(rg[rr].x), r1 = bfhi(rg[rr].x), r2 = bflo(rg[rr].y), r3 = bfhi(rg[rr].y);
                v2u o; o.x = pk2(v.x * rs * gg.x * (r0 * sigmoidf_(r0)), v.y * rs * gg.y * (r1 * sigmoidf_(r1))); o.y = pk2(v.z * rs * gg.z * (r2 * sigmoidf_(r2)), v.w * rs * gg.w * (r3 * sigmoidf_(r3)));
                *(GAS v2u*)(MIX + tok * 1024 + h * 256 + 4 * lane) = o;
            }
        }
        __syncthreads();
    }
}

#define IN(k) (lo <= (k) && (k) < hi)
#define SEAM(k) do { if (!MK_SPLIT && (k) + 1 < hi) xcd_barrier(bar); } while (0)
template <int layer>
__device__ __forceinline__ void layer_body(Frame& F, const Args& args, const XcdBarrier& bar, const int lo, const int hi) {
        { int t_ = threadIdx.x; asm volatile("" : "+v"(t_)); F.tid = t_; F.lane = t_ & 63; F.wave = __builtin_amdgcn_readfirstlane(t_ >> 6);
          int v_ = F.vcu, g_ = F.G; asm volatile("" : "+s"(v_), "+s"(g_)); F.vcu = v_; F.G = g_; F.ws = args.ws; F.ctl = (gu32*)(args.ws + WS_CTL); }
        const int pb = 1 + layer * NPH, li = layer >> 1; const bool odd = layer & 1;
        bf16* XB = (bf16*)(F.ws + WS_XB); bf16* P = (bf16*)(F.ws + WS_P); bf16* MIX = (bf16*)(F.ws + WS_MIX);
        if (IN(pb + 0)) {
            const bf16* wt = odd ? (const bf16*)(F.ws + WS_WINO) + (size_t)li * NO_P * 1024 : (const bf16*)(F.ws + WS_WINE) + (size_t)li * NE_P * 1024;
            const int N = odd ? NO_P : NE_P;
            pg8::Gemm g{XB, wt, M, N, D}; pg8::StaticOrder S; S.init(M, N, F.G, (int)blockIdx.x);
            pg8::EpiStoreBf16 E{P, LDP, nullptr, 0};
            for (int rep = 0; rep < (PROBE_DUP == 5 ? 2 : 1); ++rep) pg8::gemm_phase<pg8::EpiStoreBf16, pg8::StaticOrder, true, true>(F.lds + RING_OFF, g, S, E);
            SEAM(pb + 0);
        }
        if (IN(pb + 1)) {
            if (odd) odd_prep(F, args, li); else even_prep2(F, args, li);
            if (PROBE_DUP == 4) { if (odd) odd_prep(F, args, li); else even_prep2(F, args, li); }
            VM_WAIT(); __syncthreads();
            if (odd) mix_phaseA<false>(F); else mix_phaseA<true>(F);
            if (PROBE_DUP == 2) { if (odd) mix_phaseA<false>(F); else mix_phaseA<true>(F); }
            SEAM(pb + 1);
        }
        if (IN(pb + 4)) {
            const bool split = !odd && F.G == 256;
            if (odd) mix_scan<false>(F, F.G, F.vcu); else mix_scan<true>(F, split ? 128 : F.G, split ? (int)blockIdx.x - 128 : F.vcu);
            if (!odd) {
                pg8::Gemm g{(const bf16*)(F.ws + WS_DD), (const bf16*)(F.ws + WS_WP) + (size_t)li * 512 * 512, M, 512, 512}; pg8::StaticOrder S; S.init(M, 512, F.G, (int)blockIdx.x);
                pg8::EpiStoreBf16 E{MIX, 1024, args.in[3] + (size_t)li * 512, 0};
                for (int rep = 0; rep < (PROBE_DUP == 5 ? 2 : 1); ++rep) pg8::gemm_phase<pg8::EpiStoreBf16, pg8::StaticOrder, true, true>(F.lds + RING_OFF, g, S, E);
            }
            SEAM(pb + 4);
        }
        if (IN(pb + 5)) { if (odd) mix_phaseC<false>(F, args, li); else mix_phaseC<true>(F, args, li); if (PROBE_DUP == 2) { if (odd) mix_phaseC<false>(F, args, li); else mix_phaseC<true>(F, args, li); } SEAM(pb + 5); }
        if (IN(pb + 6)) {
            pg8::Gemm g{MIX, (const bf16*)(F.ws + WS_WOUT) + (size_t)layer * 1024 * 1024, M, D, D}; pg8::StaticOrder S; S.init(M, D, F.G, (int)blockIdx.x);
            pg8::EpiResBf16 E{(const bf16*)(F.ws + WS_XB), (bf16*)(F.ws + WS_PRE), D, ALPHA};
            for (int rep = 0; rep < (PROBE_DUP == 5 ? 2 : 1); ++rep) pg8::gemm_phase<pg8::EpiResBf16, pg8::StaticOrder, true, true>(F.lds + RING_OFF, g, S, E);
            SEAM(pb + 6);
        }
#ifndef X_NO_RW
        if (IN(pb + 7)) {
            p0_convert(F, args, layer, 1024 + F.vcu, F.G, 3072); __syncthreads();
            rw_phase<1>(F, args, layer); SEAM(pb + 7); }
#endif
        if (IN(pb + 9)) {
            moe_tables(F, layer);
            pg8::Gemm g{(const bf16*)(F.ws + (MOE_FP8_GU ? WS_X1F8 : WS_X1B)), (const bf16*)(F.ws + WS_WGU) + (size_t)layer * 32 * 2048 * 1024 / (MOE_FP8_GU ? 2 : 1), MAXROWS, 32 * 2048, MOE_FP8_GU ? D / 2 : D};
            pg8::MoeOrder S{8, F.G, F.vcu, (int)F.MISC[MW_NTILES] * 8, (const LAS int*)(F.lds + MISC_OFF) + MW_TILEE, (const LAS int*)(F.lds + MISC_OFF) + MW_TBASE, (const LAS int*)(F.lds + MISC_OFF) + MW_CNT, 0, 0};
            pg8::EpiSwiglu E{(bf16*)(F.ws + WS_ACT), args.in[22] + (size_t)layer * 32 * 2048, 0, MOE_FP8_DOWN ? (unsigned char*)(F.ws + WS_ACT8) : nullptr, MOE_FP8_GU ? 1.0f / WGU_SCALE : 1.0f};
            {
                LAS int* gc = (LAS int*)(F.lds + GCACHE_OFF); const int* LIST = (const int*)(F.ws + WS_LIST);
                const int r = F.tid & 255, s0 = F.tid >> 8; int tk[GCACHE_SLOTS / 2];
#pragma unroll
                for (int i = 0; i < GCACHE_SLOTS / 2; ++i) { pg8::Unit uu; const bool ok = S.next(2 * i + s0, uu); const bool valid = ok && (r < uu.nval); const int ai = valid ? (uu.aidx + r) : 0; const int t = LIST[ai]; tk[i] = valid ? t : 0; }
#pragma unroll
                for (int i = 0; i < GCACHE_SLOTS / 2; ++i) gc[(2 * i + s0) * 256 + r] = tk[i];
                __syncthreads();
            }
            for (int rep = 0; rep < (PROBE_DUP == 3 ? 2 : 1); ++rep) pg8::gemm_phase<pg8::EpiSwiglu, pg8::MoeOrder, true, true, true, MOE_FP8_GU != 0>(F.lds + RING_OFF, g, S, E, (const LAS int*)(F.lds + GCACHE_OFF));
            if (PROBE_DUP == 6 || PROBE_DUP == 7 || PROBE_DUP == 8) { pg8::MoeOrder S2 = S; S2.force0 = (PROBE_DUP == 6) ? 1 : 0; pg8::EpiSwiglu E2{(bf16*)(F.ws + WS_END), args.in[22] + (size_t)layer * 32 * 2048, (PROBE_DUP == 7) ? (args.ph_hi > 0) : 0, nullptr, MOE_FP8_GU ? 1.0f / WGU_SCALE : 1.0f}; pg8::gemm_phase<pg8::EpiSwiglu, pg8::MoeOrder, true, true, true, MOE_FP8_GU != 0>(F.lds + RING_OFF, g, S2, E2, (const LAS int*)(F.lds + GCACHE_OFF)); }
            {
                const int total = (int)F.MISC[MW_NTILES] * 8, rem = (F.G == 256) ? (total & 255) : 0, nidle = rem ? 256 - rem : 0, nbusy = F.G - nidle;
                int x = (F.G == 256) ? (1024 - 4 * nidle) / 256 : 1024 / F.G; if (x < 0) x = 0;
                const int left = 1024 - nbusy * x, q = nidle ? (left + nidle - 1) / nidle : 0;
                int j0, j1;
                if (nidle == 0 || F.vcu < rem) { j0 = F.vcu * x; j1 = j0 + x; if (nidle == 0 && F.vcu == F.G - 1) j1 = 1024; }
                else { j0 = nbusy * x + (F.vcu - rem) * q; j1 = j0 + q; }
                if (j1 > 1024) j1 = 1024;
                p0_convert(F, args, layer, j0, 1, j1);
            }
            SEAM(pb + 9);
        }
        if (IN(pb + 10)) {
            if (MK_SPLIT) moe_tables(F, layer);
            pg8::Gemm g{(const bf16*)(F.ws + (MOE_FP8_DOWN ? WS_ACT8 : WS_ACT)), (const bf16*)(F.ws + WS_WDN) + (size_t)layer * 32 * 1024 * 1024 / (MOE_FP8_DOWN ? 2 : 1), MAXROWS, 32 * 1024, MOE_FP8_DOWN ? D / 2 : D};
            pg8::MoeOrder S{4, F.G, F.vcu, (int)F.MISC[MW_NTILES] * 4, (const LAS int*)(F.lds + MISC_OFF) + MW_TILEE, (const LAS int*)(F.lds + MISC_OFF) + MW_TBASE, (const LAS int*)(F.lds + MISC_OFF) + MW_CNT, 0, 1};
            pg8::EpiDown E{(bf16*)(F.ws + WS_Y), args.in[24] + (size_t)layer * 32 * 1024, 0, MOE_FP8_DOWN ? 1.0f / WDN_SCALE : 1.0f};
            for (int rep = 0; rep < (PROBE_DUP == 3 ? 2 : 1); ++rep) pg8::gemm_phase<pg8::EpiDown, pg8::MoeOrder, true, true, false, MOE_FP8_DOWN != 0>(F.lds + RING_OFF, g, S, E);
            if (PROBE_DUP == 6 || PROBE_DUP == 7 || PROBE_DUP == 8) { pg8::MoeOrder S2 = S; S2.force0 = (PROBE_DUP == 6) ? 1 : 0; pg8::EpiDown E2{(bf16*)(F.ws + WS_END), args.in[24] + (size_t)layer * 32 * 1024, (PROBE_DUP == 7) ? (args.ph_hi > 0) : 0, MOE_FP8_DOWN ? 1.0f / WDN_SCALE : 1.0f}; pg8::gemm_phase<pg8::EpiDown, pg8::MoeOrder, true, true, false, MOE_FP8_DOWN != 0>(F.lds + RING_OFF, g, S2, E2); }
            SEAM(pb + 10);
        }
#ifndef X_NO_RW
        if (IN(pb + 11)) { rw_phase<2>(F, args, layer); if (PROBE_DUP == 4) rw_phase<2>(F, args, layer); SEAM(pb + 11); }
#endif
}
__global__ void __launch_bounds__(NTHR, 2) fwd_kernel(Args args) {
    extern __shared__ __attribute__((aligned(16))) unsigned char lds[];
    Frame F;
    F.lds = (LAS unsigned char*)lds; F.MISC = (volatile LAS unsigned*)(F.lds + MISC_OFF);
    F.tid = threadIdx.x; F.lane = F.tid & 63; F.wave = __builtin_amdgcn_readfirstlane(F.tid >> 6);
    F.G = gridDim.x; { const int bx = blockIdx.x; F.vcu = (F.G % 8 == 0) ? (bx % 8) * (F.G / 8) + bx / 8 : bx; }
    F.ws = args.ws; F.ctl = (gu32*)(args.ws + WS_CTL); F.out = args.out;
    for (int u = F.tid; u < 2048; u += NTHR) ((LAS unsigned*)(F.lds + MISC_OFF))[u] = 0u;
    __syncthreads();
    const int lo = args.ph_lo, hi = args.ph_hi;
    XcdBarrier bar; bar.bar = (unsigned*)(F.ctl + CW_BAR); bar.x = 0; bar.st = nullptr;
    if (!MK_SPLIT) bar = xcd_barrier_post((unsigned*)(F.ctl + CW_BAR), F.MISC + 8);

    #ifndef X_NO_P0
    if (IN(0)) { p0_weights(F, args); __syncthreads(); if (PROBE_DUP == 1) { p0_weights(F, args); __syncthreads(); }
        if (PROBE_DUP == 9) { const size_t n4 = ((size_t)4 * 32 * 1024 * 2048 + (size_t)4 * 32 * 1024 * 1024) / 4; const size_t n4a = (size_t)4 * 32 * 1024 * 2048 / 4;
            for (size_t i = (size_t)F.vcu * NTHR + F.tid; i < n4; i += (size_t)F.G * NTHR) { const f32x4 v = __builtin_nontemporal_load((const GAS f32x4*)(i < n4a ? args.in[21] : args.in[23] - n4a * 4) + i);
                v2u o; o.x = pk2(v.x, v.y); o.y = pk2(v.z, v.w); *((GAS v2u*)(F.ws + WS_END) + i) = o; } } rw_phase<0>(F, args, 0); SEAM(0); }
#endif

    layer_body<0>(F, args, bar, lo, hi);
    layer_body<1>(F, args, bar, lo, hi);
    layer_body<2>(F, args, bar, lo, hi);
    layer_body<3>(F, args, bar, lo, hi);
#undef IN
#undef SEAM
}

extern "C" void kernel_launch(void* const* d_in, const int* in_sizes, int n_in, void* d_out, int out_size, void* d_ws, size_t ws_size, hipStream_t stream) {
    static int grid = 0;
    if (grid == 0) {
        if (n_in != 25 || in_sizes[0] != M * D || out_size != M * D || ws_size < WS_END + 1024 * MiB) { fprintf(stderr, "kernel_launch: unexpected shapes (n_in %d, in0 %d, out %d, ws %zu)\n", n_in, n_in > 0 ? in_sizes[0] : -1, out_size, ws_size); grid = -1; return; }
        int dev = 0, cus = 0, per_cu = 0;
        if (hipGetDevice(&dev) != hipSuccess || hipDeviceGetAttribute(&cus, hipDeviceAttributeMultiprocessorCount, dev) != hipSuccess) { grid = -1; return; }
        if (hipFuncSetAttribute((const void*)fwd_kernel, hipFuncAttributeMaxDynamicSharedMemorySize, LDS_BYTES) != hipSuccess) { fprintf(stderr, "kernel_launch: hipFuncSetAttribute failed\n"); grid = -1; return; }
        if (hipOccupancyMaxActiveBlocksPerMultiprocessor(&per_cu, (const void*)fwd_kernel, NTHR, LDS_BYTES) != hipSuccess || per_cu < 1) { fprintf(stderr, "kernel_launch: occupancy query says %d\n", per_cu); }
        (void)hipGetLastError();
        grid = cus;
    }
    if (grid < 0) return;
    if (hipMemsetAsync((char*)d_ws + WS_CTL, 0, CTL_ZERO_BYTES, stream) != hipSuccess) return;
    Args a{};
    for (int i = 0; i < 25; ++i) a.in[i] = (const float*)d_in[i];
    a.out = (float*)d_out; a.ws = (unsigned char*)d_ws;
#if MK_SPLIT
    for (int k = 0; k < NPHASES; ++k) {
        if (k >= 1) { const int j = (k - 1) % NPH, layer = (k - 1) / NPH; if (j == 2 || j == 3 || j == 8) continue; }
        a.ph_lo = k; a.ph_hi = k + 1;
        hipLaunchKernelGGL(fwd_kernel, dim3(grid), dim3(NTHR), LDS_BYTES, stream, a);
    }
#else
    a.ph_lo = 0; a.ph_hi = NPHASES;
    hipLaunchKernelGGL(fwd_kernel, dim3(grid), dim3(NTHR), LDS_BYTES, stream, a);
#endif
}
```

```cpp
#include <hip/hip_runtime.h>
#include <cstdio>
#include <cstdint>
namespace pg8 {
#define PG8_LAS __attribute__((address_space(3)))
typedef unsigned short bf16_t;
typedef short bf16x8 __attribute__((ext_vector_type(8)));
typedef float f32x4 __attribute__((ext_vector_type(4)));
typedef unsigned u32x4 __attribute__((ext_vector_type(4)));
constexpr int BM = 256, BK = 64, HALF = 128, HTB = HALF * BK * 2  , STAGE_BYTES = 8 * HTB, NXCD = 8, WGM = 8;

__host__ __device__ __forceinline__ int lds_byte(int r, int c) { const int st = (r >> 4) * 2 + (c >> 5), rr = r & 15, cc = c & 31, ob = rr * 64 + cc * 2; return st * 1024 + (ob ^ (((ob >> 9) & 1) << 5)); }
__host__ __device__ __forceinline__ void stage_rc(int b, int& R, int& C) { const int st = b / 1024, sb = b % 1024, swz = sb ^ (((sb >> 9) & 1) << 5); R = (st >> 1) * 16 + swz / 64; C = (st & 1) * 32 + (swz % 64) / 2; }
__host__ __device__ __forceinline__ int perm32(int rho) { const int n = rho >> 4, i = rho & 15; return 8 * (i >> 2) + 4 * n + (i & 3); }

struct Unit { int pm, pn, aidx, nval, slot; };
struct Gemm { const bf16_t* A; const bf16_t* Bt; int M, N, K; };

struct StaticOrder {
    int nM, nN, nwg, G, c;
    __host__ __device__ void init(int M, int N, int G_, int c_) { nM = M / BM; nN = N / BM; nwg = nM * nN; G = G_; c = c_; }
    __host__ __device__ bool next(int i, Unit& u) const {
        const long L = (long)i * G + c; if (L >= nwg) return false;
        int wgid = (int)L; { const int q = nwg / NXCD, r = nwg % NXCD, xcd = wgid % NXCD, off = wgid / NXCD; wgid = (xcd < r ? xcd * (q + 1) : r * (q + 1) + (xcd - r) * q) + off; }
        const int nig = WGM * nN, gid = wgid / nig, fm = gid * WGM, gsz = (nM - fm) < WGM ? (nM - fm) : WGM;
        u.pm = fm + ((wgid % nig) % gsz); u.pn = (wgid % nig) / gsz; return true;
    }
    __device__ __forceinline__ void a_ready(const Unit&) const {}
    __device__ __forceinline__ void done(const Unit&) const {}
};

typedef float f32x2c_t __attribute__((ext_vector_type(2))); typedef __bf16 bf16x2c_t __attribute__((ext_vector_type(2)));
__device__ __forceinline__ unsigned cvt_pk_bf16(float lo, float hi) { f32x2c_t v = {lo, hi}; bf16x2c_t b = __builtin_convertvector(v, bf16x2c_t); return __builtin_bit_cast(unsigned, b); }
typedef float f32x2 __attribute__((ext_vector_type(2)));

struct EpiStoreBf16 {
    static constexpr bool PERM = true, AFTER_DRAIN = false;
    bf16_t* O; int ldc; const float* scale; int col_off;
    __device__ __forceinline__ void operator()(const f32x4 (&acc)[2][2][4][2], const Unit& u, int wr, int wc, int fr, int fq) const {
        const int row0 = u.pm * BM + wr * 64 + fr, col0 = u.pn * BM + wc * 32 + 8 * fq;
        f32x4 sv[2][2];
#pragma unroll
        for (int bj = 0; bj < 2; ++bj)
#pragma unroll
            for (int n = 0; n < 2; ++n) sv[bj][n] = scale ? *(const f32x4*)(scale + col0 + bj * HALF + 4 * n) : (f32x4){1.f, 1.f, 1.f, 1.f};
#pragma unroll
        for (int ai = 0; ai < 2; ++ai)
#pragma unroll
            for (int m = 0; m < 4; ++m) { bf16_t* rowp = O + (size_t)(row0 + ai * HALF + m * 16) * ldc + col_off + col0;
#pragma unroll
                for (int bj = 0; bj < 2; ++bj) { const f32x4 v0 = acc[ai][bj][m][0] * sv[bj][0], v1 = acc[ai][bj][m][1] * sv[bj][1];
                    u32x4 w; w.x = cvt_pk_bf16(v0[0], v0[1]); w.y = cvt_pk_bf16(v0[2], v0[3]); w.z = cvt_pk_bf16(v1[0], v1[1]); w.w = cvt_pk_bf16(v1[2], v1[3]);
                    *(u32x4*)(rowp + bj * HALF) = w; } }
    }
};
struct EpiResBf16 {
    static constexpr bool PERM = true, AFTER_DRAIN = false;
    const bf16_t* X; bf16_t* O; int ldc; float alpha;
    __device__ __forceinline__ void operator()(const f32x4 (&acc)[2][2][4][2], const Unit& u, int wr, int wc, int fr, int fq) const {
        const int row0 = u.pm * BM + wr * 64 + fr, col0 = u.pn * BM + wc * 32 + 8 * fq;
        u32x4 xr[2][4][2];
#pragma unroll
        for (int ai = 0; ai < 2; ++ai)
#pragma unroll
            for (int m = 0; m < 4; ++m)
#pragma unroll
                for (int bj = 0; bj < 2; ++bj) xr[ai][m][bj] = *(const u32x4*)(X + (size_t)(row0 + ai * HALF + m * 16) * ldc + col0 + bj * HALF);
#pragma unroll
        for (int ai = 0; ai < 2; ++ai)
#pragma unroll
            for (int m = 0; m < 4; ++m) { const size_t off = (size_t)(row0 + ai * HALF + m * 16) * ldc + col0;
#pragma unroll
                for (int bj = 0; bj < 2; ++bj) { const u32x4 xx = xr[ai][m][bj];
                    const f32x4 x0 = {__builtin_bit_cast(float, xx.x << 16), __builtin_bit_cast(float, xx.x & 0xffff0000u), __builtin_bit_cast(float, xx.y << 16), __builtin_bit_cast(float, xx.y & 0xffff0000u)};
                    const f32x4 x1 = {__builtin_bit_cast(float, xx.z << 16), __builtin_bit_cast(float, xx.z & 0xffff0000u), __builtin_bit_cast(float, xx.w << 16), __builtin_bit_cast(float, xx.w & 0xffff0000u)};
                    const f32x4 v0 = x0 * alpha + acc[ai][bj][m][0], v1 = x1 * alpha + acc[ai][bj][m][1];
                    u32x4 w; w.x = cvt_pk_bf16(v0[0], v0[1]); w.y = cvt_pk_bf16(v0[2], v0[3]); w.z = cvt_pk_bf16(v1[0], v1[1]); w.w = cvt_pk_bf16(v1[2], v1[3]);
                    *(u32x4*)(O + off + bj * HALF) = w; } }
    }
};
__device__ __forceinline__ f32x2 swiglu2(f32x4 h) {
    f32x2 g = {fminf(h[0], 7.0f), fminf(h[2], 7.0f)}, l = {fminf(fmaxf(h[1], -7.0f), 7.0f), fminf(fmaxf(h[3], -7.0f), 7.0f)};
    const f32x2 t = g * (-2.4554669595930156f);
    f32x2 e2; e2.x = __builtin_amdgcn_exp2f(t.x); e2.y = __builtin_amdgcn_exp2f(t.y);
    const f32x2 d = e2 + 1.0f;
    f32x2 r; r.x = __builtin_amdgcn_rcpf(d.x); r.y = __builtin_amdgcn_rcpf(d.y);
    return (g * r) * (l + 1.0f);
}
__device__ __forceinline__ unsigned pk4_fp8(float a, float b, float c, float d) { int v = __builtin_amdgcn_cvt_pk_fp8_f32(a, b, 0, false); v = __builtin_amdgcn_cvt_pk_fp8_f32(c, d, v, true); return (unsigned)v; }
struct EpiSwiglu {
    static constexpr bool PERM = true, AFTER_DRAIN = false;
    bf16_t* ACT; const float* bgu; int skip; unsigned char* ACT8; float ascale;
    __device__ __forceinline__ void operator()(const f32x4 (&acc)[2][2][4][2], const Unit& u, int wr, int wc, int fr, int fq) const {
        if (skip && u.pm >= 0) return;
        const int e = u.pn >> 3, pnl = u.pn & 7;
        const int row0 = u.pm * BM + wr * 64 + fr, hcol0 = pnl * BM + wc * 32 + 8 * fq;
        f32x4 bv[2][2];
#pragma unroll
        for (int bj = 0; bj < 2; ++bj)
#pragma unroll
            for (int n = 0; n < 2; ++n) bv[bj][n] = *(const f32x4*)(bgu + (size_t)e * 2048 + hcol0 + bj * HALF + 4 * n);
#pragma unroll
        for (int ai = 0; ai < 2; ++ai)
#pragma unroll
            for (int m = 0; m < 4; ++m) { bf16_t* rowp = ACT + (size_t)(row0 + ai * HALF + m * 16) * 1024 + (hcol0 >> 1);
#pragma unroll
                for (int bj = 0; bj < 2; ++bj) { const f32x4 v0 = acc[ai][bj][m][0] * ascale + bv[bj][0], v1 = acc[ai][bj][m][1] * ascale + bv[bj][1];
                    typedef unsigned u32x2v __attribute__((ext_vector_type(2)));
                    const f32x2 a0 = swiglu2(v0), a1 = swiglu2(v1);
                    if (ACT8) *(unsigned*)(ACT8 + (size_t)(row0 + ai * HALF + m * 16) * 1024 + (hcol0 >> 1) + bj * (HALF / 2)) = pk4_fp8(a0.x, a0.y, a1.x, a1.y);
                    else { u32x2v w; w.x = cvt_pk_bf16(a0.x, a0.y); w.y = cvt_pk_bf16(a1.x, a1.y); *(u32x2v*)(rowp + bj * (HALF / 2)) = w; } } }
    }
};
struct EpiDown {
    static constexpr bool PERM = true, AFTER_DRAIN = false;
    bf16_t* Y; const float* bdn; int skip; float ascale;
    __device__ __forceinline__ void operator()(const f32x4 (&acc)[2][2][4][2], const Unit& u, int wr, int wc, int fr, int fq) const {
        if (skip && u.pm >= 0) return;
        const int e = u.pn >> 2, pnl = u.pn & 3;
        const int row0 = u.pm * BM + wr * 64 + fr, col0 = pnl * BM + wc * 32 + 8 * fq;
        f32x4 bv[2][2];
#pragma unroll
        for (int bj = 0; bj < 2; ++bj)
#pragma unroll
            for (int n = 0; n < 2; ++n) bv[bj][n] = *(const f32x4*)(bdn + (size_t)e * 1024 + col0 + bj * HALF + 4 * n);
#pragma unroll
        for (int ai = 0; ai < 2; ++ai)
#pragma unroll
            for (int m = 0; m < 4; ++m) { bf16_t* rowp = Y + (size_t)(row0 + ai * HALF + m * 16) * 1024 + col0;
#pragma unroll
                for (int bj = 0; bj < 2; ++bj) { const f32x4 v0 = acc[ai][bj][m][0] * ascale + bv[bj][0], v1 = acc[ai][bj][m][1] * ascale + bv[bj][1];
                    u32x4 w; w.x = cvt_pk_bf16(v0[0], v0[1]); w.y = cvt_pk_bf16(v0[2], v0[3]); w.z = cvt_pk_bf16(v1[0], v1[1]); w.w = cvt_pk_bf16(v1[2], v1[3]);
                    *(u32x4*)(rowp + bj * HALF) = w; } }
    }
};
struct MoeOrder {
    int NT, G, c, total; const PG8_LAS int* tile_e; const PG8_LAS int* tbase; const PG8_LAS int* cnt; int force0, rev;
    __device__ __forceinline__ bool next(int i, Unit& u) const {
        const int L = i * G + c; if (L >= total) return false;
        const int pm0 = L / NT, pnl = L - pm0 * NT, pm = rev ? (total / NT - 1 - pm0) : pm0; const int e = __builtin_amdgcn_readfirstlane(tile_e[pm]);
        const int pml = pm - __builtin_amdgcn_readfirstlane(tbase[e]);
        u.pm = pm; u.pn = (force0 ? 0 : e) * NT + pnl; u.aidx = e * 16384 + pml * 256; u.nval = __builtin_amdgcn_readfirstlane(cnt[e]) - pml * 256; u.slot = i; return true;
    }
    __device__ __forceinline__ void a_ready(const Unit&) const {}
    __device__ __forceinline__ void done(const Unit&) const {}
};
template <class Epi, class Sched, bool ALIGN_EPI = false, bool SP2 = false, bool GATHER = false, bool FP8 = false>
__device__ __forceinline__ void gemm_phase(PG8_LAS unsigned char* lds, const Gemm g, const Sched& S, const Epi& E, const PG8_LAS int* gcache = nullptr) {
    int tid_ = threadIdx.x; asm volatile("" : "+v"(tid_));
    const int tid = tid_, wid = __builtin_amdgcn_readfirstlane(tid >> 6), lane = tid & 63, wr = wid >> 2, wc = wid & 3, fr = lane & 15, fq = lane >> 4;
    const int K = g.K, nt = K / BK;
    unsigned voffA[2], voffB[2]; int rA[2]; unsigned cA2[2];
#pragma unroll
    for (int i = 0; i < 2; ++i) { int R, C; stage_rc(tid * 16 + i * 8192, R, C); const int Rb = Epi::PERM ? ((R & ~31) + perm32(R & 31)) : R;
        voffA[i] = (unsigned)(R * K + C) * 2u; voffB[i] = (unsigned)(Rb * K + C) * 2u; rA[i] = R; cA2[i] = (unsigned)C * 2u; }
    const size_t kstep = (size_t)(BK * 2);
    const size_t hstep = (size_t)HALF * K * 2;
    const size_t tstep = 2 * hstep;
    const unsigned ldsw = (unsigned)wid * 1024u;
    const int aoff = lds_byte(wr * 64 + fr, fq * 8), boff = lds_byte(wc * 32 + fr, fq * 8);
#define PG8_SA(b, h) (((b) * 2 + (h)) * HTB)
#define PG8_SB(b, h) ((4 + (b) * 2 + (h)) * HTB)
#define PG8_STAGE(bufoff, gbase, voff) do { _Pragma("unroll") for (int _i = 0; _i < 2; ++_i) \
        __builtin_amdgcn_global_load_lds((const unsigned*)((const char*)(gbase) + (voff)[_i]), (PG8_LAS unsigned*)(lds + (bufoff) + ldsw + _i * 8192), 16, 0, 0); } while (0)
#define PG8_STAGE_A(bufoff, ubase, half, gsel_) do { if constexpr (GATHER) { PG8_STAGE(bufoff, ubase, (gsel_)[half]); } else { PG8_STAGE(bufoff, (ubase) + (half) * hstep, voffA); } } while (0)
#define PG8_GOFF(u_, dst_) do { _Pragma("unroll") for (int _h = 0; _h < 2; ++_h) _Pragma("unroll") for (int _i = 0; _i < 2; ++_i) { const int _r = 128 * _h + rA[_i]; \
        const int _tok = gcache[(u_).slot * 256 + _r]; (dst_)[_h][_i] = (unsigned)_tok * (unsigned)(K * 2) + cA2[_i]; } } while (0)
#define PG8_LDA(dst, b, h) do { _Pragma("unroll") for (int m = 0; m < 4; ++m) { const i32x4_ lo_ = *(const PG8_LAS i32x4_*)(lds + PG8_SA(b, h) + aoff + m * 2048), hi_ = *(const PG8_LAS i32x4_*)(lds + PG8_SA(b, h) + aoff + m * 2048 + 1024); \
        dst[m] = __builtin_shufflevector(lo_, hi_, 0, 1, 2, 3, 4, 5, 6, 7); } } while (0)
#define PG8_LDB(dst, b, h) do { _Pragma("unroll") for (int n = 0; n < 2; ++n) { const i32x4_ lo_ = *(const PG8_LAS i32x4_*)(lds + PG8_SB(b, h) + boff + n * 2048), hi_ = *(const PG8_LAS i32x4_*)(lds + PG8_SB(b, h) + boff + n * 2048 + 1024); \
        dst[n] = __builtin_shufflevector(lo_, hi_, 0, 1, 2, 3, 4, 5, 6, 7); } } while (0)
#define PG8_MMA(ai, bj, At, Bt) do { __builtin_amdgcn_s_setprio(1); \
        if constexpr (FP8) { _Pragma("unroll") for (int m = 0; m < 4; ++m) _Pragma("unroll") for (int n = 0; n < 2; ++n) \
                asm volatile("v_mfma_scale_f32_16x16x128_f8f6f4 %0, %1, %2, %0, %3, %3 op_sel_hi:[0,0,0]" : "+v"(acc[ai][bj][m][n]) : "v"(Bt[n]), "v"(At[m]), "v"(mxscale)); } \
        else { _Pragma("unroll") for (int m = 0; m < 4; ++m) _Pragma("unroll") for (int n = 0; n < 2; ++n) { \
                acc[ai][bj][m][n] = __builtin_amdgcn_mfma_f32_16x16x32_bf16(__builtin_bit_cast(bf16x8, __builtin_shufflevector(Bt[n], Bt[n], 0, 1, 2, 3)), __builtin_bit_cast(bf16x8, __builtin_shufflevector(At[m], At[m], 0, 1, 2, 3)), acc[ai][bj][m][n], 0, 0, 0); \
                acc[ai][bj][m][n] = __builtin_amdgcn_mfma_f32_16x16x32_bf16(__builtin_bit_cast(bf16x8, __builtin_shufflevector(Bt[n], Bt[n], 4, 5, 6, 7)), __builtin_bit_cast(bf16x8, __builtin_shufflevector(At[m], At[m], 4, 5, 6, 7)), acc[ai][bj][m][n], 0, 0, 0); } } \
        __builtin_amdgcn_s_setprio(0); } while (0)
#define PG8_WAIT_V(n) asm volatile("s_waitcnt vmcnt(" #n ")" ::: "memory")
#define PG8_WAIT_L(n) asm volatile("s_waitcnt lgkmcnt(" #n ")" ::: "memory")
#define PG8_BAR __builtin_amdgcn_s_barrier()
#define PG8_SCHED __builtin_amdgcn_sched_barrier(0)
    Unit cur, nxt; int ui = 0; int mxscale = 0x7F7F7F7F; asm volatile("" : "+v"(mxscale));
    if (!S.next(0, cur)) return;
    f32x4 acc[2][2][4][2];
#pragma unroll
    for (int a = 0; a < 2; ++a)
#pragma unroll
        for (int b = 0; b < 2; ++b)
#pragma unroll
            for (int m = 0; m < 4; ++m)
#pragma unroll
                for (int n = 0; n < 2; ++n) acc[a][b][m][n] = (f32x4){0.f, 0.f, 0.f, 0.f};
    typedef int i32x4_ __attribute__((ext_vector_type(4))); typedef int i32x8_ __attribute__((ext_vector_type(8)));
    i32x8_ At[4], B0[2], B1[2];
    const char* cA = (const char*)g.A + (GATHER ? (size_t)0 : (size_t)cur.pm * tstep); const char* cB = (const char*)g.Bt + (size_t)cur.pn * tstep;
    unsigned gofc[2][2] = {{0u, 0u}, {0u, 0u}}, gofn[2][2] = {{0u, 0u}, {0u, 0u}};
    if constexpr (GATHER) PG8_GOFF(cur, gofc);
    S.a_ready(cur);
    if constexpr (SP2) {
        PG8_STAGE(PG8_SB(0, 0), cB, voffB); PG8_STAGE(PG8_SB(0, 1), cB + hstep, voffB); PG8_STAGE_A(PG8_SA(0, 0), cA, 0, gofc); PG8_STAGE_A(PG8_SA(0, 1), cA, 1, gofc);
        if (wr == 1) PG8_BAR;
        PG8_WAIT_V(2); PG8_BAR;
        PG8_STAGE(PG8_SB(1, 0), cB + kstep, voffB); PG8_STAGE_A(PG8_SA(1, 0), cA + kstep, 0, gofc); PG8_STAGE(PG8_SB(1, 1), cB + hstep + kstep, voffB);
        PG8_WAIT_V(6); PG8_BAR;
    } else {
        PG8_STAGE(PG8_SB(0, 0), cB, voffB); PG8_STAGE_A(PG8_SA(0, 0), cA, 0, gofc); PG8_STAGE(PG8_SB(0, 1), cB + hstep, voffB); PG8_STAGE_A(PG8_SA(0, 1), cA, 1, gofc);
        if (wr == 1) PG8_BAR;
        PG8_WAIT_V(4); PG8_BAR;
        PG8_STAGE(PG8_SB(1, 0), cB + kstep, voffB); PG8_STAGE_A(PG8_SA(1, 0), cA + kstep, 0, gofc); PG8_STAGE(PG8_SB(1, 1), cB + hstep + kstep, voffB);
        PG8_WAIT_V(6); PG8_BAR;
    }
    for (;;) {
        const bool has_next = S.next(ui + 1, nxt);
        const char* nA = (has_next && !GATHER) ? (const char*)g.A + (size_t)nxt.pm * tstep : cA; const char* nB = has_next ? (const char*)g.Bt + (size_t)nxt.pn * tstep : cB;
        if constexpr (GATHER) { if (has_next) PG8_GOFF(nxt, gofn); else {
#pragma unroll
                for (int _h = 0; _h < 2; ++_h) { gofn[_h][0] = gofc[_h][0]; gofn[_h][1] = gofc[_h][1]; } } }
#pragma unroll 1
        for (int t = 0; t < nt; t += 2) {
            const bool last = (t == nt - 2);
            const char* a1 = cA + (size_t)(t + 1) * kstep;
            const char* a2 = last ? nA : cA + (size_t)(t + 2) * kstep; const char* b2 = last ? nB : cB + (size_t)(t + 2) * kstep;
            const char* a3 = a2 + kstep; const char* b3 = b2 + kstep;
            unsigned gsel[2][2];
#pragma unroll
            for (int _h = 0; _h < 2; ++_h) { gsel[_h][0] = last ? gofn[_h][0] : gofc[_h][0]; gsel[_h][1] = last ? gofn[_h][1] : gofc[_h][1]; }
            if (last && has_next) S.a_ready(nxt);
            if constexpr (SP2) {
            PG8_LDB(B0, 0, 0); PG8_LDB(B1, 0, 1); PG8_SCHED; PG8_LDA(At, 0, 0); PG8_STAGE_A(PG8_SA(1, 1), a1, 1, gofc);
            PG8_WAIT_V(8); PG8_WAIT_L(0); PG8_BAR; PG8_MMA(0, 0, At, B0); PG8_MMA(0, 1, At, B1); PG8_BAR; PG8_SCHED;
            PG8_LDA(At, 0, 1); PG8_STAGE(PG8_SB(0, 0), b2, voffB); PG8_STAGE(PG8_SB(0, 1), b2 + hstep, voffB); PG8_STAGE_A(PG8_SA(0, 0), a2, 0, gsel);
            PG8_WAIT_V(8); PG8_WAIT_L(0); PG8_BAR; PG8_MMA(1, 0, At, B0); PG8_MMA(1, 1, At, B1); PG8_BAR; PG8_SCHED;
            PG8_LDB(B0, 1, 0); PG8_LDB(B1, 1, 1); PG8_SCHED; PG8_LDA(At, 1, 0); PG8_STAGE_A(PG8_SA(0, 1), a2, 1, gsel);
            PG8_WAIT_V(8); PG8_WAIT_L(0); PG8_BAR; PG8_MMA(0, 0, At, B0); PG8_MMA(0, 1, At, B1); PG8_BAR; PG8_SCHED;
            PG8_LDA(At, 1, 1); PG8_STAGE(PG8_SB(1, 0), b3, voffB); PG8_STAGE(PG8_SB(1, 1), b3 + hstep, voffB); PG8_STAGE_A(PG8_SA(1, 0), a3, 0, gsel);
            PG8_WAIT_V(8); PG8_WAIT_L(0); PG8_BAR; PG8_MMA(1, 0, At, B0); PG8_MMA(1, 1, At, B1); PG8_BAR; PG8_SCHED;
            } else {
            PG8_LDB(B0, 0, 0); PG8_SCHED; PG8_LDA(At, 0, 0); PG8_STAGE_A(PG8_SA(1, 1), a1, 1, gofc);
            PG8_WAIT_L(8); PG8_BAR; PG8_WAIT_L(0); PG8_MMA(0, 0, At, B0); PG8_BAR; PG8_SCHED;
            PG8_LDB(B1, 0, 1); PG8_STAGE(PG8_SB(0, 0), b2, voffB);
            PG8_BAR; PG8_WAIT_L(0); PG8_MMA(0, 1, At, B1); PG8_BAR;
            PG8_LDA(At, 0, 1); PG8_STAGE_A(PG8_SA(0, 0), a2, 0, gsel);
            PG8_BAR; PG8_WAIT_L(0); PG8_MMA(1, 0, At, B0); PG8_BAR; PG8_SCHED;
            PG8_STAGE(PG8_SB(0, 1), b2 + hstep, voffB);
            PG8_WAIT_V(6); PG8_BAR; PG8_MMA(1, 1, At, B1); PG8_BAR;
            PG8_LDB(B0, 1, 0); PG8_SCHED; PG8_LDA(At, 1, 0); PG8_STAGE_A(PG8_SA(0, 1), a2, 1, gsel);
            PG8_WAIT_L(8); PG8_BAR; PG8_WAIT_L(0); PG8_MMA(0, 0, At, B0); PG8_BAR; PG8_SCHED;
            PG8_LDB(B1, 1, 1); PG8_STAGE(PG8_SB(1, 0), b3, voffB);
            PG8_BAR; PG8_WAIT_L(0); PG8_MMA(0, 1, At, B1); PG8_BAR;
            PG8_LDA(At, 1, 1); PG8_STAGE_A(PG8_SA(1, 0), a3, 0, gsel);
            PG8_BAR; PG8_WAIT_L(0); PG8_MMA(1, 0, At, B0); PG8_BAR; PG8_SCHED;
            PG8_STAGE(PG8_SB(1, 1), b3 + hstep, voffB);
            PG8_WAIT_V(6); PG8_BAR; PG8_MMA(1, 1, At, B1); PG8_BAR;
            }
        }
        if constexpr (FP8) asm volatile("s_nop 15\n\ts_nop 15" ::: "memory");
        if constexpr (ALIGN_EPI) { if (wr == 0) PG8_BAR; }
        if constexpr (!Epi::AFTER_DRAIN) { E(acc, cur, wr, wc, fr, fq); S.done(cur); }
        if (!has_next) break;
#pragma unroll
        for (int a = 0; a < 2; ++a)
#pragma unroll
            for (int b = 0; b < 2; ++b)
#pragma unroll
                for (int m = 0; m < 4; ++m)
#pragma unroll
                    for (int n = 0; n < 2; ++n) acc[a][b][m][n] = (f32x4){0.f, 0.f, 0.f, 0.f};
        cur = nxt; cA = nA; cB = nB; ++ui;
        if constexpr (GATHER) {
#pragma unroll
            for (int _h = 0; _h < 2; ++_h) { gofc[_h][0] = gofn[_h][0]; gofc[_h][1] = gofn[_h][1]; } }
        if constexpr (ALIGN_EPI) { if (wr == 1) PG8_BAR; }
    }
    PG8_WAIT_V(0);
    if constexpr (!ALIGN_EPI) { if (wr == 0) PG8_BAR; }
    PG8_BAR;
    if constexpr (Epi::AFTER_DRAIN) { E.fused(acc, cur, wr, wc, fr, fq, lds, wid, lane); S.done(cur); }
#undef PG8_SA
#undef PG8_SB
#undef PG8_STAGE
#undef PG8_STAGE_A
#undef PG8_GOFF
#undef PG8_LDA
#undef PG8_LDB
#undef PG8_MMA
#undef PG8_WAIT_V
#undef PG8_WAIT_L
#undef PG8_BAR
#undef PG8_SCHED
}
}

constexpr int NWAVES = 8, NTHR = 512;
constexpr int SEQ = 4096, D = 1024, M = 16384, DEPTH = 4;
constexpr int EVEN_IN = 2568, ODD_IN = 3088, NE_P = 2560, NO_P = 3072, LDP = 3072;
constexpr int NEXP = 32, MAXROWS = 65536 + 32 * 256;
constexpr float ALPHA = 1.6817928305074290f, LN_EPS = 1e-5f;
constexpr int NPH = 12, NPHASES = 1 + DEPTH * NPH;
#ifndef PROBE_DUP
#define PROBE_DUP 0
#endif
#ifndef MOE_FP8_DOWN
#define MOE_FP8_DOWN 1
#endif
#ifndef MOE_FP8_GU
#define MOE_FP8_GU 1
#endif
constexpr float WDN_SCALE = 128.0f, WGU_SCALE = 64.0f;
#ifndef IDLE_Q
#define IDLE_Q 0
#endif
#ifndef MK_SPLIT
#define MK_SPLIT 0
#endif

constexpr size_t MiB = 1u << 20;
constexpr size_t WS_CTL = 0, CTL_ZERO_BYTES = 1 * MiB;
constexpr size_t WS_WINE = 1 * MiB, WS_WINO = 11 * MiB, WS_WOUT = 23 * MiB, WS_WP = 31 * MiB, WS_WGU = 32 * MiB, WS_WDN = 544 * MiB;
constexpr size_t WS_X = 800 * MiB, WS_XB = 864 * MiB, WS_X1 = 896 * MiB, WS_X1B = 960 * MiB, WS_PRE = 992 * MiB, WS_P = 1056 * MiB, WS_MIX = 1152 * MiB;
constexpr size_t WS_QK = 1184 * MiB, WS_DD = 1216 * MiB, WS_GATES = 1232 * MiB, WS_H = 1234 * MiB, WS_TOKE = 1298 * MiB, WS_TOKPOS = WS_TOKE + 256 * 1024, WS_GATE = WS_TOKE + 512 * 1024, WS_SLOT = WS_TOKE + 768 * 1024;
constexpr size_t WS_XS = 1300 * MiB, WS_ACT = 1444 * MiB, WS_Y = 1588 * MiB, WS_END = 1876 * MiB;
constexpr size_t WS_X1F8 = WS_XS;
constexpr size_t WS_ACT8 = WS_ACT;
constexpr int CW_TMO = 0, CW_BAR = 4096, CW_CNT = 16384;

constexpr int RING_OFF = 0, RING_BYTES = 131072;
constexpr int MISC_OFF = RING_BYTES;
constexpr int GCACHE_OFF = RING_BYTES + 8192, GCACHE_SLOTS = 16;
constexpr int LDS_BYTES = GCACHE_OFF + GCACHE_SLOTS * 1024;
constexpr int MW_CNT = 16, MW_ROWBASE = 48, MW_TILEE = 96, MW_NTILES = 400, MW_LCNT = 416, MW_WBASE = 448, MW_PICK = 512, MW_TBASE = 1600;
constexpr size_t WS_LIST = WS_H + 2 * MiB;

#define GAS __attribute__((address_space(1)))
#define LAS __attribute__((address_space(3)))
typedef unsigned short bf16;
typedef unsigned v4u __attribute__((ext_vector_type(4)));
typedef unsigned v2u __attribute__((ext_vector_type(2)));
typedef float f32x4 __attribute__((ext_vector_type(4)));
typedef GAS unsigned gu32;
#define RLX_AGENT __ATOMIC_RELAXED, __HIP_MEMORY_SCOPE_AGENT
#define LDS_WAIT() asm volatile("s_waitcnt lgkmcnt(0)" ::: "memory")
#define VM_WAIT() asm volatile("s_waitcnt vmcnt(0)" ::: "memory")
typedef float f32x2_t __attribute__((ext_vector_type(2))); typedef __bf16 bf16x2_t __attribute__((ext_vector_type(2)));
__device__ __forceinline__ unsigned pk2(float lo, float hi) { f32x2_t v = {lo, hi}; bf16x2_t b = __builtin_convertvector(v, bf16x2_t); return __builtin_bit_cast(unsigned, b); }
__device__ __forceinline__ unsigned f2bf(float f) { return pk2(f, f) & 0xffffu; }
__device__ __forceinline__ float bf2f(unsigned short b) { return __builtin_bit_cast(float, (unsigned)b << 16); }
__device__ __forceinline__ float bflo(unsigned w) { return __builtin_bit_cast(float, w << 16); }
__device__ __forceinline__ float bfhi(unsigned w) { return __builtin_bit_cast(float, w & 0xffff0000u); }
__device__ __forceinline__ float sigmoidf_(float x) { return __builtin_amdgcn_rcpf(1.0f + __expf(-x)); }
__device__ __forceinline__ float logsigmoidf_(float x) { return fminf(x, 0.f) - __logf(1.0f + __expf(-fabsf(x))); }

#define XB_TMO      128
#define XB_XCNT(j)  (256  + 64 * (j))
#define XB_XSUB(j)  (1280 + 64 * (j))
#define XB_XGEN(j)  (2304 + 64 * (j))
#define XB_TOP      3328
#define XB_TOPGEN   3392
#define XCD_BAR_WORDS 3456
#define XB_SPIN_CAP (1u << 18)

__device__ __forceinline__ unsigned xb_ld(unsigned* p)              { return __hip_atomic_load(p, __ATOMIC_RELAXED, __HIP_MEMORY_SCOPE_AGENT); }
__device__ __forceinline__ unsigned xb_add(unsigned* p, unsigned v) { return __hip_atomic_fetch_add(p, v, __ATOMIC_RELAXED, __HIP_MEMORY_SCOPE_AGENT); }
__device__ __forceinline__ unsigned xb_xcc_id() { return (unsigned)__builtin_amdgcn_s_getreg((3 << 11) | 20) & 0xFu; }
#define XB_SPIN(cond, bar) do { unsigned _sp = 0; while (cond) { __builtin_amdgcn_s_sleep(1); \
    if ((++_sp & 255u) == 0u) { if (xb_ld(&(bar)[XB_TMO])) break; if (_sp > XB_SPIN_CAP) { atomicAdd(&(bar)[XB_TMO], 1u); break; } } } } while (0)

struct XcdBarrier {
    unsigned* bar; unsigned x;
    volatile LAS unsigned* st;
};

__device__ __forceinline__ XcdBarrier xcd_barrier_post(unsigned* bar, volatile LAS unsigned* st) {
    XcdBarrier b; b.bar = bar; b.x = xb_xcc_id(); b.st = st;
    if (threadIdx.x == 0) (void)xb_add(&bar[XB_XCNT(b.x)], 1u);
    return b;
}
__device__ __forceinline__ void xcd_barrier_complete(unsigned* bar, unsigned x, unsigned& nloc, unsigned& nx) {
    const unsigned G = gridDim.x * gridDim.y * gridDim.z;
    unsigned sum, cnt, mine, sp = 0u;
    for (;;) {
        sum = 0u; cnt = 0u; mine = 0u;
#pragma unroll
        for (unsigned j = 0; j < 16; ++j) { const unsigned c = xb_ld(&bar[XB_XCNT(j)]); sum += c; cnt += (c > 0u) ? 1u : 0u; mine = (j == x) ? c : mine; }
        if (sum == G) break;
        __builtin_amdgcn_s_sleep(1);
        if ((++sp & 255u) == 0u) { if (xb_ld(&bar[XB_TMO])) break; if (sp > XB_SPIN_CAP) { atomicAdd(&bar[XB_TMO], 1u); break; } }
    }
    nloc = mine > 0u ? mine : 1u; nx = cnt > 0u ? cnt : 1u;
}

__device__ __forceinline__ void xcd_barrier(const XcdBarrier& b) {
    asm volatile("s_waitcnt vmcnt(0)" ::: "memory");
    __syncthreads();
    if (threadIdx.x == 0) {
        unsigned* bar = b.bar;
        __builtin_amdgcn_s_waitcnt(0);
        unsigned nloc = b.st[0], nx = b.st[1];
        if (nloc == 0u) { xcd_barrier_complete(bar, b.x, nloc, nx); b.st[0] = nloc; b.st[1] = nx; }
        const unsigned old = xb_add(&bar[XB_XSUB(b.x)], 1u);
        const unsigned gen = old / nloc;
        if (old + 1u == (gen + 1u) * nloc) {
            __builtin_amdgcn_fence(__ATOMIC_RELEASE, "agent");
            asm volatile("s_waitcnt vmcnt(0)" ::: "memory");
            (void)xb_add(&bar[XB_TOP], 1u);
            const unsigned target = (gen + 1u) * nx;
            XB_SPIN((int)(xb_ld(&bar[XB_TOP]) - target) < 0, bar);
            __builtin_amdgcn_fence(__ATOMIC_ACQUIRE, "agent");
            xb_add(&bar[XB_XGEN(b.x)], 1u);
            asm volatile("s_waitcnt vmcnt(0)" ::: "memory");
        } else {
            XB_SPIN(xb_ld(&bar[XB_XGEN(b.x)]) == gen, bar);
            __builtin_amdgcn_fence(__ATOMIC_ACQUIRE, "agent");
            asm volatile("s_waitcnt vmcnt(0)" ::: "memory");
        }
    }
    __syncthreads();
}


typedef short s16x4 __attribute__((ext_vector_type(4)));
__device__ __forceinline__ pg8::bf16x8 tr8(const LAS unsigned char* p, int pitchB) {
    const s16x4 lo = __builtin_amdgcn_ds_read_tr16_b64_v4i16((LAS s16x4*)p);
    const s16x4 hi = __builtin_amdgcn_ds_read_tr16_b64_v4i16((LAS s16x4*)(p + 4 * pitchB));
    return __builtin_shufflevector(lo, hi, 0, 1, 2, 3, 4, 5, 6, 7);
}
struct Args { const float* in[25]; float* out; unsigned char* ws; int ph_lo, ph_hi; };
struct Frame {
    LAS unsigned char* lds;
    volatile LAS unsigned* MISC;
    gu32* ctl;
    int tid, lane, wave, vcu, G;
    float* out; unsigned char* ws;
};
__device__ __forceinline__ float dpp_add(float v, const int ctrl_sel) {
    const int x = __builtin_bit_cast(int, v); int y;
    if (ctrl_sel == 0) y = __builtin_amdgcn_update_dpp(x, x, 0xB1, 0xF, 0xF, false);
    else if (ctrl_sel == 1) y = __builtin_amdgcn_update_dpp(x, x, 0x4E, 0xF, 0xF, false);
    else if (ctrl_sel == 2) y = __builtin_amdgcn_update_dpp(x, x, 0x124, 0xF, 0xF, false);
    else y = __builtin_amdgcn_update_dpp(x, x, 0x128, 0xF, 0xF, false);
    return v + __builtin_bit_cast(float, y);
}
__device__ __forceinline__ float wave_sum(float v) {
    v = dpp_add(v, 0); v = dpp_add(v, 1); v = dpp_add(v, 2); v = dpp_add(v, 3);
    v += __shfl_xor(v, 16); v += __shfl_xor(v, 32);
    return v;
}
struct P0Tile { const float* src; size_t ldw; bf16* dst; size_t ldd; int fp8; };
constexpr int P0_PB = 528;
__device__ __forceinline__ P0Tile p0_tile(Frame& F, const Args& A, int t) {
    bf16* wine = (bf16*)(F.ws + WS_WINE); bf16* wino = (bf16*)(F.ws + WS_WINO); bf16* wout = (bf16*)(F.ws + WS_WOUT); bf16* wgu = (bf16*)(F.ws + WS_WGU); bf16* wdn = (bf16*)(F.ws + WS_WDN);
    constexpr int T_GU = 8 * 8, T_DN = 8 * 4, T_WE = 8 * 10, T_WO = 8 * 12, T_OUT = 8 * 4;
    constexpr int N_GU = 128 * T_GU, N_DN = 128 * T_DN, N_WE = 2 * T_WE, N_WO = 2 * T_WO;
    P0Tile o; int r = t, kt, nt; o.fp8 = 0;
    if (r < N_GU) { const int mtx = r / T_GU, q = r % T_GU; kt = q / 8; nt = q % 8; o.src = A.in[21] + (size_t)mtx * 1024 * 2048; o.ldw = 2048; o.dst = MOE_FP8_GU ? (bf16*)((unsigned char*)wgu + (size_t)mtx * 2048 * 1024) : wgu + (size_t)mtx * 2048 * 1024; o.fp8 = MOE_FP8_GU ? 2 : 0; }
    else if ((r -= N_GU) < N_DN) { const int mtx = r / T_DN, q = r % T_DN; kt = q / 4; nt = q % 4; o.src = A.in[23] + (size_t)mtx * 1024 * 1024; o.ldw = 1024; o.dst = MOE_FP8_DOWN ? (bf16*)((unsigned char*)wdn + (size_t)mtx * 1024 * 1024) : wdn + (size_t)mtx * 1024 * 1024; o.fp8 = MOE_FP8_DOWN; }
    else if ((r -= N_DN) < N_WE) { const int mtx = r / T_WE, q = r % T_WE; kt = q / 10; nt = q % 10; o.src = A.in[1] + (size_t)mtx * 1024 * EVEN_IN; o.ldw = EVEN_IN; o.dst = wine + (size_t)mtx * NE_P * 1024; }
    else if ((r -= N_WE) < N_WO) { const int mtx = r / T_WO, q = r % T_WO; kt = q / 12; nt = q % 12; o.src = A.in[10] + (size_t)mtx * 1024 * ODD_IN; o.ldw = ODD_IN; o.dst = wino + (size_t)mtx * NO_P * 1024; }
    else { r -= N_WO; const int l = r / T_OUT, q = r % T_OUT; kt = q / 4; nt = q % 4; o.src = ((l & 1) ? A.in[14] : A.in[9]) + (size_t)(l >> 1) * 1024 * 1024; o.ldw = 1024; o.dst = wout + (size_t)l * 1024 * 1024; }
    o.ldd = 1024; o.src += (size_t)(128 * kt) * o.ldw + 256 * nt;
    if (o.fp8) o.dst = (bf16*)((unsigned char*)o.dst + (size_t)(256 * nt) * 1024 + 128 * kt); else o.dst += (size_t)(256 * nt) * o.ldd + 128 * kt;
    return o;
}
__device__ __forceinline__ void p0_tile_load(const P0Tile& t, int wave, int lane, f32x4 (&v)[16]) {
#pragma unroll
    for (int i = 0; i < 16; ++i) v[i] = __builtin_nontemporal_load((const GAS f32x4*)(t.src + (size_t)(16 * wave + i) * t.ldw + 4 * lane));
}
__device__ __forceinline__ int p0_map(int layer, int j) { return layer < 0 ? j : (j < 1024 ? 8192 + layer * 1024 + j : layer * 2048 + (j - 1024)); }
__device__ __forceinline__ void p0_convert(Frame& F, const Args& A, int layer, int j0, int jstep, int jend) {
    LAS unsigned char* img = F.lds + RING_OFF;
    const int lane = F.lane, w = F.wave, g = lane >> 4, q = (lane & 15) >> 2, p = lane & 3, l15 = lane & 15;
    f32x4 v[16];
    int j = j0;
    if (j < jend) { const P0Tile cur = p0_tile(F, A, p0_map(layer, j)); p0_tile_load(cur, w, lane, v); }
    for (; j < jend; j += jstep) {
        const P0Tile cur = p0_tile(F, A, p0_map(layer, j));
#pragma unroll
        for (int i = 0; i < 16; ++i) { v2u o; o.x = pk2(v[i].x, v[i].y); o.y = pk2(v[i].z, v[i].w); *(LAS v2u*)(img + (16 * w + i) * P0_PB + lane * 8) = o; }
        __syncthreads();
        if (j + jstep < jend) { const P0Tile nx = p0_tile(F, A, p0_map(layer, j + jstep)); p0_tile_load(nx, w, lane, v); }
        if (cur.fp8) {
            const float sc_ = (cur.fp8 == 2) ? WGU_SCALE : WDN_SCALE;
#pragma unroll
            for (int kh = 0; kh < 2; ++kh)
#pragma unroll
                for (int c = 0; c < 2; ++c) {
                    const v4u f0 = __builtin_bit_cast(v4u, tr8(img + (64 * kh + 16 * g + q) * P0_PB + (32 * w + 16 * c + 4 * p) * 2, P0_PB));
                    const v4u f1 = __builtin_bit_cast(v4u, tr8(img + (64 * kh + 16 * g + 8 + q) * P0_PB + (32 * w + 16 * c + 4 * p) * 2, P0_PB));
                    v4u o8;
                    o8.x = pg8::pk4_fp8(bflo(f0.x) * sc_, bfhi(f0.x) * sc_, bflo(f0.y) * sc_, bfhi(f0.y) * sc_); o8.y = pg8::pk4_fp8(bflo(f0.z) * sc_, bfhi(f0.z) * sc_, bflo(f0.w) * sc_, bfhi(f0.w) * sc_);
                    o8.z = pg8::pk4_fp8(bflo(f1.x) * sc_, bfhi(f1.x) * sc_, bflo(f1.y) * sc_, bfhi(f1.y) * sc_); o8.w = pg8::pk4_fp8(bflo(f1.z) * sc_, bfhi(f1.z) * sc_, bflo(f1.w) * sc_, bfhi(f1.w) * sc_);
                    *(GAS v4u*)((unsigned char*)cur.dst + (size_t)(32 * w + 16 * c + l15) * 1024 + 64 * kh + 16 * g) = o8;
                }
        } else {
#pragma unroll
            for (int kb = 0; kb < 4; ++kb)
#pragma unroll
                for (int c = 0; c < 2; ++c) {
                    const pg8::bf16x8 fr = tr8(img + (32 * kb + 8 * g + q) * P0_PB + (32 * w + 16 * c + 4 * p) * 2, P0_PB);
                    *(GAS pg8::bf16x8*)(cur.dst + (size_t)(32 * w + 16 * c + l15) * cur.ldd + 32 * kb + 8 * g) = fr;
                }
        }
        __syncthreads();
    }
}
__device__ __forceinline__ void p0_weights(Frame& F, const Args& A) {
    bf16* wp = (bf16*)(F.ws + WS_WP);
    p0_convert(F, A, -1, 12288 + F.vcu, F.G, 12768);
    for (int i = F.vcu * NTHR + F.tid; i < 2 * 4 * 128 * 128; i += F.G * NTHR) { const int mtx = i >> 14, d = (i >> 7) & 127, c = i & 127, li = mtx >> 2, gg = mtx & 3;
        wp[(size_t)li * 512 * 512 + (size_t)(gg * 128 + d) * 512 + gg * 128 + c] = (bf16)f2bf(A.in[2][(size_t)mtx * 16384 + c * 128 + d]); }
    for (int i = (F.vcu * NTHR + F.tid); i < 2 * 512 * 64; i += F.G * NTHR) {
        const int li = i / (512 * 64), rem = i % (512 * 64), row = rem / 64, ch = rem % 64;
        if ((row >> 7) != (ch >> 4)) *(GAS v4u*)(wp + (size_t)li * 512 * 512 + (size_t)row * 512 + ch * 8) = (v4u){0u, 0u, 0u, 0u};
    }
}

__device__ __forceinline__ void moe_tables(Frame& F, int layer) {
    if (F.tid < 64) {
        const int e = F.tid & 31;
        const unsigned n = __hip_atomic_load((unsigned*)(F.ctl + CW_CNT + (layer * 32 + e) * 64), RLX_AGENT), t = (n + 255u) >> 8;
        unsigned incl = t;
#pragma unroll
        for (int o = 1; o < 32; o <<= 1) { const unsigned up = __shfl_up(incl, o, 32); if (e >= o) incl += up; }
        const unsigned tb = incl - t;
        if (F.tid < 32) {
            F.MISC[MW_CNT + e] = n; F.MISC[MW_ROWBASE + e] = tb * 256u; F.MISC[MW_TBASE + e] = tb;
            for (unsigned k = 0; k < t; ++k) F.MISC[MW_TILEE + tb + k] = (unsigned)e;
            if (e == 31) { F.MISC[MW_ROWBASE + 32] = incl * 256u; F.MISC[MW_NTILES] = incl; }
        }
    }
    __syncthreads();
}
constexpr int XS_LD = 1028;
template <int MODE>
__device__ __forceinline__ void rw_phase(Frame& F, const Args& A, int layer) {
    LAS float* xs = (LAS float*)(F.lds + RING_OFF);
    LAS float* part = (LAS float*)(F.lds + RING_OFF + 16 * XS_LD * 4);
    const int lane = F.lane, w = F.wave, tid = F.tid;
    const float* pw = nullptr; size_t ldw = 0; int ncols = 0; const float* pbias = nullptr;
    if (MODE == 1) { pw = A.in[19] + (size_t)layer * 1024 * 32; ldw = 32; ncols = 32; pbias = A.in[20] + layer * 32; }
    else { const int nl = (MODE == 0) ? 0 : layer + 1;
        if (nl < DEPTH) { if (nl & 1) { pw = A.in[10] + (size_t)(nl >> 1) * 1024 * ODD_IN + NO_P; ldw = ODD_IN; ncols = 16; } else { pw = A.in[1] + (size_t)(nl >> 1) * 1024 * EVEN_IN + NE_P; ldw = EVEN_IN; ncols = 8; } } }
    const float* lg = nullptr; const float* lb = nullptr;
    if (MODE == 1) { lg = A.in[15] + layer * D; lb = A.in[16] + layer * D; }
    if (MODE == 2) { lg = A.in[17] + layer * D; lb = A.in[18] + layer * D; }
    bf16* XB = (bf16*)(F.ws + WS_XB); bf16* X1B = (bf16*)(F.ws + WS_X1B);
    const bf16* PRE = (const bf16*)(F.ws + WS_PRE); const bf16* Y = (const bf16*)(F.ws + WS_Y); float* GATES = (float*)(F.ws + WS_GATES);
    float* GATE = (float*)(F.ws + WS_GATE); int* SLOT = (int*)(F.ws + WS_SLOT); int* LIST = (int*)(F.ws + WS_LIST);
    if (MODE == 1) { if (tid < 32) F.MISC[MW_LCNT + tid] = 0u; __syncthreads(); }
    if (MODE == 2 && MK_SPLIT) moe_tables(F, layer);
    float bw0[8][4], bw1[8][4];
    { const int kq = lane >> 4, c0 = lane & 15, c1 = 16 + (lane & 15);
#pragma unroll
        for (int st = 0; st < 8; ++st)
#pragma unroll
            for (int j = 0; j < 4; ++j) { const int k = 128 * w + 16 * st + 4 * kq + j;
                bw0[st][j] = (ncols > 0 && c0 < ncols) ? pw[(size_t)k * ldw + c0] : 0.f; bw1[st][j] = (MODE == 1 && ncols > 0 && c1 < ncols) ? pw[(size_t)k * ldw + c1] : 0.f; } }
    f32x4 lgv[4], lbv[4];
#pragma unroll
    for (int j = 0; j < 4; ++j) { lgv[j] = (MODE != 0) ? *((const GAS f32x4*)lg + lane + 64 * j) : (f32x4){1.f, 1.f, 1.f, 1.f}; lbv[j] = (MODE != 0) ? *((const GAS f32x4*)lb + lane + 64 * j) : (f32x4){0.f, 0.f, 0.f, 0.f}; }
    int srow = 0, gbits = 0;
    if (MODE == 2) { const int tl = F.vcu + (lane >> 3) * F.G;
        if (tl < M / 16) { const int tk = (tl * 16 + 2 * w + ((lane >> 2) & 1)) * 4 + (lane & 3); const int idx = SLOT[tk]; srow = (int)F.MISC[MW_TBASE + (idx >> 14)] * 256 + (idx & 16383); gbits = __builtin_bit_cast(int, GATE[tk]); } }
    f32x4 rx[2][4]; v2u xx[2][4], yy[2][4][4]; float gk[2][4];
#define RW_ISSUE(tile_, tc_) do { const int tok0_ = (tile_) * 16 + 2 * w; \
        if (MODE == 0) { _Pragma("unroll") for (int rr = 0; rr < 2; ++rr) { const GAS f32x4* xr = (const GAS f32x4*)(A.in[0] + (size_t)(tok0_ + rr) * D) + lane; _Pragma("unroll") for (int j = 0; j < 4; ++j) rx[rr][j] = xr[64 * j]; } } \
        else if (MODE == 1) { _Pragma("unroll") for (int rr = 0; rr < 2; ++rr) { const GAS v2u* xr = (const GAS v2u*)(PRE + (size_t)(tok0_ + rr) * D) + lane; _Pragma("unroll") for (int j = 0; j < 4; ++j) xx[rr][j] = xr[64 * j]; } } \
        else { _Pragma("unroll") for (int rr = 0; rr < 2; ++rr) _Pragma("unroll") for (int k = 0; k < 4; ++k) { const int li = (tc_) * 8 + rr * 4 + k; const int s = __builtin_amdgcn_readlane(srow, li); gk[rr][k] = __builtin_bit_cast(float, __builtin_amdgcn_readlane(gbits, li)); \
                    const GAS v2u* yr = (const GAS v2u*)(Y + (size_t)s * D) + lane; _Pragma("unroll") for (int j = 0; j < 4; ++j) yy[rr][k][j] = yr[64 * j]; } \
            _Pragma("unroll") for (int rr = 0; rr < 2; ++rr) { const GAS v2u* xr = (const GAS v2u*)(X1B + (size_t)(tok0_ + rr) * D) + lane; _Pragma("unroll") for (int j = 0; j < 4; ++j) xx[rr][j] = xr[64 * j]; } } } while (0)
    int tcount = 0;
    if (F.vcu < M / 16) RW_ISSUE(F.vcu, 0);
    for (int tile = F.vcu; tile < M / 16; tile += F.G, ++tcount) {
        f32x4 vv[2][4];
#pragma unroll
        for (int rr = 0; rr < 2; ++rr)
#pragma unroll
            for (int j = 0; j < 4; ++j) {
                if (MODE == 0) vv[rr][j] = rx[rr][j];
                else { f32x4 a = (f32x4){bflo(xx[rr][j].x), bfhi(xx[rr][j].x), bflo(xx[rr][j].y), bfhi(xx[rr][j].y)};
                    if (MODE == 2) { a = a * ALPHA;
#pragma unroll
                        for (int k = 0; k < 4; ++k) { const v2u y2 = yy[rr][k][j]; const float g = gk[rr][k]; a.x += bflo(y2.x) * g; a.y += bfhi(y2.x) * g; a.z += bflo(y2.y) * g; a.w += bfhi(y2.y) * g; } }
                    vv[rr][j] = a; } }
        if (tile + F.G < M / 16) RW_ISSUE(tile + F.G, tcount + 1);
#pragma unroll
        for (int rr = 0; rr < 2; ++rr) {
            const int r = 2 * w + rr, tok = tile * 16 + r;
            f32x4 v[4];
#pragma unroll
            for (int j = 0; j < 4; ++j) v[j] = vv[rr][j];
            if (MODE != 0) {
                float s = 0.f;
#pragma unroll
                for (int j = 0; j < 4; ++j) s += (v[j].x + v[j].y) + (v[j].z + v[j].w);
                const float mean = wave_sum(s) * (1.f / D); float s2 = 0.f;
#pragma unroll
                for (int j = 0; j < 4; ++j) { v[j] = v[j] - mean; s2 += (v[j].x * v[j].x + v[j].y * v[j].y) + (v[j].z * v[j].z + v[j].w * v[j].w); }
                const float rstd = __builtin_amdgcn_rsqf(wave_sum(s2) * (1.f / D) + LN_EPS);
#pragma unroll
                for (int j = 0; j < 4; ++j) v[j] = v[j] * rstd * lgv[j] + lbv[j];
                if (MODE == 2 && layer == DEPTH - 1) { GAS f32x4* o4 = (GAS f32x4*)(F.out + (size_t)tok * D) + lane;
#pragma unroll
                    for (int j = 0; j < 4; ++j) o4[64 * j] = v[j]; }
            }
            bf16* bo = (MODE == 1) ? X1B : XB;
            GAS v2u* o8 = (GAS v2u*)(bo + (size_t)tok * D) + lane;
            if (!(MODE == 2 && layer == DEPTH - 1)) {
#pragma unroll
                for (int j = 0; j < 4; ++j) { v2u p; p.x = pk2(v[j].x, v[j].y); p.y = pk2(v[j].z, v[j].w); o8[64 * j] = p; } }
            if (MODE == 1 && MOE_FP8_GU) { GAS unsigned* o4 = (GAS unsigned*)(F.ws + WS_X1F8 + (size_t)tok * D) + lane;
#pragma unroll
                for (int j = 0; j < 4; ++j) o4[64 * j] = pg8::pk4_fp8(v[j].x, v[j].y, v[j].z, v[j].w); }
            if (ncols > 0) {
#pragma unroll
                for (int j = 0; j < 4; ++j) *(LAS f32x4*)(xs + r * XS_LD + 4 * lane + 256 * j) = v[j]; }
        }
        if (ncols > 0) __syncthreads();
        if (ncols > 0) {
            f32x4 acc0 = {0.f, 0.f, 0.f, 0.f}, acc1 = {0.f, 0.f, 0.f, 0.f};
            const int prow = lane & 15, kq = lane >> 4, c0 = lane & 15, c1 = 16 + (lane & 15);
#pragma unroll
            for (int st = 0; st < 8; ++st) {
                const int k0 = 128 * w + 16 * st + 4 * kq;
                const f32x4 a = *(const LAS f32x4*)(xs + prow * XS_LD + k0);
#pragma unroll
                for (int j = 0; j < 4; ++j) {
                    acc0 = __builtin_amdgcn_mfma_f32_16x16x4f32(a[j], bw0[st][j], acc0, 0, 0, 0);
                    if (MODE == 1) acc1 = __builtin_amdgcn_mfma_f32_16x16x4f32(a[j], bw1[st][j], acc1, 0, 0, 0);
                }
            }
#pragma unroll
            for (int g = 0; g < 4; ++g) { part[(w * 16 + kq * 4 + g) * 32 + c0] = acc0[g]; part[(w * 16 + kq * 4 + g) * 32 + c1] = acc1[g]; }
        }
        __syncthreads();
        if (ncols > 0) {
            const int r = tid >> 5, c = tid & 31, tok = tile * 16 + r;
            float val = 0.f;
#pragma unroll
            for (int ww = 0; ww < 8; ++ww) val += part[(ww * 16 + r) * 32 + c];
            if (MODE != 1) { if (c < ncols) GATES[tok * 16 + c] = val; }
            else {
                val += pbias[c];
                float cur = val; float selv[4]; int seli[4];
#pragma unroll
                for (int k = 0; k < 4; ++k) {
                    float bv = cur; int bi = c;
#pragma unroll
                    for (int off = 16; off >= 1; off >>= 1) { const float ov = __shfl_xor(bv, off); const int oi = __shfl_xor(bi, off); if (ov > bv || (ov == bv && oi < bi)) { bv = ov; bi = oi; } }
                    selv[k] = bv; seli[k] = bi; if (c == bi) cur = -3.0e38f;
                }
                if (c < 4) {
                    const float e0 = 1.f, e1 = __expf(selv[1] - selv[0]), e2 = __expf(selv[2] - selv[0]), e3 = __expf(selv[3] - selv[0]);
                    const float inv = __builtin_amdgcn_rcpf(e0 + e1 + e2 + e3);
                    const float ge = (c == 0) ? e0 : (c == 1) ? e1 : (c == 2) ? e2 : e3;
                    const int ee = (c == 0) ? seli[0] : (c == 1) ? seli[1] : (c == 2) ? seli[2] : seli[3];
                    GATE[tok * 4 + c] = ge * inv;
                    const unsigned rank = __hip_atomic_fetch_add((LAS unsigned*)(F.lds + MISC_OFF) + MW_LCNT + ee, 1u, __ATOMIC_RELAXED, __HIP_MEMORY_SCOPE_WORKGROUP);
                    F.MISC[MW_PICK + tcount * 64 + r * 4 + c] = (unsigned)ee | (rank << 8);
                }
            }
        }
        __syncthreads();
    }
    if (MODE == 1) {
        if (tid < 32) { const unsigned n = F.MISC[MW_LCNT + tid]; unsigned base = 0u; if (n) base = __hip_atomic_fetch_add((unsigned*)(F.ctl + CW_CNT + (layer * 32 + tid) * 64), n, RLX_AGENT); F.MISC[MW_WBASE + tid] = base; }
        __syncthreads();
        for (int i = tid; i < tcount * 64; i += NTHR) { const int tc = i >> 6, r = (i >> 2) & 15, k = i & 3; const int tok = (F.vcu + tc * F.G) * 16 + r;
            const unsigned pk = F.MISC[MW_PICK + i]; const int idx = (int)((pk & 0xffu) * 16384u + F.MISC[MW_WBASE + (pk & 0xffu)] + (pk >> 8)); SLOT[tok * 4 + k] = idx; LIST[idx] = tok; }
        __syncthreads();
    }
}

constexpr size_t WS_QW = WS_QK, WS_KW = WS_QK + 16 * MiB, WS_ST = WS_XS;
constexpr size_t WS_BT = WS_H, WS_CM = WS_H + 256 * 1024, WS_RMAX = WS_H + 512 * 1024, WS_GC = WS_H + 516 * 1024, WS_MPREV = WS_H + 520 * 1024, WS_EBL = WS_H + 1 * MiB;
constexpr int KP = 136;

__device__ __forceinline__ pg8::f32x4 mma16(pg8::bf16x8 a, pg8::bf16x8 b, pg8::f32x4 c) { return __builtin_amdgcn_mfma_f32_16x16x32_bf16(a, b, c, 0, 0, 0); }

__device__ __forceinline__ void even_prep2(Frame& F, const Args& A, int li) {
    const bf16* P = (const bf16*)(F.ws + WS_P); bf16* QW = (bf16*)(F.ws + WS_QW); bf16* KW = (bf16*)(F.ws + WS_KW); bf16* DD = (bf16*)(F.ws + WS_DD);
    const float* GATES = (const float*)(F.ws + WS_GATES);
    float* BT = (float*)(F.ws + WS_BT); float* CM = (float*)(F.ws + WS_CM); float* RMAX = (float*)(F.ws + WS_RMAX); float* GC = (float*)(F.ws + WS_GC);
    const float* cw = A.in[4] + (size_t)li * 4 * 1024; const float* cb = A.in[5] + (size_t)li * 1024;
    LAS float* gs = (LAS float*)(F.lds + RING_OFF); LAS float* ls = gs + 256; LAS float* rs = ls + 256; LAS float* fac = rs + 256;
    const int tid = F.tid;
    for (int unit = F.vcu; unit < 256; unit += F.G) {
        const int tok0 = (unit >> 6) * SEQ + (unit & 63) * 64;
        v4u rows[19];
        { const int ch = (tid & 127) * 8, tb = tok0 + 16 * (tid >> 7), s0 = tb & (SEQ - 1);
#pragma unroll
            for (int r = 0; r < 19; ++r) { rows[r] = (v4u){0u, 0u, 0u, 0u}; if (s0 - 3 + r >= 0) rows[r] = *(const GAS v4u*)(P + (size_t)(tb - 3 + r) * LDP + 512 + ch); } }
        if (tid < 256) { const int t = tid >> 2, h = tid & 3; gs[tid] = GATES[(size_t)(tok0 + t) * 16 + h] + A.in[6][li * 4 + h]; ls[tid] = logsigmoidf_(GATES[(size_t)(tok0 + t) * 16 + 4 + h] + A.in[7][li * 4 + h]); }
        __syncthreads();
        if (tid < 256) {
            const int h = tid >> 6, t = tid & 63;
            float bs = ls[t * 4 + h];
#pragma unroll
            for (int o = 1; o < 64; o <<= 1) { const float up = __shfl_up(bs, o); if (t >= o) bs += up; }
            const float r = gs[t * 4 + h] - bs; float cm = r;
#pragma unroll
            for (int o = 1; o < 64; o <<= 1) { const float up = __shfl_up(cm, o); if (t >= o) cm = fmaxf(cm, up); }
            const float rmax = __shfl(cm, 63), gsum = __shfl(bs, 63);
            BT[(size_t)(tok0 + t) * 4 + h] = bs; CM[(size_t)(tok0 + t) * 4 + h] = cm;
            if (t == 0) { RMAX[unit * 4 + h] = rmax; GC[unit * 4 + h] = gsum; }
            fac[t * 4 + h] = __expf(r - rmax) * 0.08838834764831845f;
        }
        __syncthreads();
        {
            const int ch = (tid & 127) * 8, tb = tok0 + 16 * (tid >> 7);
            float wv[4][8], bv[8];
#pragma unroll
            for (int i = 0; i < 8; ++i) { bv[i] = cb[ch + i];
#pragma unroll
                for (int jj = 0; jj < 4; ++jj) wv[jj][i] = cw[jj * 1024 + ch + i]; }
#pragma unroll
            for (int t = 0; t < 16; ++t) {
                float acc[8];
#pragma unroll
                for (int i = 0; i < 8; ++i) acc[i] = bv[i];
#pragma unroll
                for (int jj = 0; jj < 4; ++jj) { const v4u pv = rows[t + jj];
                    acc[0] += wv[jj][0] * bflo(pv.x); acc[1] += wv[jj][1] * bfhi(pv.x); acc[2] += wv[jj][2] * bflo(pv.y); acc[3] += wv[jj][3] * bfhi(pv.y);
                    acc[4] += wv[jj][4] * bflo(pv.z); acc[5] += wv[jj][5] * bfhi(pv.z); acc[6] += wv[jj][6] * bflo(pv.w); acc[7] += wv[jj][7] * bfhi(pv.w); }
                const int tl = 16 * (tid >> 7) + t;
                const float sc = (ch >= 512) ? fac[tl * 4 + ((ch - 512) >> 7)] : 1.0f;
#pragma unroll
                for (int i = 0; i < 8; ++i) acc[i] = acc[i] * sigmoidf_(acc[i]) * sc;
                v4u o; o.x = pk2(acc[0], acc[1]); o.y = pk2(acc[2], acc[3]); o.z = pk2(acc[4], acc[5]); o.w = pk2(acc[6], acc[7]);
                if (ch < 512) *(GAS v4u*)(QW + (size_t)(tb + t) * 512 + ch) = o; else *(GAS v4u*)(KW + (size_t)(tb + t) * 512 + ch - 512) = o;
            }
        }
        {
            const int ch = (tid & 63) * 8, tb = tok0 + 8 * (tid >> 6), s0 = tb & (SEQ - 1), win = 2 << (ch >> 7);
            v4u rows[23];
#pragma unroll
            for (int r = 0; r < 23; ++r) { rows[r] = (v4u){0u, 0u, 0u, 0u}; if (r >= 16 - win && s0 - 15 + r >= 0) rows[r] = *(const GAS v4u*)(P + (size_t)(tb - 15 + r) * LDP + ch); }
#pragma unroll
            for (int t = 0; t < 8; ++t) {
                const int s = s0 + t, n = (s + 1 < win) ? (s + 1) : win;
                float acc[8] = {0.f, 0.f, 0.f, 0.f, 0.f, 0.f, 0.f, 0.f};
#pragma unroll
                for (int jj = 0; jj < 16; ++jj) { if (jj < win) { const v4u pv = rows[15 + t - jj];
                        acc[0] += bflo(pv.x); acc[1] += bfhi(pv.x); acc[2] += bflo(pv.y); acc[3] += bfhi(pv.y); acc[4] += bflo(pv.z); acc[5] += bfhi(pv.z); acc[6] += bflo(pv.w); acc[7] += bfhi(pv.w); } }
                const v4u u = rows[15 + t]; const float inv = __builtin_amdgcn_rcpf((float)n);
                const float u0[8] = {bflo(u.x), bfhi(u.x), bflo(u.y), bfhi(u.y), bflo(u.z), bfhi(u.z), bflo(u.w), bfhi(u.w)};
#pragma unroll
                for (int i = 0; i < 8; ++i) acc[i] = acc[i] * inv - u0[i];
                v4u o; o.x = pk2(acc[0], acc[1]); o.y = pk2(acc[2], acc[3]); o.z = pk2(acc[4], acc[5]); o.w = pk2(acc[6], acc[7]);
                *(GAS v4u*)(DD + (size_t)(tb + t) * 512 + ch) = o;
            }
        }
        __syncthreads();
    }
}
__device__ __forceinline__ void odd_prep(Frame& F, const Args& A, int li) {
    const bf16* P = (const bf16*)(F.ws + WS_P); bf16* QW = (bf16*)(F.ws + WS_QW); bf16* KW = (bf16*)(F.ws + WS_KW); float* EBL = (float*)(F.ws + WS_EBL);
    const float* GATES = (const float*)(F.ws + WS_GATES);
    const float* w2 = A.in[11] + (size_t)li * 16 * 512; const float* gb = A.in[12] + (size_t)li * 512;
    LAS float* gl = (LAS float*)(F.lds + RING_OFF);
    const int tid = F.tid, d = tid;
    float wc[16];
#pragma unroll
    for (int r = 0; r < 16; ++r) wc[r] = w2[r * 512 + d];
    const float gbv = gb[d];
    for (int unit = F.vcu; unit < 256; unit += F.G) {
        const int tok0 = (unit >> 6) * SEQ + (unit & 63) * 64;
        for (int i = tid; i < 1024; i += NTHR) gl[i] = GATES[(size_t)(tok0 + (i >> 4)) * 16 + (i & 15)];
        __syncthreads();
        float Bc = 0.f;
        unsigned short qn[8], kn[8];
#pragma unroll
        for (int j = 0; j < 8; ++j) { qn[j] = P[(size_t)(tok0 + j) * LDP + d]; kn[j] = P[(size_t)(tok0 + j) * LDP + 512 + d]; }
        for (int t0 = 0; t0 < 64; t0 += 8) {
            unsigned short qv[8], kv[8];
#pragma unroll
            for (int j = 0; j < 8; ++j) { qv[j] = qn[j]; kv[j] = kn[j]; }
            { const int tn = (t0 + 8 < 64) ? t0 + 8 : t0;
#pragma unroll
                for (int j = 0; j < 8; ++j) { qn[j] = P[(size_t)(tok0 + tn + j) * LDP + d]; kn[j] = P[(size_t)(tok0 + tn + j) * LDP + 512 + d]; } }
#pragma unroll
            for (int j = 0; j < 8; ++j) {
                const int t = t0 + j;
                float z = gbv;
#pragma unroll
                for (int r = 0; r < 16; ++r) z += gl[t * 16 + r] * wc[r];
                Bc += logsigmoidf_(z) * 0.0625f;
                QW[(size_t)(tok0 + t) * 512 + d] = (bf16)f2bf(bf2f(qv[j]) * 0.08838834764831845f * __expf(Bc));
                KW[(size_t)(tok0 + t) * 512 + d] = (bf16)f2bf(bf2f(kv[j]) * __expf(-Bc));
            }
        }
        EBL[unit * 512 + d] = __expf(Bc);
        __syncthreads();
    }
}
template <bool EVEN>
__device__ __forceinline__ void stage_rows128(Frame& F, const bf16* src, int tok0, int h, LAS unsigned char* dst) {
    for (int i = F.tid; i < 1024; i += NTHR) { const int t = i >> 4, ch = i & 15; const v4u x = *(const GAS v4u*)(src + (size_t)(tok0 + t) * 512 + h * 128 + ch * 8); *(LAS v4u*)(dst + t * (KP * 2) + ch * 16) = x; }
}
template <bool EVEN>
__device__ __forceinline__ void stage_v(Frame& F, int tok0, int h, LAS unsigned char* Vs) {
    constexpr int DV = EVEN ? 128 : 256, DVP = EVEN ? 144 : 256, VPB = (DVP + 8) * 2, CH = DV / 8;
    const bf16* P = (const bf16*)(F.ws + WS_P) + (EVEN ? 1536 : 1024) + h * DV;
    for (int i = F.tid; i < 64 * CH; i += NTHR) { const int t = i / CH, ch = i % CH; const v4u x = *(const GAS v4u*)(P + (size_t)(tok0 + t) * LDP + ch * 8); *(LAS v4u*)(Vs + t * VPB + ch * 16) = x; }
    if (EVEN) { if (F.tid < 128) { const int t = F.tid >> 1, ch = F.tid & 1; v4u x = {0u, 0u, 0u, 0u}; if (ch == 0) x.x = 0x00003F80u; *(LAS v4u*)(Vs + t * VPB + (128 + ch * 8) * 2) = x; } }
}
__device__ __forceinline__ void ld_rows128(Frame& F, const bf16* src, int tok0, int h, v4u (&r)[2]) {
#pragma unroll
    for (int k = 0; k < 2; ++k) { const int i = F.tid + NTHR * k, t = i >> 4, ch = i & 15; r[k] = *(const GAS v4u*)(src + (size_t)(tok0 + t) * 512 + h * 128 + ch * 8); }
}
__device__ __forceinline__ void st_rows128(Frame& F, LAS unsigned char* dst, const v4u (&r)[2]) {
#pragma unroll
    for (int k = 0; k < 2; ++k) { const int i = F.tid + NTHR * k, t = i >> 4, ch = i & 15; *(LAS v4u*)(dst + t * (KP * 2) + ch * 16) = r[k]; }
}
template <bool EVEN>
__device__ __forceinline__ void ld_v(Frame& F, int tok0, int h, v4u (&r)[EVEN ? 2 : 4]) {
    constexpr int DV = EVEN ? 128 : 256, CH = DV / 8, NK = EVEN ? 2 : 4;
    const bf16* P = (const bf16*)(F.ws + WS_P) + (EVEN ? 1536 : 1024) + h * DV;
#pragma unroll
    for (int k = 0; k < NK; ++k) { const int i = F.tid + NTHR * k, t = i / CH, ch = i % CH; r[k] = *(const GAS v4u*)(P + (size_t)(tok0 + t) * LDP + ch * 8); }
}
template <bool EVEN>
__device__ __forceinline__ void st_v(Frame& F, LAS unsigned char* Vs, const v4u (&r)[EVEN ? 2 : 4]) {
    constexpr int DV = EVEN ? 128 : 256, DVP = EVEN ? 144 : 256, VPB = (DVP + 8) * 2, CH = DV / 8, NK = EVEN ? 2 : 4;
#pragma unroll
    for (int k = 0; k < NK; ++k) { const int i = F.tid + NTHR * k, t = i / CH, ch = i % CH; *(LAS v4u*)(Vs + t * VPB + ch * 16) = r[k]; }
    if (EVEN) { if (F.tid < 128) { const int t = F.tid >> 1, ch = F.tid & 1; v4u x = {0u, 0u, 0u, 0u}; if (ch == 0) x.x = 0x00003F80u; *(LAS v4u*)(Vs + t * VPB + (128 + ch * 8) * 2) = x; } }
}
template <bool EVEN>
__device__ __forceinline__ void mix_phaseA(Frame& F) {
    constexpr int DVP = EVEN ? 144 : 256, NTW = EVEN ? 1 : 2, VPB = (DVP + 8) * 2, KPB = KP * 2;
    LAS unsigned char* KWs = F.lds + RING_OFF; LAS unsigned char* Vs = KWs + 64 * KPB;
    const bf16* KW = (const bf16*)(F.ws + WS_KW); bf16* ST = (bf16*)(F.ws + WS_ST);
    const int lane = F.lane, w = F.wave, g = lane >> 4, q = (lane & 15) >> 2, p = lane & 3;
    v4u rk[2], rv[EVEN ? 2 : 4];
    if (F.vcu * 4 < 1024) { const int unit = F.vcu, b = unit >> 6, c = unit & 63; ld_rows128(F, KW, b * SEQ + c * 64, 0, rk); ld_v<EVEN>(F, b * SEQ + c * 64, 0, rv); }
    for (int uu = F.vcu * 4; uu < 1024; uu += F.G * 4)
    for (int h = 0; h < 4; ++h) {
        const int unit = uu >> 2, b = unit >> 6, c = unit & 63, bh = b * 4 + h, u = bh * 64 + c, tok0 = b * SEQ + c * 64;
        st_rows128(F, KWs, rk); st_v<EVEN>(F, Vs, rv);
        __syncthreads();
        { const int nh = (h + 1) & 3, nuu = (h == 3) ? uu + F.G * 4 : uu;
            if (nuu < 1024) { const int nunit = nuu >> 2, nb = nunit >> 6, nc = nunit & 63; ld_rows128(F, KW, nb * SEQ + nc * 64, nh, rk); ld_v<EVEN>(F, nb * SEQ + nc * 64, nh, rv); } }
        pg8::f32x4 acc[NTW][8]; pg8::f32x4 accx = {0.f, 0.f, 0.f, 0.f};
#pragma unroll
        for (int j = 0; j < NTW; ++j)
#pragma unroll
            for (int mt = 0; mt < 8; ++mt) acc[j][mt] = (pg8::f32x4){0.f, 0.f, 0.f, 0.f};
#pragma unroll
        for (int ks = 0; ks < 2; ++ks) {
            pg8::bf16x8 bv[NTW], bx;
#pragma unroll
            for (int j = 0; j < NTW; ++j) bv[j] = tr8(Vs + (32 * ks + 8 * g + q) * VPB + (16 * (w * NTW + j) + 4 * p) * 2, VPB);
            if (EVEN) bx = tr8(Vs + (32 * ks + 8 * g + q) * VPB + (128 + 4 * p) * 2, VPB);
#pragma unroll
            for (int mt = 0; mt < 8; ++mt) {
                const pg8::bf16x8 a = tr8(KWs + (32 * ks + 8 * g + q) * KPB + (16 * mt + 4 * p) * 2, KPB);
#pragma unroll
                for (int j = 0; j < NTW; ++j) acc[j][mt] = mma16(a, bv[j], acc[j][mt]);
                if (EVEN) { if (mt == w) accx = mma16(a, bx, accx); }
            }
        }
#pragma unroll
        for (int j = 0; j < NTW; ++j)
#pragma unroll
            for (int mt = 0; mt < 8; ++mt) { v2u o; o.x = pk2(acc[j][mt][0], acc[j][mt][1]); o.y = pk2(acc[j][mt][2], acc[j][mt][3]);
                *(GAS v2u*)(ST + ((size_t)u * DVP + 16 * (w * NTW + j) + (lane & 15)) * 128 + 16 * mt + 4 * g) = o; }
        if (EVEN) { v2u o; o.x = pk2(accx[0], accx[1]); o.y = pk2(accx[2], accx[3]); *(GAS v2u*)(ST + ((size_t)u * DVP + 128 + (lane & 15)) * 128 + 16 * w + 4 * g) = o; }
        __syncthreads();
    }
}
template <bool EVEN>
__device__ __forceinline__ void mix_scan(Frame& F, int nwg_s, int idx_s) {
    constexpr int DVP = EVEN ? 144 : 256, NTK = DVP * 16;
    bf16* ST = (bf16*)(F.ws + WS_ST);
    const float* RMAX = (const float*)(F.ws + WS_RMAX); const float* GC = (const float*)(F.ws + WS_GC); float* MPREV = (float*)(F.ws + WS_MPREV); const float* EBL = (const float*)(F.ws + WS_EBL);
    if (idx_s >= 0)
    for (int gi = (F.wave * nwg_s + idx_s) * 64 + F.lane; gi < 16 * NTK; gi += nwg_s * NTHR) {
        const int bh = gi / NTK, rem = gi % NTK, dv = rem >> 4, d8 = rem & 15, b = bh >> 2, h = bh & 3;
        bf16* base = ST + ((size_t)(bh * 64) * DVP + dv) * 128 + d8 * 8;
        float s[8];
#pragma unroll
        for (int i = 0; i < 8; ++i) s[i] = 0.f;
        float m = 0.f;
        for (int c0 = 0; c0 < 64; c0 += 8) {
            v4u uu[8];
#pragma unroll
            for (int k = 0; k < 8; ++k) uu[k] = *(const GAS v4u*)(base + (size_t)(c0 + k) * DVP * 128);
#pragma unroll
            for (int k = 0; k < 8; ++k) {
                const int c = c0 + k;
                const float u8[8] = {bflo(uu[k].x), bfhi(uu[k].x), bflo(uu[k].y), bfhi(uu[k].y), bflo(uu[k].z), bfhi(uu[k].z), bflo(uu[k].w), bfhi(uu[k].w)};
                v4u o;
                if (EVEN) {
                    const float rmax = RMAX[(b * 64 + c) * 4 + h], gc = GC[(b * 64 + c) * 4 + h];
                    const float Mc = fmaxf(m, rmax), al = __expf(m - Mc), be = __expf(rmax - Mc), kap = __expf(m - rmax);
                    o.x = pk2(kap * s[0], kap * s[1]); o.y = pk2(kap * s[2], kap * s[3]); o.z = pk2(kap * s[4], kap * s[5]); o.w = pk2(kap * s[6], kap * s[7]);
                    if (dv == 0 && d8 == 0) MPREV[bh * 64 + c] = m;
#pragma unroll
                    for (int i = 0; i < 8; ++i) s[i] = al * s[i] + be * u8[i];
                    m = gc + Mc;
                } else {
                    o.x = pk2(s[0], s[1]); o.y = pk2(s[2], s[3]); o.z = pk2(s[4], s[5]); o.w = pk2(s[6], s[7]);
                    const f32x4 a0 = *(const GAS f32x4*)(EBL + (size_t)(b * 64 + c) * 512 + h * 128 + d8 * 8), a1 = *(const GAS f32x4*)(EBL + (size_t)(b * 64 + c) * 512 + h * 128 + d8 * 8 + 4);
                    const float al[8] = {a0.x, a0.y, a0.z, a0.w, a1.x, a1.y, a1.z, a1.w};
#pragma unroll
                    for (int i = 0; i < 8; ++i) s[i] = al[i] * (s[i] + u8[i]);
                }
                *(GAS v4u*)(base + (size_t)c * DVP * 128) = o;
            }
        }
    }
}
template <bool EVEN>
__device__ __forceinline__ void mix_phaseC(Frame& F, const Args& A, int li) {
    constexpr int DV = EVEN ? 128 : 256, DVP = EVEN ? 144 : 256, NTW = EVEN ? 1 : 2, VPB = (DVP + 8) * 2, KPB = KP * 2, PPB = 72 * 2, OP = DVP + 4;
    LAS unsigned char* QWs = F.lds + RING_OFF; LAS unsigned char* KWs = QWs + 64 * KPB; LAS unsigned char* Vs = KWs + 64 * KPB; LAS unsigned char* PS = F.lds + RING_OFF + 68608;
    LAS float* rho = (LAS float*)(F.lds + RING_OFF + 77824); LAS float* thr = rho + 64; LAS float* OUT = (LAS float*)(F.lds + RING_OFF);
    static_assert(64 * KPB * 2 + 64 * VPB <= 68608 && 64 * OP * 4 <= 68608, "phase C LDS map");
    const bf16* QW = (const bf16*)(F.ws + WS_QW); const bf16* KW = (const bf16*)(F.ws + WS_KW); const bf16* ST = (const bf16*)(F.ws + WS_ST);
    const bf16* P = (const bf16*)(F.ws + WS_P); bf16* MIX = (bf16*)(F.ws + WS_MIX);
    const float* gn = EVEN ? A.in[8] + (size_t)li * 512 : A.in[13] + (size_t)li * 1024;
    const int lane = F.lane, w = F.wave, g = lane >> 4, q = (lane & 15) >> 2, p = lane & 3, l15 = lane & 15;
    v4u rq[2], rk[2], rv[EVEN ? 2 : 4];
    float pcm = 0.f, pbt = 0.f, prmax = 0.f, pmp = 0.f;
    if (F.vcu < 1024) { const int u = F.vcu, bh = u >> 6, c = u & 63, tok0 = (bh >> 2) * SEQ + c * 64, h = bh & 3; ld_rows128(F, QW, tok0, h, rq); ld_rows128(F, KW, tok0, h, rk); ld_v<EVEN>(F, tok0, h, rv);
        if (EVEN) { if (F.tid < 64) { const int t = F.tid; pcm = ((const float*)(F.ws + WS_CM))[(size_t)(tok0 + t) * 4 + h]; pbt = ((const float*)(F.ws + WS_BT))[(size_t)(tok0 + t) * 4 + h];
                prmax = ((const float*)(F.ws + WS_RMAX))[((bh >> 2) * 64 + c) * 4 + h]; pmp = ((const float*)(F.ws + WS_MPREV))[u]; } } }
    for (int u = F.vcu; u < 1024; u += F.G) {
        const int bh = u >> 6, c = u & 63, b = bh >> 2, h = bh & 3, tok0 = b * SEQ + c * 64;
        pg8::bf16x8 sb[4][NTW], sbx[4];
#pragma unroll
        for (int ks = 0; ks < 4; ++ks) {
#pragma unroll
            for (int j = 0; j < NTW; ++j) sb[ks][j] = *(const GAS pg8::bf16x8*)(ST + ((size_t)u * DVP + 16 * (w * NTW + j) + l15) * 128 + 32 * ks + 8 * g);
            if (EVEN) sbx[ks] = *(const GAS pg8::bf16x8*)(ST + ((size_t)u * DVP + 128 + l15) * 128 + 32 * ks + 8 * g);
        }
        st_rows128(F, QWs, rq); st_rows128(F, KWs, rk); st_v<EVEN>(F, Vs, rv);
        if (EVEN) { if (F.tid < 64) { const int t = F.tid;
                const float cm = pcm, bt = pbt, rmax = prmax, mp = pmp;
                const float Mt = fmaxf(mp, cm); rho[t] = __expf(rmax - Mt); thr[t] = __expf(-(bt + Mt)); } }
        __syncthreads();
        if (u + F.G < 1024) { const int nu = u + F.G, nbh = nu >> 6, nc = nu & 63, ntok0 = (nbh >> 2) * SEQ + nc * 64, nh = nbh & 3;
            ld_rows128(F, QW, ntok0, nh, rq); ld_rows128(F, KW, ntok0, nh, rk); ld_v<EVEN>(F, ntok0, nh, rv);
            if (EVEN) { if (F.tid < 64) { const int t = F.tid; pcm = ((const float*)(F.ws + WS_CM))[(size_t)(ntok0 + t) * 4 + nh]; pbt = ((const float*)(F.ws + WS_BT))[(size_t)(ntok0 + t) * 4 + nh];
                    prmax = ((const float*)(F.ws + WS_RMAX))[((nbh >> 2) * 64 + nc) * 4 + nh]; pmp = ((const float*)(F.ws + WS_MPREV))[nu]; } } }
        {
            const int mt = w >> 1;
            pg8::f32x4 pa[2] = {{0.f, 0.f, 0.f, 0.f}, {0.f, 0.f, 0.f, 0.f}};
#pragma unroll
            for (int ks = 0; ks < 4; ++ks) {
                const pg8::bf16x8 a = *(const LAS pg8::bf16x8*)(QWs + (16 * mt + l15) * KPB + (32 * ks + 8 * g) * 2);
#pragma unroll
                for (int jj = 0; jj < 2; ++jj) { const int nt = 2 * (w & 1) + jj; const pg8::bf16x8 bb = *(const LAS pg8::bf16x8*)(KWs + (16 * nt + l15) * KPB + (32 * ks + 8 * g) * 2); pa[jj] = mma16(a, bb, pa[jj]); }
            }
#pragma unroll
            for (int jj = 0; jj < 2; ++jj) { const int nt = 2 * (w & 1) + jj, s = 16 * nt + l15;
#pragma unroll
                for (int r = 0; r < 4; ++r) { const int t = 16 * mt + 4 * g + r; *(LAS bf16*)(PS + t * PPB + s * 2) = (bf16)((s <= t) ? f2bf(pa[jj][r]) : 0u); } }
        }
        __syncthreads();
        unsigned og[8]; v2u rg[8];
#pragma unroll
        for (int rr = 0; rr < 8; ++rr) { if (EVEN) og[rr] = *(const GAS unsigned*)(P + (size_t)(tok0 + 8 * w + rr) * LDP + 2048 + h * 128 + 2 * lane); else rg[rr] = *(const GAS v2u*)(P + (size_t)(tok0 + 8 * w + rr) * LDP + 2048 + h * 256 + 4 * lane); }
        pg8::f32x4 acc[NTW][4]; pg8::f32x4 accx = {0.f, 0.f, 0.f, 0.f};
#pragma unroll
        for (int j = 0; j < NTW; ++j)
#pragma unroll
            for (int mt = 0; mt < 4; ++mt) acc[j][mt] = (pg8::f32x4){0.f, 0.f, 0.f, 0.f};
#pragma unroll
        for (int ks = 0; ks < 2; ++ks) {
            pg8::bf16x8 bv[NTW], bx;
#pragma unroll
            for (int j = 0; j < NTW; ++j) bv[j] = tr8(Vs + (32 * ks + 8 * g + q) * VPB + (16 * (w * NTW + j) + 4 * p) * 2, VPB);
            if (EVEN) bx = tr8(Vs + (32 * ks + 8 * g + q) * VPB + (128 + 4 * p) * 2, VPB);
#pragma unroll
            for (int mt = 0; mt < 4; ++mt) {
                const pg8::bf16x8 a = *(const LAS pg8::bf16x8*)(PS + (16 * mt + l15) * PPB + (32 * ks + 8 * g) * 2);
#pragma unroll
                for (int j = 0; j < NTW; ++j) acc[j][mt] = mma16(a, bv[j], acc[j][mt]);
                if (EVEN) { if (mt == w) accx = mma16(a, bx, accx); }
            }
        }
#pragma unroll
        for (int ks = 0; ks < 4; ++ks) {
#pragma unroll
            for (int mt = 0; mt < 4; ++mt) {
                const pg8::bf16x8 a = *(const LAS pg8::bf16x8*)(QWs + (16 * mt + l15) * KPB + (32 * ks + 8 * g) * 2);
#pragma unroll
                for (int j = 0; j < NTW; ++j) acc[j][mt] = mma16(a, sb[ks][j], acc[j][mt]);
                if (EVEN) { if (mt == w) accx = mma16(a, sbx[ks], accx); }
            }
        }
        __syncthreads();
#pragma unroll
        for (int j = 0; j < NTW; ++j)
#pragma unroll
            for (int mt = 0; mt < 4; ++mt)
#pragma unroll
                for (int r = 0; r < 4; ++r) OUT[(16 * mt + 4 * g + r) * OP + 16 * (w * NTW + j) + l15] = acc[j][mt][r];
        if (EVEN) { if (w < 4) {
#pragma unroll
                for (int r = 0; r < 4; ++r) OUT[(16 * w + 4 * g + r) * OP + 128 + l15] = accx[r]; } }
        __syncthreads();
        if (EVEN) {
            const float g0 = gn[h * 128 + 2 * lane], g1 = gn[h * 128 + 2 * lane + 1];
#pragma unroll
            for (int rr = 0; rr < 8; ++rr) {
                const int t = 8 * w + rr; const size_t tok = (size_t)(tok0 + t);
                const float v0 = OUT[t * OP + 2 * lane], v1 = OUT[t * OP + 2 * lane + 1], den = OUT[t * OP + 128], rh = rho[t];
                const float dd = __builtin_amdgcn_rcpf(fmaxf(fabsf(rh * den), thr[t]));
                float h0 = rh * v0 * dd, h1 = rh * v1 * dd;
                const float mu = wave_sum(h0 + h1) * (1.f / 128.f); h0 -= mu; h1 -= mu;
                const float rs = __builtin_amdgcn_rsqf(wave_sum(h0 * h0 + h1 * h1) * (1.f / 128.f) + LN_EPS);
                const float o0 = h0 * rs * g0 * sigmoidf_(bflo(og[rr])), o1 = h1 * rs * g1 * sigmoidf_(bfhi(og[rr]));
                *(GAS unsigned*)(MIX + tok * 1024 + 512 + h * 128 + 2 * lane) = pk2(o0, o1);
            }
        } else {
            const f32x4 gg = *(const GAS f32x4*)(gn + h * 256 + 4 * lane);
#pragma unroll
            for (int rr = 0; rr < 8; ++rr) {
                const int t = 8 * w + rr; const size_t tok = (size_t)(tok0 + t);
                f32x4 v = *(const LAS f32x4*)(OUT + t * OP + 4 * lane);
                const float mu = wave_sum((v.x + v.y) + (v.z + v.w)) * (1.f / 256.f); v = v - mu;
                const float rs = __builtin_amdgcn_rsqf(wave_sum((v.x * v.x + v.y * v.y) + (v.z * v.z + v.w * v.w)) * (1.f / 256.f) + LN_EPS);
                const float r0 = bflo(rg[rr].x), r1 = bfhi(rg[rr].x), r2 = bflo(rg[rr].y), r3 = bfhi(rg[rr].y);
                v2u o; o.x = pk2(v.x * rs * gg.x * (r0 * sigmoidf_(r0)), v.y * rs * gg.y * (r1 * sigmoidf_(r1))); o.y = pk2(v.z * rs * gg.z * (r2 * sigmoidf_(r2)), v.w * rs * gg.w * (r3 * sigmoidf_(r3)));
                *(GAS v2u*)(MIX + tok * 1024 + h * 256 + 4 * lane) = o;
            }
        }
        __syncthreads();
    }
}

#define IN(k) (lo <= (k) && (k) < hi)
#define SEAM(k) do { if (!MK_SPLIT && (k) + 1 < hi) xcd_barrier(bar); } while (0)
template <int layer>
__device__ __forceinline__ void layer_body(Frame& F, const Args& args, const XcdBarrier& bar, const int lo, const int hi) {
        { int t_ = threadIdx.x; asm volatile("" : "+v"(t_)); F.tid = t_; F.lane = t_ & 63; F.wave = __builtin_amdgcn_readfirstlane(t_ >> 6);
          int v_ = F.vcu, g_ = F.G; asm volatile("" : "+s"(v_), "+s"(g_)); F.vcu = v_; F.G = g_; F.ws = args.ws; F.ctl = (gu32*)(args.ws + WS_CTL); }
        const int pb = 1 + layer * NPH, li = layer >> 1; const bool odd = layer & 1;
        bf16* XB = (bf16*)(F.ws + WS_XB); bf16* P = (bf16*)(F.ws + WS_P); bf16* MIX = (bf16*)(F.ws + WS_MIX);
        if (IN(pb + 0)) {
            const bf16* wt = odd ? (const bf16*)(F.ws + WS_WINO) + (size_t)li * NO_P * 1024 : (const bf16*)(F.ws + WS_WINE) + (size_t)li * NE_P * 1024;
            const int N = odd ? NO_P : NE_P;
            pg8::Gemm g{XB, wt, M, N, D}; pg8::StaticOrder S; S.init(M, N, F.G, (int)blockIdx.x);
            pg8::EpiStoreBf16 E{P, LDP, nullptr, 0};
            for (int rep = 0; rep < (PROBE_DUP == 5 ? 2 : 1); ++rep) pg8::gemm_phase<pg8::EpiStoreBf16, pg8::StaticOrder, true, true>(F.lds + RING_OFF, g, S, E);
            SEAM(pb + 0);
        }
        if (IN(pb + 1)) {
            if (odd) odd_prep(F, args, li); else even_prep2(F, args, li);
            if (PROBE_DUP == 4) { if (odd) odd_prep(F, args, li); else even_prep2(F, args, li); }
            VM_WAIT(); __syncthreads();
            if (odd) mix_phaseA<false>(F); else mix_phaseA<true>(F);
            if (PROBE_DUP == 2) { if (odd) mix_phaseA<false>(F); else mix_phaseA<true>(F); }
            SEAM(pb + 1);
        }
        if (IN(pb + 4)) {
            const bool split = !odd && F.G == 256;
            if (odd) mix_scan<false>(F, F.G, F.vcu); else mix_scan<true>(F, split ? 128 : F.G, split ? (int)blockIdx.x - 128 : F.vcu);
            if (!odd) {
                pg8::Gemm g{(const bf16*)(F.ws + WS_DD), (const bf16*)(F.ws + WS_WP) + (size_t)li * 512 * 512, M, 512, 512}; pg8::StaticOrder S; S.init(M, 512, F.G, (int)blockIdx.x);
                pg8::EpiStoreBf16 E{MIX, 1024, args.in[3] + (size_t)li * 512, 0};
                for (int rep = 0; rep < (PROBE_DUP == 5 ? 2 : 1); ++rep) pg8::gemm_phase<pg8::EpiStoreBf16, pg8::StaticOrder, true, true>(F.lds + RING_OFF, g, S, E);
            }
            SEAM(pb + 4);
        }
        if (IN(pb + 5)) { if (odd) mix_phaseC<false>(F, args, li); else mix_phaseC<true>(F, args, li); if (PROBE_DUP == 2) { if (odd) mix_phaseC<false>(F, args, li); else mix_phaseC<true>(F, args, li); } SEAM(pb + 5); }
        if (IN(pb + 6)) {
            pg8::Gemm g{MIX, (const bf16*)(F.ws + WS_WOUT) + (size_t)layer * 1024 * 1024, M, D, D}; pg8::StaticOrder S; S.init(M, D, F.G, (int)blockIdx.x);
            pg8::EpiResBf16 E{(const bf16*)(F.ws + WS_XB), (bf16*)(F.ws + WS_PRE), D, ALPHA};
            for (int rep = 0; rep < (PROBE_DUP == 5 ? 2 : 1); ++rep) pg8::gemm_phase<pg8::EpiResBf16, pg8::StaticOrder, true, true>(F.lds + RING_OFF, g, S, E);
            SEAM(pb + 6);
        }
#ifndef X_NO_RW
        if (IN(pb + 7)) {
            p0_convert(F, args, layer, 1024 + F.vcu, F.G, 3072); __syncthreads();
            rw_phase<1>(F, args, layer); SEAM(pb + 7); }
#endif
        if (IN(pb + 9)) {
            moe_tables(F, layer);
            pg8::Gemm g{(const bf16*)(F.ws + (MOE_FP8_GU ? WS_X1F8 : WS_X1B)), (const bf16*)(F.ws + WS_WGU) + (size_t)layer * 32 * 2048 * 1024 / (MOE_FP8_GU ? 2 : 1), MAXROWS, 32 * 2048, MOE_FP8_GU ? D / 2 : D};
            pg8::MoeOrder S{8, F.G, F.vcu, (int)F.MISC[MW_NTILES] * 8, (const LAS int*)(F.lds + MISC_OFF) + MW_TILEE, (const LAS int*)(F.lds + MISC_OFF) + MW_TBASE, (const LAS int*)(F.lds + MISC_OFF) + MW_CNT, 0, 1};
            pg8::EpiSwiglu E{(bf16*)(F.ws + WS_ACT), args.in[22] + (size_t)layer * 32 * 2048, 0, MOE_FP8_DOWN ? (unsigned char*)(F.ws + WS_ACT8) : nullptr, MOE_FP8_GU ? 1.0f / WGU_SCALE : 1.0f};
            {
                LAS int* gc = (LAS int*)(F.lds + GCACHE_OFF); const int* LIST = (const int*)(F.ws + WS_LIST);
                const int r = F.tid & 255, s0 = F.tid >> 8; int tk[GCACHE_SLOTS / 2];
#pragma unroll
                for (int i = 0; i < GCACHE_SLOTS / 2; ++i) { pg8::Unit uu; const bool ok = S.next(2 * i + s0, uu); const bool valid = ok && (r < uu.nval); const int ai = valid ? (uu.aidx + r) : 0; const int t = LIST[ai]; tk[i] = valid ? t : 0; }
#pragma unroll
                for (int i = 0; i < GCACHE_SLOTS / 2; ++i) gc[(2 * i + s0) * 256 + r] = tk[i];
                __syncthreads();
            }
            for (int rep = 0; rep < (PROBE_DUP == 3 ? 2 : 1); ++rep) pg8::gemm_phase<pg8::EpiSwiglu, pg8::MoeOrder, true, true, true, MOE_FP8_GU != 0>(F.lds + RING_OFF, g, S, E, (const LAS int*)(F.lds + GCACHE_OFF));
            if (PROBE_DUP == 6 || PROBE_DUP == 7 || PROBE_DUP == 8) { pg8::MoeOrder S2 = S; S2.force0 = (PROBE_DUP == 6) ? 1 : 0; pg8::EpiSwiglu E2{(bf16*)(F.ws + WS_END), args.in[22] + (size_t)layer * 32 * 2048, (PROBE_DUP == 7) ? (args.ph_hi > 0) : 0, nullptr, MOE_FP8_GU ? 1.0f / WGU_SCALE : 1.0f}; pg8::gemm_phase<pg8::EpiSwiglu, pg8::MoeOrder, true, true, true, MOE_FP8_GU != 0>(F.lds + RING_OFF, g, S2, E2, (const LAS int*)(F.lds + GCACHE_OFF)); }
            {
                const int total = (int)F.MISC[MW_NTILES] * 8, rem = (F.G == 256) ? (total & 255) : 0, nidle = rem ? 256 - rem : 0, nbusy = F.G - nidle;
                int x = (F.G == 256) ? (1024 - 4 * nidle) / 256 : 1024 / F.G; if (x < 0) x = 0;
                const int left = 1024 - nbusy * x, q = nidle ? (left + nidle - 1) / nidle : 0;
                int j0, j1;
                if (nidle == 0 || F.vcu < rem) { j0 = F.vcu * x; j1 = j0 + x; if (nidle == 0 && F.vcu == F.G - 1) j1 = 1024; }
                else { j0 = nbusy * x + (F.vcu - rem) * q; j1 = j0 + q; }
                if (j1 > 1024) j1 = 1024;
                p0_convert(F, args, layer, j0, 1, j1);
            }
            SEAM(pb + 9);
        }
        if (IN(pb + 10)) {
            if (MK_SPLIT) moe_tables(F, layer);
            pg8::Gemm g{(const bf16*)(F.ws + (MOE_FP8_DOWN ? WS_ACT8 : WS_ACT)), (const bf16*)(F.ws + WS_WDN) + (size_t)layer * 32 * 1024 * 1024 / (MOE_FP8_DOWN ? 2 : 1), MAXROWS, 32 * 1024, MOE_FP8_DOWN ? D / 2 : D};
            pg8::MoeOrder S{4, F.G, F.vcu, (int)F.MISC[MW_NTILES] * 4, (const LAS int*)(F.lds + MISC_OFF) + MW_TILEE, (const LAS int*)(F.lds + MISC_OFF) + MW_TBASE, (const LAS int*)(F.lds + MISC_OFF) + MW_CNT, 0, 0};
            pg8::EpiDown E{(bf16*)(F.ws + WS_Y), args.in[24] + (size_t)layer * 32 * 1024, 0, MOE_FP8_DOWN ? 1.0f / WDN_SCALE : 1.0f};
            for (int rep = 0; rep < (PROBE_DUP == 3 ? 2 : 1); ++rep) pg8::gemm_phase<pg8::EpiDown, pg8::MoeOrder, true, true, false, MOE_FP8_DOWN != 0>(F.lds + RING_OFF, g, S, E);
            if (PROBE_DUP == 6 || PROBE_DUP == 7 || PROBE_DUP == 8) { pg8::MoeOrder S2 = S; S2.force0 = (PROBE_DUP == 6) ? 1 : 0; pg8::EpiDown E2{(bf16*)(F.ws + WS_END), args.in[24] + (size_t)layer * 32 * 1024, (PROBE_DUP == 7) ? (args.ph_hi > 0) : 0, MOE_FP8_DOWN ? 1.0f / WDN_SCALE : 1.0f}; pg8::gemm_phase<pg8::EpiDown, pg8::MoeOrder, true, true, false, MOE_FP8_DOWN != 0>(F.lds + RING_OFF, g, S2, E2); }
            SEAM(pb + 10);
        }
#ifndef X_NO_RW
        if (IN(pb + 11)) { rw_phase<2>(F, args, layer); if (PROBE_DUP == 4) rw_phase<2>(F, args, layer); SEAM(pb + 11); }
#endif
}
__global__ void __launch_bounds__(NTHR, 2) fwd_kernel(Args args) {
    extern __shared__ __attribute__((aligned(16))) unsigned char lds[];
    Frame F;
    F.lds = (LAS unsigned char*)lds; F.MISC = (volatile LAS unsigned*)(F.lds + MISC_OFF);
    F.tid = threadIdx.x; F.lane = F.tid & 63; F.wave = __builtin_amdgcn_readfirstlane(F.tid >> 6);
    F.G = gridDim.x; { const int bx = blockIdx.x; F.vcu = (F.G % 8 == 0) ? (bx % 8) * (F.G / 8) + bx / 8 : bx; }
    F.ws = args.ws; F.ctl = (gu32*)(args.ws + WS_CTL); F.out = args.out;
    for (int u = F.tid; u < 2048; u += NTHR) ((LAS unsigned*)(F.lds + MISC_OFF))[u] = 0u;
    __syncthreads();
    const int lo = args.ph_lo, hi = args.ph_hi;
    XcdBarrier bar; bar.bar = (unsigned*)(F.ctl + CW_BAR); bar.x = 0; bar.st = nullptr;
    if (!MK_SPLIT) bar = xcd_barrier_post((unsigned*)(F.ctl + CW_BAR), F.MISC + 8);

    #ifndef X_NO_P0
    if (IN(0)) { p0_weights(F, args); __syncthreads(); if (PROBE_DUP == 1) { p0_weights(F, args); __syncthreads(); }
        if (PROBE_DUP == 9) { const size_t n4 = ((size_t)4 * 32 * 1024 * 2048 + (size_t)4 * 32 * 1024 * 1024) / 4; const size_t n4a = (size_t)4 * 32 * 1024 * 2048 / 4;
            for (size_t i = (size_t)F.vcu * NTHR + F.tid; i < n4; i += (size_t)F.G * NTHR) { const f32x4 v = __builtin_nontemporal_load((const GAS f32x4*)(i < n4a ? args.in[21] : args.in[23] - n4a * 4) + i);
                v2u o; o.x = pk2(v.x, v.y); o.y = pk2(v.z, v.w); *((GAS v2u*)(F.ws + WS_END) + i) = o; } } rw_phase<0>(F, args, 0); SEAM(0); }
#endif

    layer_body<0>(F, args, bar, lo, hi);
    layer_body<1>(F, args, bar, lo, hi);
    layer_body<2>(F, args, bar, lo, hi);
    layer_body<3>(F, args, bar, lo, hi);
#undef IN
#undef SEAM
}

extern "C" void kernel_launch(void* const* d_in, const int* in_sizes, int n_in, void* d_out, int out_size, void* d_ws, size_t ws_size, hipStream_t stream) {
    static int grid = 0;
    if (grid == 0) {
        if (n_in != 25 || in_sizes[0] != M * D || out_size != M * D || ws_size < WS_END + 1024 * MiB) { fprintf(stderr, "kernel_launch: unexpected shapes (n_in %d, in0 %d, out %d, ws %zu)\n", n_in, n_in > 0 ? in_sizes[0] : -1, out_size, ws_size); grid = -1; return; }
        int dev = 0, cus = 0, per_cu = 0;
        if (hipGetDevice(&dev) != hipSuccess || hipDeviceGetAttribute(&cus, hipDeviceAttributeMultiprocessorCount, dev) != hipSuccess) { grid = -1; return; }
        if (hipFuncSetAttribute((const void*)fwd_kernel, hipFuncAttributeMaxDynamicSharedMemorySize, LDS_BYTES) != hipSuccess) { fprintf(stderr, "kernel_launch: hipFuncSetAttribute failed\n"); grid = -1; return; }
        if (hipOccupancyMaxActiveBlocksPerMultiprocessor(&per_cu, (const void*)fwd_kernel, NTHR, LDS_BYTES) != hipSuccess || per_cu < 1) { fprintf(stderr, "kernel_launch: occupancy query says %d\n", per_cu); }
        (void)hipGetLastError();
        grid = cus;
    }
    if (grid < 0) return;
    if (hipMemsetAsync((char*)d_ws + WS_CTL, 0, CTL_ZERO_BYTES, stream) != hipSuccess) return;
    Args a{};
    for (int i = 0; i < 25; ++i) a.in[i] = (const float*)d_in[i];
    a.out = (float*)d_out; a.ws = (unsigned char*)d_ws;
#if MK_SPLIT
    for (int k = 0; k < NPHASES; ++k) {
        if (k >= 1) { const int j = (k - 1) % NPH, layer = (k - 1) / NPH; if (j == 2 || j == 3 || j == 8) continue; }
        a.ph_lo = k; a.ph_hi = k + 1;
        hipLaunchKernelGGL(fwd_kernel, dim3(grid), dim3(NTHR), LDS_BYTES, stream, a);
    }
#else
    a.ph_lo = 0; a.ph_hi = NPHASES;
    hipLaunchKernelGGL(fwd_kernel, dim3(grid), dim3(NTHR), LDS_BYTES, stream, a);
#endif
}
```
